# Optimizing an MI355X kernel written in HIP

```python
import math
import jax, jax.numpy as jnp
from jax import lax
import numpy as np

D_MODEL = 1024
BATCH = 2
SEQ = 8192
DEPTH = 2

HEAD_DIM = 64
N_A_LAYERS = DEPTH // 2
N_B_LAYERS = DEPTH - N_A_LAYERS
MAIN_W = (3 * D_MODEL) // 4
DIFF_HEADS = MAIN_W // (2 * HEAD_DIM)
DIFF_W = DIFF_HEADS * 2 * HEAD_DIM
SB_HEADS = MAIN_W // HEAD_DIM
SB_W = SB_HEADS * HEAD_DIM
MEM_HEADS = 4
MEM_LEN = 256
MEM_W = D_MODEL - MAIN_W
MEM_HEAD_DIM = MEM_W // MEM_HEADS
MIX_W = DIFF_W + MEM_W
A_IN = 3 * DIFF_W + MEM_W + MIX_W
B_IN = SB_W + MEM_W + MIX_W
ROPE_DIM = HEAD_DIM // 4
ROPE_THETA = 500000.0
BLOCK = 128
EPS = 1e-6

kernel_name = "yoco_diffattn_stickbreak_memory_hybrid"


def rms_norm(x, g):
    xf = x.astype(jnp.float32)
    y = xf * lax.rsqrt(jnp.mean(xf * xf, axis=-1, keepdims=True) + EPS)
    return (y * g.astype(jnp.float32)).astype(x.dtype)


def rope_cos_sin(positions):
    inv = ROPE_THETA ** (-jnp.arange(0, ROPE_DIM, 2, dtype=jnp.float32) / ROPE_DIM)
    ang = positions.astype(jnp.float32)[..., None] * inv
    return jnp.cos(ang), jnp.sin(ang)


def apply_partial_rope(x, cos, sin):
    half = ROPE_DIM // 2
    c = cos[:, :, None, None, :].astype(x.dtype)
    s = sin[:, :, None, None, :].astype(x.dtype)
    x1 = x[..., :half]
    x2 = x[..., half:ROPE_DIM]
    return jnp.concatenate([x1 * c - x2 * s, x2 * c + x1 * s, x[..., ROPE_DIM:]], axis=-1)


def diff_attention(q, k, v, lam):
    S = q.shape[3]
    scale = HEAD_DIM ** -0.5
    outs = []
    for i in range(S // BLOCK):
        s0, s1 = i * BLOCK, (i + 1) * BLOCK
        sc = jnp.einsum('bchqd,bchkd->bchqk', q[:, :, :, s0:s1], k[:, :, :, :s1]).astype(jnp.float32) * scale
        mask = (s0 + jnp.arange(BLOCK))[:, None] >= jnp.arange(s1)[None, :]
        p = jax.nn.softmax(jnp.where(mask, sc, -jnp.inf), axis=-1)
        w = p[:, 0] - lam * p[:, 1]
        outs.append(jnp.einsum('bhqk,bhkd->bhqd', w.astype(v.dtype), v[:, :, :s1]))
    return jnp.concatenate(outs, axis=2)


def stick_breaking_attention(q, k, v):
    S = q.shape[2]
    scale = HEAD_DIM ** -0.5
    outs = []
    for i in range(S // BLOCK):
        s0, s1 = i * BLOCK, (i + 1) * BLOCK
        z = jnp.einsum('bhqd,bhkd->bhqk', q[:, :, s0:s1], k[:, :, :s1]).astype(jnp.float32) * scale
        mask = (s0 + jnp.arange(BLOCK))[:, None] > jnp.arange(s1)[None, :]
        log_beta = jax.nn.log_sigmoid(z)
        log_1m = jnp.where(mask, jax.nn.log_sigmoid(-z), 0.0)
        suffix = lax.cumsum(log_1m, axis=3, reverse=True) - log_1m
        a = jnp.exp(jnp.where(mask, log_beta + suffix, -jnp.inf))
        outs.append(jnp.einsum('bhqk,bhkd->bhqd', a.astype(v.dtype), v[:, :, :s1]))
    return jnp.concatenate(outs, axis=2)


def memory_attention(qm, mem, l, mem_norm, mem_w_kv, mem_q_norm, mem_k_norm):
    B, S, _ = qm.shape
    M = mem.shape[1]
    kvm = rms_norm(mem, mem_norm[l]) @ mem_w_kv[l]
    km, vm = jnp.split(kvm, 2, axis=-1)
    km = rms_norm(km.reshape(B, M, MEM_HEADS, MEM_HEAD_DIM), mem_k_norm[l])
    vm = vm.reshape(B, M, MEM_HEADS, MEM_HEAD_DIM)
    qh = rms_norm(qm.reshape(B, S, MEM_HEADS, MEM_HEAD_DIM), mem_q_norm[l])
    sc = jnp.einsum('bshd,bmhd->bhsm', qh, km).astype(jnp.float32) * (MEM_HEAD_DIM ** -0.5)
    p = jax.nn.softmax(sc, axis=-1)
    o = jnp.einsum('bhsm,bmhd->bshd', p.astype(vm.dtype), vm)
    return o.reshape(B, S, MEM_W)


def setup_inputs(seed: int = 0) -> dict:
    key = jax.random.key(seed)
    ks = jax.random.split(key, 24)
    nrm = lambda k, shape: jax.random.normal(k, shape, jnp.float32)
    gain = lambda k, shape: 1.0 + 0.02 * nrm(k, shape)
    s_in = D_MODEL ** -0.5
    return {
        "x": nrm(ks[0], (BATCH, SEQ, D_MODEL)),
        "mem": nrm(ks[1], (BATCH, MEM_LEN, D_MODEL)),
        "positions": jnp.broadcast_to(jnp.arange(SEQ, dtype=jnp.int32), (BATCH, SEQ)),
        "a_norm": gain(ks[2], (N_A_LAYERS, D_MODEL)),
        "a_w_in": nrm(ks[3], (N_A_LAYERS, D_MODEL, A_IN)) * s_in,
        "a_q_norm": gain(ks[4], (N_A_LAYERS, HEAD_DIM)),
        "a_k_norm": gain(ks[5], (N_A_LAYERS, HEAD_DIM)),
        "a_lambda_q1": 0.1 * nrm(ks[6], (N_A_LAYERS, HEAD_DIM)),
        "a_lambda_k1": 0.1 * nrm(ks[7], (N_A_LAYERS, HEAD_DIM)),
        "a_lambda_q2": 0.1 * nrm(ks[8], (N_A_LAYERS, HEAD_DIM)),
        "a_lambda_k2": 0.1 * nrm(ks[9], (N_A_LAYERS, HEAD_DIM)),
        "a_subln": gain(ks[10], (N_A_LAYERS, 2 * HEAD_DIM)),
        "a_w_out": nrm(ks[11], (N_A_LAYERS, MIX_W, D_MODEL)) * (MIX_W ** -0.5),
        "kv_norm": gain(ks[12], (D_MODEL,)),
        "w_kv_shared": nrm(ks[13], (D_MODEL, 2 * SB_W)) * s_in,
        "b_norm": gain(ks[14], (N_B_LAYERS, D_MODEL)),
        "b_w_in": nrm(ks[15], (N_B_LAYERS, D_MODEL, B_IN)) * s_in,
        "b_w_out": nrm(ks[16], (N_B_LAYERS, MIX_W, D_MODEL)) * (MIX_W ** -0.5),
        "mem_norm": gain(ks[17], (DEPTH, D_MODEL)),
        "mem_w_kv": nrm(ks[18], (DEPTH, D_MODEL, 2 * MEM_W)) * s_in,
        "mem_q_norm": gain(ks[19], (DEPTH, MEM_HEAD_DIM)),
        "mem_k_norm": gain(ks[20], (DEPTH, MEM_HEAD_DIM)),
    }


def reference(x, mem, positions, a_norm, a_w_in, a_q_norm, a_k_norm, a_lambda_q1, a_lambda_k1,
              a_lambda_q2, a_lambda_k2, a_subln, a_w_out, kv_norm, w_kv_shared, b_norm, b_w_in,
              b_w_out, mem_norm, mem_w_kv, mem_q_norm, mem_k_norm):
    B, S, D = x.shape
    cos, sin = rope_cos_sin(positions)
    k_sb = v_sb = None
    for i in range(DEPTH):
        if i < N_A_LAYERS:
            l = i
            h = rms_norm(x, a_norm[l])
            proj = h @ a_w_in[l]
            q, k, v, qm, gate = jnp.split(
                proj, [DIFF_W, 2 * DIFF_W, 3 * DIFF_W, 3 * DIFF_W + MEM_W], axis=-1)
            q = apply_partial_rope(rms_norm(q.reshape(B, S, 2, DIFF_HEADS, HEAD_DIM), a_q_norm[l]), cos, sin)
            k = apply_partial_rope(rms_norm(k.reshape(B, S, 2, DIFF_HEADS, HEAD_DIM), a_k_norm[l]), cos, sin)
            q = q.transpose(0, 2, 3, 1, 4)
            k = k.transpose(0, 2, 3, 1, 4)
            v = v.reshape(B, S, DIFF_HEADS, 2 * HEAD_DIM).transpose(0, 2, 1, 3)
            lambda_init = 0.8 - 0.6 * math.exp(-0.3 * i)
            lam = (jnp.exp(jnp.sum(a_lambda_q1[l] * a_lambda_k1[l]).astype(jnp.float32))
                   - jnp.exp(jnp.sum(a_lambda_q2[l] * a_lambda_k2[l]).astype(jnp.float32))
                   + lambda_init)
            o = diff_attention(q, k, v, lam).transpose(0, 2, 1, 3)
            o = (rms_norm(o, a_subln[l]) * (1.0 - lambda_init)).reshape(B, S, DIFF_W)
            om = memory_attention(qm, mem, i, mem_norm, mem_w_kv, mem_q_norm, mem_k_norm)
            y = jnp.concatenate([o, om], axis=-1) * jax.nn.silu(gate)
            x = x + y @ a_w_out[l]
        else:
            j = i - N_A_LAYERS
            if i == N_A_LAYERS:
                kv = rms_norm(x, kv_norm) @ w_kv_shared
                k_s, v_s = jnp.split(kv, 2, axis=-1)
                k_sb = k_s.reshape(B, S, SB_HEADS, HEAD_DIM).transpose(0, 2, 1, 3)
                v_sb = v_s.reshape(B, S, SB_HEADS, HEAD_DIM).transpose(0, 2, 1, 3)
            h = rms_norm(x, b_norm[j])
            proj = h @ b_w_in[j]
            q, qm, gate = jnp.split(proj, [SB_W, SB_W + MEM_W], axis=-1)
            q = q.reshape(B, S, SB_HEADS, HEAD_DIM).transpose(0, 2, 1, 3)
            o = stick_breaking_attention(q, k_sb, v_sb).transpose(0, 2, 1, 3).reshape(B, S, SB_W)
            om = memory_attention(qm, mem, i, mem_norm, mem_w_kv, mem_q_norm, mem_k_norm)
            y = jnp.concatenate([o, om], axis=-1) * jax.nn.silu(gate)
            x = x + y @ b_w_out[j]
    return x
```

```cpp
#include <hip/hip_runtime.h>
#include <hip/hip_cooperative_groups.h>
#include <cstdio>
#include <cmath>
#include <cstring>
namespace cg = cooperative_groups;

typedef unsigned short bf16_t;
typedef short bf16x8 __attribute__((ext_vector_type(8)));
typedef short bf16x4 __attribute__((ext_vector_type(4)));
typedef float f32x16 __attribute__((ext_vector_type(16)));
typedef float f32x4 __attribute__((ext_vector_type(4)));
typedef float f32x2 __attribute__((ext_vector_type(2)));
typedef unsigned u32x4 __attribute__((ext_vector_type(4)));
typedef unsigned u32x2 __attribute__((ext_vector_type(2)));
typedef __bf16 bf2_t __attribute__((ext_vector_type(2)));

#define DI __device__ __forceinline__
#define MFMA32(a, b, c) __builtin_amdgcn_mfma_f32_32x32x16_bf16((a), (b), (c), 0, 0, 0)

constexpr int SEQ = 8192, DM = 1024, NTOK = 16384, NP = 3584;
constexpr int NT = 512;
constexpr float EPS = 1e-6f;
constexpr int LDS_ELEMS = 2 * 512 * 72;
constexpr int LDS_BYTES = LDS_ELEMS * 2 + 16;

struct Seg { const float* src; const float* gain; bf16_t* dst; int ld; int col0; int ncols; int pad; };

struct Params {
  const float* x; const float* mem; const int* pos;
  const float* a_q_norm; const float* a_k_norm; const float* lq1; const float* lk1; const float* lq2; const float* lk2; const float* a_subln;
  const float* mem_q_norm; const float* mem_k_norm;
  float* out;
  bf16_t* xb; bf16_t* memb; bf16_t* P; bf16_t* Vt; bf16_t* y;
  bf16_t* Ksb; bf16_t* W1t; bf16_t* W2t; bf16_t* W3t; bf16_t* W4t; bf16_t* Wmt; bf16_t* Km; bf16_t* Vmt;
  float* ssq0; float* ssq1; float* ssqm; float* cs; int* ctr;
  Seg seg[8];
  float inv[8];
};

DI unsigned pk2(float a, float b) { f32x2 v = {a, b}; bf2_t r = __builtin_convertvector(v, bf2_t); return __builtin_bit_cast(unsigned, r); }
DI bf16_t f2bf(float a) { return (bf16_t)(pk2(a, 0.f) & 0xffffu); }
DI float bflo(unsigned w) { return __uint_as_float(w << 16); }
DI float bfhi(unsigned w) { return __uint_as_float(w & 0xffff0000u); }
DI int crow(int reg, int h) { return (reg & 3) + 8 * (reg >> 2) + 4 * h; }
DI int perm16(int kk) { return ((kk >> 2) & 1) * 8 + (kk >> 3) * 4 + (kk & 3); }
DI bf16x8 pack8(const float* v) {
  u32x4 w; w.x = pk2(v[0], v[1]); w.y = pk2(v[2], v[3]); w.z = pk2(v[4], v[5]); w.w = pk2(v[6], v[7]);
  return __builtin_bit_cast(bf16x8, w);
}
DI int opaque_tid() { int t = threadIdx.x; asm volatile("" : "+v"(t)); return t; }
typedef unsigned u32x2v __attribute__((ext_vector_type(2)));
DI float xhalf(float v, int h) {
  const u32x2v rr = __builtin_amdgcn_permlane32_swap(__float_as_uint(v), __float_as_uint(v), false, false);
  return h ? __uint_as_float(rr.x) : __uint_as_float(rr.y);
}
DI f32x16 zero16() { f32x16 z; for (int i = 0; i < 16; ++i) z[i] = 0.f; return z; }

__device__ void phase0(const Params& p, bf16_t* smem) {
  const int tid = opaque_tid(), lane = tid & 63, wid = tid >> 6, nb = gridDim.x, bid = blockIdx.x;
  for (int row0 = (bid * 8 + wid) * 2; row0 < NTOK + 512; row0 += nb * 16) {
    f32x4 v[2][4];
#pragma unroll
    for (int q = 0; q < 2; ++q) {
      const int row = row0 + q;
      const float* src = (row < NTOK) ? p.x + (size_t)row * DM : p.mem + (size_t)(row - NTOK) * DM;
#pragma unroll
      for (int j = 0; j < 4; ++j) v[q][j] = *(const f32x4*)(src + 256 * j + 4 * lane);
    }
#pragma unroll
    for (int q = 0; q < 2; ++q) {
      const int row = row0 + q;
      bf16_t* dst; float* sq;
      if (row < NTOK) { dst = p.xb + (size_t)row * DM; sq = p.ssq0 + (size_t)row * 16; }
      else { const int r2 = row - NTOK; dst = p.memb + (size_t)r2 * DM; sq = p.ssqm + (size_t)r2 * 16; }
#pragma unroll
      for (int j = 0; j < 4; ++j) {
        const f32x4 t = v[q][j];
        float s = t.x * t.x + t.y * t.y + t.z * t.z + t.w * t.w;
        u32x2 w; w.x = pk2(t.x, t.y); w.y = pk2(t.z, t.w);
        *(u32x2*)(dst + 256 * j + 4 * lane) = w;
        s += __shfl_xor(s, 1); s += __shfl_xor(s, 2); s += __shfl_xor(s, 4); s += __shfl_xor(s, 8);
        if ((lane & 15) == 0) sq[4 * j + (lane >> 4)] = s;
      }
    }
  }
  for (int i = bid * NT + tid; i < NTOK * 8; i += nb * NT) {
    const int token = i >> 3, f = i & 7;
    const float ang = (float)p.pos[token] * p.inv[f];
    double rev = (double)ang * 0.15915494309189535;
    rev -= floor(rev);
    const double q4 = rint(rev * 4.0);
    const double a = (rev - q4 * 0.25) * 6.283185307179586;
    const int q = ((int)q4) & 3;
    const double a2 = a * a;
    double sn = -1.0 / 39916800.0; sn = sn * a2 + 1.0 / 362880.0; sn = sn * a2 - 1.0 / 5040.0; sn = sn * a2 + 1.0 / 120.0; sn = sn * a2 - 1.0 / 6.0; sn = sn * a2 + 1.0; sn *= a;
    double cn = 1.0 / 479001600.0; cn = cn * a2 - 1.0 / 3628800.0; cn = cn * a2 + 1.0 / 40320.0; cn = cn * a2 - 1.0 / 720.0; cn = cn * a2 + 1.0 / 24.0; cn = cn * a2 - 0.5; cn = cn * a2 + 1.0;
    double c, s;
    if (q == 0) { c = cn; s = sn; } else if (q == 1) { c = -sn; s = cn; } else if (q == 2) { c = -cn; s = -sn; } else { c = sn; s = -cn; }
    p.cs[(size_t)token * 16 + f] = (float)c;
    p.cs[(size_t)token * 16 + 8 + f] = (float)s;
  }
  {
    f32x4 nv[2]; float ng[2]; bf16_t* ndst = nullptr;
    auto fetch = [&](int t) {
      int ct = t >> 4; const int k0 = (t & 15) * 64;
      int si = 0;
      while (ct >= (p.seg[si].ncols >> 6)) { ct -= (p.seg[si].ncols >> 6); ++si; }
      const Seg sg = p.seg[si];
      const int n0 = ct * 64;
#pragma unroll
      for (int j = 0; j < 2; ++j) {
        const int i = tid + NT * j, kr = i >> 4, c4 = i & 15;
        nv[j] = *(const f32x4*)(sg.src + (size_t)(k0 + kr) * sg.ld + sg.col0 + n0 + c4 * 4);
        ng[j] = sg.gain ? sg.gain[k0 + kr] : 1.f;
      }
      ndst = sg.dst + (size_t)(n0 + (tid >> 3)) * DM + k0 + (tid & 7) * 8;
    };
    if (bid < 2560) fetch(bid);
    for (int t = bid; t < 2560; t += nb) {
      const f32x4 v0 = nv[0], v1 = nv[1]; const float g0 = ng[0], g1 = ng[1]; bf16_t* dst = ndst;
      if (t + nb < 2560) fetch(t + nb);
      __syncthreads();
      {
        const int kr = tid >> 4, c4 = tid & 15;
        smem[(c4 * 4 + 0) * 72 + kr] = f2bf(v0.x * g0); smem[(c4 * 4 + 1) * 72 + kr] = f2bf(v0.y * g0);
        smem[(c4 * 4 + 2) * 72 + kr] = f2bf(v0.z * g0); smem[(c4 * 4 + 3) * 72 + kr] = f2bf(v0.w * g0);
        smem[(c4 * 4 + 0) * 72 + kr + 32] = f2bf(v1.x * g1); smem[(c4 * 4 + 1) * 72 + kr + 32] = f2bf(v1.y * g1);
        smem[(c4 * 4 + 2) * 72 + kr + 32] = f2bf(v1.z * g1); smem[(c4 * 4 + 3) * 72 + kr + 32] = f2bf(v1.w * g1);
      }
      __syncthreads();
      *(u32x4*)dst = *(const u32x4*)(smem + (tid >> 3) * 72 + (tid & 7) * 8);
    }
  }
  __syncthreads();
}

template <int MT>
DI void gemm_core(const bf16_t* __restrict__ Wt, const bf16_t* __restrict__ X, int n0, int m0, f32x16 (&acc)[2][MT], bf16_t* smem) {
  const int tid = opaque_tid(), lane = tid & 63, wid = tid >> 6, wn = wid >> 1, wm = wid & 1, r = lane & 31, h = lane >> 5;
  bf16_t* Ws = smem;
  bf16_t* Xs = smem + 2 * 256 * 72;
  const char* wub = (const char*)(Wt + (size_t)n0 * DM);
  const char* xub = (const char*)(X + (size_t)m0 * DM);
  const unsigned voff = (unsigned)(((tid >> 3) * DM + (tid & 7) * 8) * 2);
#define GLD_W(i, k) (*(const u32x4*)(wub + ((size_t)(i) * 64 * DM * 2 + (size_t)(k) * 128) + voff))
#define GLD_X(i, k) (*(const u32x4*)(xub + ((size_t)(i) * 64 * DM * 2 + (size_t)(k) * 128) + voff))
  const int so = (tid >> 3) * 72 + (tid & 7) * 8;
  u32x4 wr[4], xr[MT];
#pragma unroll
  for (int i = 0; i < 4; ++i) wr[i] = GLD_W(i, 0);
#pragma unroll
  for (int i = 0; i < MT; ++i) xr[i] = GLD_X(i, 0);
  __syncthreads();
#pragma unroll
  for (int i = 0; i < 4; ++i) *(u32x4*)(Ws + so + i * 64 * 72) = wr[i];
#pragma unroll
  for (int i = 0; i < MT; ++i) *(u32x4*)(Xs + so + i * 64 * 72) = xr[i];
#pragma unroll
  for (int i = 0; i < 4; ++i) wr[i] = GLD_W(i, 1);
#pragma unroll
  for (int i = 0; i < MT; ++i) xr[i] = GLD_X(i, 1);
  __syncthreads();
  const int ao = (wn * 64 + r) * 72 + h * 8, bo = (wm * (MT * 32) + r) * 72 + h * 8;
  for (int kt = 0; kt < 16; ++kt) {
    const int cur = (kt & 1) * 256 * 72, nxt = ((kt + 1) & 1) * 256 * 72;
#pragma unroll
    for (int s = 0; s < 4; ++s) {
      bf16x8 a[2], b[MT];
#pragma unroll
      for (int nt = 0; nt < 2; ++nt) a[nt] = *(const bf16x8*)(Ws + cur + ao + nt * 32 * 72 + s * 16);
#pragma unroll
      for (int mt = 0; mt < MT; ++mt) b[mt] = *(const bf16x8*)(Xs + cur + bo + mt * 32 * 72 + s * 16);
      if (kt + 1 < 16) {
        *(u32x4*)(Ws + nxt + so + s * 64 * 72) = wr[s];
        if (s < MT) *(u32x4*)(Xs + nxt + so + s * 64 * 72) = xr[s < MT ? s : 0];
        if (kt + 2 < 16) {
          wr[s] = GLD_W(s, kt + 2);
          if (s < MT) xr[s < MT ? s : 0] = GLD_X(s, kt + 2);
        }
      }
#pragma unroll
      for (int nt = 0; nt < 2; ++nt)
#pragma unroll
        for (int mt = 0; mt < MT; ++mt) acc[nt][mt] = MFMA32(a[nt], b[mt], acc[nt][mt]);
    }
    __syncthreads();
  }
}

DI float row_rinv(const float* ssq, int token) {
  const f32x4* q = (const f32x4*)(ssq + (size_t)token * 16);
  const f32x4 a = q[0], b = q[1], c = q[2], d = q[3];
  const float s = ((a.x + a.y) + (a.z + a.w)) + ((b.x + b.y) + (b.z + b.w)) + ((c.x + c.y) + (c.z + c.w)) + ((d.x + d.y) + (d.z + d.w));
  return rsqrtf(s * (1.f / 1024.f) + EPS);
}

enum { EK_QKROPE = 0, EK_NORM = 1, EK_PLAIN = 2, EK_VT = 3, EK_SILU = 4, EK_VBLK = 5 };

template <int MT>
DI void epi_proj(const f32x16 (&acc)[2][MT], int kind, const float* __restrict__ ssq0, const float* __restrict__ gain, const float* __restrict__ cs0,
                 bf16_t* __restrict__ dbase, int ld, bf16_t* __restrict__ vbase, int vt_ld, bf16_t* smem, float qscale) {
  const int tid = opaque_tid(), lane = tid & 63, wid = tid >> 6, r = lane & 31, h = lane >> 5;
  bf16_t* wreg = smem + wid * 9216;
#pragma unroll
  for (int mt = 0; mt < MT; ++mt) {
    const float rs = row_rinv(ssq0, mt * 32);
    float v[2][16];
#pragma unroll
    for (int nt = 0; nt < 2; ++nt)
#pragma unroll
      for (int i = 0; i < 16; ++i) v[nt][i] = acc[nt][mt][i] * rs;
    if (kind <= EK_NORM) {
      float ss = 0.f;
#pragma unroll
      for (int nt = 0; nt < 2; ++nt)
#pragma unroll
        for (int i = 0; i < 16; ++i) ss += v[nt][i] * v[nt][i];
      ss += __shfl_xor(ss, 32);
      const float rn = rsqrtf(ss * (1.f / 64.f) + EPS);
#pragma unroll
      for (int nt = 0; nt < 2; ++nt)
#pragma unroll
        for (int g = 0; g < 4; ++g) {
          const f32x4 gg = *(const f32x4*)(gain + nt * 32 + 8 * g + 4 * h);
          v[nt][4 * g + 0] *= rn * gg.x; v[nt][4 * g + 1] *= rn * gg.y; v[nt][4 * g + 2] *= rn * gg.z; v[nt][4 * g + 3] *= rn * gg.w;
        }
      if (kind == EK_QKROPE) {
        const f32x4 c = *(const f32x4*)(cs0 + mt * 32 * 16 + 4 * h);
        const f32x4 s = *(const f32x4*)(cs0 + mt * 32 * 16 + 8 + 4 * h);
#pragma unroll
        for (int i = 0; i < 4; ++i) {
          const float x1 = v[0][i], x2 = v[0][4 + i];
          v[0][i] = x1 * c[i] - x2 * s[i];
          v[0][4 + i] = x2 * c[i] + x1 * s[i];
        }
#pragma unroll
        for (int nt = 0; nt < 2; ++nt)
#pragma unroll
          for (int i = 0; i < 16; ++i) v[nt][i] *= qscale;
      }
    } else if (kind == EK_PLAIN) {
#pragma unroll
      for (int nt = 0; nt < 2; ++nt)
#pragma unroll
        for (int i = 0; i < 16; ++i) v[nt][i] *= qscale;
    } else if (kind == EK_SILU) {
#pragma unroll
      for (int nt = 0; nt < 2; ++nt)
#pragma unroll
        for (int i = 0; i < 16; ++i) v[nt][i] = v[nt][i] * __builtin_amdgcn_rcpf(1.f + __builtin_amdgcn_exp2f(-1.4426950408889634f * v[nt][i]));
    }
    if (kind == EK_VT || kind == EK_VBLK) {
#pragma unroll
      for (int nt = 0; nt < 2; ++nt)
#pragma unroll
        for (int i = 0; i < 16; ++i) wreg[(nt * 32 + crow(i, h)) * 136 + mt * 32 + (r & 16) + perm16(r & 15)] = f2bf(v[nt][i]);
    } else {
#pragma unroll
      for (int nt = 0; nt < 2; ++nt)
#pragma unroll
        for (int g = 0; g < 4; ++g) {
          u32x2 w; w.x = pk2(v[nt][4 * g], v[nt][4 * g + 1]); w.y = pk2(v[nt][4 * g + 2], v[nt][4 * g + 3]);
          *(u32x2*)(wreg + (mt * 32 + r) * 72 + nt * 32 + 8 * g + 4 * h) = w;
        }
    }
  }
  __syncthreads();
  constexpr int CPR = MT * 4, RPI = 64 / CPR;
  if (kind == EK_VT) {
#pragma unroll
    for (int j = 0; j < CPR; ++j) {
      const int n = j * RPI + lane / CPR, c = lane % CPR;
      *(u32x4*)(vbase + (size_t)n * vt_ld + c * 8) = *(const u32x4*)(wreg + n * 136 + c * 8);
    }
  } else if (kind == EK_VBLK) {
#pragma unroll
    for (int j = 0; j < CPR; ++j) {
      const int n = j * RPI + lane / CPR, c = lane % CPR;
      *(u32x4*)(vbase + (size_t)(c >> 2) * 2048 + n * 32 + (c & 3) * 8) = *(const u32x4*)(wreg + n * 136 + c * 8);
    }
  } else {
#pragma unroll
    for (int j = 0; j < MT * 4; ++j) {
      const int row = j * 8 + (lane >> 3), c = lane & 7;
      *(u32x4*)(dbase + (size_t)row * ld + c * 8) = *(const u32x4*)(wreg + row * 72 + c * 8);
    }
  }
}

template <int MT>
DI void zero_acc(f32x16 (&acc)[2][MT]) {
#pragma unroll
  for (int a = 0; a < 2; ++a)
#pragma unroll
    for (int b = 0; b < MT; ++b) acc[a][b] = zero16();
}

template <int MT>
__device__ void proj_tile(const Params& p, int layer, int m0, int nti, bf16_t* smem) {
  const int tid = opaque_tid(), lane = tid & 63, wid = tid >> 6, wn = wid >> 1, wm = wid & 1, r = lane & 31, h = lane >> 5;
  const int n0 = nti * 256;
  f32x16 acc[2][MT];
  zero_acc<MT>(acc);
  gemm_core<MT>(layer ? p.W3t : p.W1t, p.xb, n0, m0, acc, smem);
  const float* ssq = layer ? p.ssq1 : p.ssq0;
  const int tok = m0 + wm * (MT * 32) + r;
  const int cc = n0 + wn * 64;
  int kind; const float* gain = p.a_q_norm;
  if (cc < 1536) { kind = layer ? EK_PLAIN : EK_QKROPE; gain = (cc < 768) ? p.a_q_norm : p.a_k_norm; }
  else if (cc < 2304) kind = EK_VT;
  else if (cc < 2560) { kind = EK_NORM; gain = p.mem_q_norm + layer * 64; }
  else kind = EK_SILU;
  const int tok0 = m0 + wm * (MT * 32), b = tok0 >> 13;
  bf16_t* vtb = p.Vt + ((size_t)b * 768 + (cc - 1536)) * SEQ + (tok0 & (SEQ - 1));
  bf16_t* dbase = p.P + (size_t)tok0 * NP + cc;
  int ld = NP;
  if (layer && cc >= 768 && cc < 1536) {
    dbase = p.Ksb + (((size_t)b * 12 + ((cc - 768) >> 6)) * SEQ + (tok0 & (SEQ - 1))) * 64; ld = 64;
  } else if (layer && kind == EK_VT) {
    kind = EK_VBLK;
    vtb = p.Vt + (((size_t)b * 12 + ((cc - 1536) >> 6)) * 256 + ((tok0 & (SEQ - 1)) >> 5)) * 2048;
  }
  epi_proj<MT>(acc, kind, ssq + (size_t)tok * 16, gain, p.cs + (size_t)tok * 16, dbase, ld, vtb, SEQ, smem, (cc < 768) ? 0.125f * 1.4426950408889634f : 1.f);
}

__device__ void mem_tile(const Params& p, int l, int mti, int nti, bf16_t* smem) {
  const int tid = opaque_tid(), lane = tid & 63, wid = tid >> 6, wn = wid >> 1, wm = wid & 1, r = lane & 31, h = lane >> 5;
  const int m0 = mti * 256, n0 = nti * 256;
  f32x16 acc[2][4];
  zero_acc<4>(acc);
  gemm_core<4>(p.Wmt + (size_t)l * 512 * DM, p.memb, n0, m0, acc, smem);
  const int tok = m0 + wm * 128 + r;
  const int cc = n0 + wn * 64;
  const int kind = (cc < 256) ? EK_NORM : EK_VT;
  const int tok0 = m0 + wm * 128, b = tok0 >> 8;
  bf16_t* vtb = p.Vmt + ((size_t)(l * 2 + b) * 256 + (cc - 256)) * 256 + (tok0 & 255);
  epi_proj<4>(acc, kind, p.ssqm + (size_t)tok * 16, p.mem_k_norm + l * 64, p.cs, p.Km + ((size_t)l * 512 + tok0) * 256 + cc, 256, vtb, 256, smem, 1.f);
}

__device__ void out_tile(const Params& p, const bf16_t* Wt, bool first, int mti, int nti, bf16_t* smem) {
  const int tid = opaque_tid(), lane = tid & 63, wid = tid >> 6, wn = wid >> 1, wm = wid & 1, r = lane & 31, h = lane >> 5;
  const int m0 = mti * 256, n0 = nti * 256;
  f32x16 acc[2][4];
  zero_acc<4>(acc);
  gemm_core<4>(Wt, p.y, n0, m0, acc, smem);
  const int cc = n0 + wn * 64;
  float* freg = (float*)smem + wid * 4608;
#pragma unroll
  for (int half = 0; half < 2; ++half) {
#pragma unroll
    for (int mtl = 0; mtl < 2; ++mtl)
#pragma unroll
      for (int nt = 0; nt < 2; ++nt)
#pragma unroll
        for (int g = 0; g < 4; ++g) {
          f32x4 o; o.x = acc[nt][half * 2 + mtl][4 * g + 0]; o.y = acc[nt][half * 2 + mtl][4 * g + 1]; o.z = acc[nt][half * 2 + mtl][4 * g + 2]; o.w = acc[nt][half * 2 + mtl][4 * g + 3];
          *(f32x4*)(freg + (mtl * 32 + r) * 68 + nt * 32 + 8 * g + 4 * h) = o;
        }
    __syncthreads();
#pragma unroll
    for (int j = 0; j < 16; ++j) {
      const int row = j * 4 + (lane >> 4), c = lane & 15;
      const int tok = m0 + wm * 128 + half * 64 + row;
      const size_t off = (size_t)tok * DM + cc + c * 4;
      const f32x4 a = *(const f32x4*)(freg + row * 68 + c * 4);
      f32x4 o;
      if (first) {
        o = *(const f32x4*)(p.x + off);
        o.x += a.x; o.y += a.y; o.z += a.z; o.w += a.w;
        u32x2 w; w.x = pk2(o.x, o.y); w.y = pk2(o.z, o.w);
        *(u32x2*)(p.xb + off) = w;
        float ss = o.x * o.x + o.y * o.y + o.z * o.z + o.w * o.w;
        ss += __shfl_xor(ss, 1); ss += __shfl_xor(ss, 2); ss += __shfl_xor(ss, 4); ss += __shfl_xor(ss, 8);
        if (c == 0) p.ssq1[(size_t)tok * 16 + (cc >> 6)] = ss;
      } else {
        const u32x2 w = *(const u32x2*)(p.xb + off);
        o.x = bflo(w.x) + a.x; o.y = bfhi(w.x) + a.y; o.z = bflo(w.y) + a.z; o.w = bfhi(w.y) + a.w;
        *(f32x4*)(p.out + off) = o;
      }
      if ((j & 3) == 3) __builtin_amdgcn_sched_barrier(0);
    }
    __syncthreads();
  }
}

template <int NDT>
DI void store_gated(const f32x16 (&O)[NDT], float* reg, const bf16_t* __restrict__ grow0, bf16_t* __restrict__ yrow0, const float* __restrict__ gain, int lane) {
  constexpr int RS = NDT * 32 + 4, LPR = NDT * 8, RPI = 64 / LPR;
  const int r = lane & 31, h = lane >> 5;
#pragma unroll
  for (int dvt = 0; dvt < NDT; ++dvt)
#pragma unroll
    for (int g = 0; g < 4; ++g) {
      f32x4 o; o.x = O[dvt][4 * g + 0]; o.y = O[dvt][4 * g + 1]; o.z = O[dvt][4 * g + 2]; o.w = O[dvt][4 * g + 3];
      *(f32x4*)(reg + r * RS + dvt * 32 + 8 * g + 4 * h) = o;
    }
  asm volatile("s_waitcnt lgkmcnt(0)" ::: "memory");
  const int c = lane % LPR;
  f32x4 gg; gg.x = 1.f; gg.y = 1.f; gg.z = 1.f; gg.w = 1.f;
  if (gain) gg = *(const f32x4*)(gain + c * 4);
#pragma unroll
  for (int j = 0; j < 32 / RPI; ++j) {
    const int row = j * RPI + lane / LPR;
    const f32x4 v = *(const f32x4*)(reg + row * RS + c * 4);
    const u32x2 gw = *(const u32x2*)(grow0 + (size_t)row * NP + c * 4);
    u32x2 w;
    w.x = pk2(v.x * gg.x * bflo(gw.x), v.y * gg.y * bfhi(gw.x));
    w.y = pk2(v.z * gg.z * bflo(gw.y), v.w * gg.w * bfhi(gw.y));
    *(u32x2*)(yrow0 + (size_t)row * DM + c * 4) = w;
  }
  asm volatile("s_waitcnt lgkmcnt(0)" ::: "memory");
}

__device__ void attn_a_unit(const Params& p, int b, int hd, int qb, bf16_t* smem, float lam, float msh) {
  const int tid = opaque_tid(), lane = tid & 63, wid = tid >> 6, r = lane & 31, h = lane >> 5, grp = wid >> 2, wq = wid & 3;
  const bf16_t* Pb = p.P + (size_t)b * SEQ * NP;
  const bf16_t* Vb = p.Vt + ((size_t)b * 768 + hd * 128) * SEQ;
  const int q0 = qb * 128 + wq * 32;
  bf16x8 qf[4];
#pragma unroll
  for (int s = 0; s < 4; ++s) qf[s] = *(const bf16x8*)(Pb + (size_t)(q0 + r) * NP + grp * 384 + hd * 64 + s * 16 + h * 8);
  f32x16 O[4];
#pragma unroll
  for (int i = 0; i < 4; ++i) O[i] = zero16();
  float l = 0.f;
  const int nkt = 2 * (qb + 1);
  constexpr int VOFF = 9216, SSTR = 18432;
  const char* kub = (const char*)(Pb + 768 + hd * 64);
  const char* vub = (const char*)Vb;
  const unsigned kvo = (unsigned)(((tid >> 3) * NP + (tid & 7) * 8) * 2);
  const unsigned vvo = (unsigned)(((tid >> 3) * SEQ + (tid & 7) * 8) * 2);
#define GLD_K(i, t) (*(const u32x4*)(kub + ((size_t)(t) * 64 * NP * 2 + (size_t)(i) * 768) + kvo))
#define GLD_V(i, t) (*(const u32x4*)(vub + ((size_t)(i) * 64 * SEQ * 2 + (size_t)(t) * 128) + vvo))
  const int kso = (tid >> 3) * 72 + (tid & 7) * 8;
  const int vso = VOFF + (tid >> 3) * 72 + (tid & 7) * 8;
  const int kro = grp * 64 * 72 + r * 72 + h * 8;
  const int vro = VOFF + r * 72 + 8 * h;
  u32x4 kr[2], vr[2];
#pragma unroll
  for (int i = 0; i < 2; ++i) { kr[i] = GLD_K(i, 0); vr[i] = GLD_V(i, 0); }
#pragma unroll
  for (int i = 0; i < 2; ++i) {
    *(u32x4*)(smem + kso + i * 64 * 72) = kr[i];
    *(u32x4*)(smem + vso + i * 64 * 72) = vr[i];
  }
#pragma unroll
  for (int i = 0; i < 2; ++i) { kr[i] = GLD_K(i, 1); vr[i] = GLD_V(i, 1); }
  __syncthreads();
  for (int kt = 0; kt < nkt; ++kt) {
    const int cur = (kt & 1) * SSTR, nxt = ((kt + 1) & 1) * SSTR;
    if (kt + 1 < nkt) {
#pragma unroll
      for (int i = 0; i < 2; ++i) {
        *(u32x4*)(smem + nxt + kso + i * 64 * 72) = kr[i];
        *(u32x4*)(smem + nxt + vso + i * 64 * 72) = vr[i];
      }
      if (kt + 2 < nkt) {
#pragma unroll
        for (int i = 0; i < 2; ++i) { kr[i] = GLD_K(i, kt + 2); vr[i] = GLD_V(i, kt + 2); }
      }
    }
    const int k0 = kt * 64;
    if (k0 <= q0 + 31) {
      bf16x8 kfr[8], vfa[8], vfb[8];
#pragma unroll
      for (int s = 0; s < 8; ++s) kfr[s] = *(const bf16x8*)(smem + cur + kro + (s >> 2) * 32 * 72 + (s & 3) * 16);
      __builtin_amdgcn_sched_barrier(0);
      f32x16 S0 = zero16(), S1 = zero16();
#pragma unroll
      for (int s = 0; s < 4; ++s) S0 = MFMA32(kfr[s], qf[s], S0);
#pragma unroll
      for (int s = 0; s < 8; ++s) vfa[s] = *(const bf16x8*)(smem + cur + vro + (s >> 1) * 32 * 72 + (s & 1) * 16);
#pragma unroll
      for (int s = 0; s < 4; ++s) S1 = MFMA32(kfr[4 + s], qf[s], S1);
      __builtin_amdgcn_sched_barrier(0);
      const int dq = q0 + r - k0 - 4 * h;
      float pv[16]; bf16x8 pk[2];
#pragma unroll
      for (int s = 0; s < 8; ++s) vfb[s] = *(const bf16x8*)(smem + cur + vro + (s >> 1) * 32 * 72 + 32 + (s & 1) * 16);
#pragma unroll
      for (int i = 0; i < 16; ++i) pv[i] = __builtin_amdgcn_exp2f(S0[i]);
      if (k0 + 31 > q0) {
#pragma unroll
        for (int i = 0; i < 16; ++i) if ((i & 3) + 8 * (i >> 2) > dq) pv[i] = 0.f;
      }
#pragma unroll
      for (int i = 0; i < 16; ++i) l += pv[i];
      pk[0] = pack8(pv); pk[1] = pack8(pv + 8);
      __builtin_amdgcn_sched_barrier(0);
#pragma unroll
      for (int s = 0; s < 8; ++s) O[s >> 1] = MFMA32(vfa[s], pk[s & 1], O[s >> 1]);
#pragma unroll
      for (int i = 0; i < 16; ++i) pv[i] = __builtin_amdgcn_exp2f(S1[i]);
      if (k0 + 63 > q0) {
#pragma unroll
        for (int i = 0; i < 16; ++i) if (32 + (i & 3) + 8 * (i >> 2) > dq) pv[i] = 0.f;
      }
#pragma unroll
      for (int i = 0; i < 16; ++i) l += pv[i];
      bf16x8 pq[2]; pq[0] = pack8(pv); pq[1] = pack8(pv + 8);
      __builtin_amdgcn_sched_barrier(0);
#pragma unroll
      for (int s = 0; s < 8; ++s) O[s >> 1] = MFMA32(vfb[s], pq[s & 1], O[s >> 1]);
    }
    __syncthreads();
  }
  l += __shfl_xor(l, 32);
  float* xch = (float*)smem + (size_t)wq * 65 * 64 + lane;
  if (grp == 1) {
#pragma unroll
    for (int dvt = 0; dvt < 4; ++dvt)
#pragma unroll
      for (int i = 0; i < 16; ++i) xch[(dvt * 16 + i) * 64] = O[dvt][i];
    xch[64 * 64] = l;
  }
  __syncthreads();
  if (grp == 0) {
    const float i1 = 1.f / l, i2 = lam / xch[64 * 64];
    float ss = 0.f;
#pragma unroll
    for (int dvt = 0; dvt < 4; ++dvt)
#pragma unroll
      for (int i = 0; i < 16; ++i) { const float o = O[dvt][i] * i1 - xch[(dvt * 16 + i) * 64] * i2; O[dvt][i] = o; ss += o * o; }
    ss += __shfl_xor(ss, 32);
    const float rn = rsqrtf(ss * (1.f / 128.f) + EPS) * 0.8f;
#pragma unroll
    for (int dvt = 0; dvt < 4; ++dvt)
#pragma unroll
      for (int i = 0; i < 16; ++i) O[dvt][i] *= rn;
    const size_t tok0 = (size_t)b * SEQ + q0;
    store_gated<4>(O, (float*)smem + 16640 + wq * 4352, p.P + tok0 * NP + 2560 + hd * 128, p.y + tok0 * DM + hd * 128, p.a_subln, lane);
  }
}

__device__ void mem_wave(const Params& p, int l, int b, int mh, int q0, float sc2, float msh, bf16_t* smem) {
  const int tid = opaque_tid(), lane = tid & 63, r = lane & 31, h = lane >> 5;
  const size_t tok = (size_t)b * SEQ + q0 + r;
  const bf16_t* prow = p.P + tok * NP;
  bf16x8 qf[4];
#pragma unroll
  for (int s = 0; s < 4; ++s) qf[s] = *(const bf16x8*)(prow + 2304 + mh * 64 + s * 16 + h * 8);
  const bf16_t* Kl = p.Km + ((size_t)(l * 2 + b) * 256 + r) * 256 + mh * 64 + h * 8;
  const bf16_t* Vl = p.Vmt + ((size_t)(l * 2 + b) * 256 + mh * 64 + r) * 256 + 8 * h;
  f32x16 O[2]; O[0] = zero16(); O[1] = zero16();
  float lsum = 0.f;
  bf16x8 kf[4], vf[4], kn[4], vn[4];
#pragma unroll
  for (int s = 0; s < 4; ++s) { kf[s] = *(const bf16x8*)(Kl + s * 16); vf[s] = *(const bf16x8*)(Vl + (s >> 1) * 32 * 256 + (s & 1) * 16); }
#pragma unroll
  for (int s = 0; s < 4; ++s) { kn[s] = kf[s]; vn[s] = vf[s]; }
  for (int kt = 0; kt < 8; ++kt) {
    if (kt + 1 < 8) {
      const int k1 = (kt + 1) * 32;
#pragma unroll
      for (int s = 0; s < 4; ++s) { kn[s] = *(const bf16x8*)(Kl + (size_t)k1 * 256 + s * 16); vn[s] = *(const bf16x8*)(Vl + (s >> 1) * 32 * 256 + k1 + (s & 1) * 16); }
    }
    __builtin_amdgcn_sched_barrier(0);
    f32x16 S = zero16();
#pragma unroll
    for (int s = 0; s < 4; ++s) S = MFMA32(kf[s], qf[s], S);
    float pv[16];
#pragma unroll
    for (int i = 0; i < 16; ++i) { pv[i] = __builtin_amdgcn_exp2f(S[i] * sc2 - msh); lsum += pv[i]; }
    bf16x8 pk[2]; pk[0] = pack8(pv); pk[1] = pack8(pv + 8);
#pragma unroll
    for (int s = 0; s < 4; ++s) O[s >> 1] = MFMA32(vf[s], pk[s & 1], O[s >> 1]);
#pragma unroll
    for (int s = 0; s < 4; ++s) { kf[s] = kn[s]; vf[s] = vn[s]; }
  }
  lsum += __shfl_xor(lsum, 32);
  const float inv = __builtin_amdgcn_rcpf(lsum);
#pragma unroll
  for (int dvt = 0; dvt < 2; ++dvt)
#pragma unroll
    for (int i = 0; i < 16; ++i) O[dvt][i] *= inv;
  store_gated<2>(O, (float*)smem + (tid >> 6) * 4608, prow - (size_t)r * NP + 2560 + 768 + mh * 64, p.y + (tok - r) * DM + 768 + mh * 64, nullptr, lane);
}

__device__ void sb_wave(const Params& p, int b, int hd, int q0, bf16_t* smem) {
  const int tid = opaque_tid(), lane = tid & 63, r = lane & 31, h = lane >> 5;
  const bf16_t* Pb = p.P + (size_t)b * SEQ * NP;
  const bf16_t* Kl = p.Ksb + (((size_t)b * 12 + hd) * SEQ + r) * 64 + h * 8;
  const bf16_t* Vl = p.Vt + ((size_t)b * 12 + hd) * 256 * 2048 + r * 32 + 8 * h;
  const size_t tok = (size_t)b * SEQ + q0 + r;
  bf16x8 qf[4];
#pragma unroll
  for (int s = 0; s < 4; ++s) qf[s] = *(const bf16x8*)(Pb + (size_t)(q0 + r) * NP + hd * 64 + s * 16 + h * 8);
  f32x16 O[2]; O[0] = zero16(); O[1] = zero16();
  float R = 0.f;
  const int ktd = q0 >> 5;
  bf16x8 kf[4], kn[4], vf[4], vn[4];
#pragma unroll
  for (int s = 0; s < 4; ++s) {
    kf[s] = *(const bf16x8*)(Kl + (size_t)q0 * 64 + s * 16); kn[s] = kf[s];
    vf[s] = *(const bf16x8*)(Vl + (size_t)ktd * 2048 + (s >> 1) * 32 * 32 + (s & 1) * 16); vn[s] = vf[s];
  }
  for (int kt = ktd; kt >= 0; --kt) {
    const int k0 = kt * 32;
    const bool diag = (kt == ktd);
    if (kt > 0) {
#pragma unroll
      for (int s = 0; s < 4; ++s) {
        kn[s] = *(const bf16x8*)(Kl + (size_t)(k0 - 32) * 64 + s * 16);
        vn[s] = *(const bf16x8*)(Vl + (size_t)(kt - 1) * 2048 + (s >> 1) * 32 * 32 + (s & 1) * 16);
      }
    }
    __builtin_amdgcn_sched_barrier(0);
    f32x16 S = zero16();
#pragma unroll
    for (int s = 0; s < 4; ++s) S = MFMA32(kf[s], qf[s], S);
    float lb[16], f[16];
#pragma unroll
    for (int i = 0; i < 16; ++i) {
      const float z = S[i];
      const float L = __builtin_amdgcn_logf(1.f + __builtin_amdgcn_exp2f(-fabsf(z)));
      const float lbv = fminf(z, 0.f) - L;
      lb[i] = lbv; f[i] = lbv - z;
    }
    if (diag) {
#pragma unroll
      for (int i = 0; i < 16; ++i) if (crow(i, h) >= r) f[i] = 0.f;
    }
    float T[4], PT[4], loc[16];
#pragma unroll
    for (int g = 0; g < 4; ++g) {
      loc[4 * g + 3] = 0.f;
      loc[4 * g + 2] = f[4 * g + 3];
      loc[4 * g + 1] = loc[4 * g + 2] + f[4 * g + 2];
      loc[4 * g + 0] = loc[4 * g + 1] + f[4 * g + 1];
      T[g] = loc[4 * g + 0] + f[4 * g + 0];
    }
#pragma unroll
    for (int g = 0; g < 4; ++g) PT[g] = xhalf(T[g], h);
    float hg = R;
    float av[16];
#pragma unroll
    for (int g = 3; g >= 0; --g) {
      const float base = hg + (h == 0 ? PT[g] : 0.f);
#pragma unroll
      for (int i = 0; i < 4; ++i) av[4 * g + i] = __builtin_amdgcn_exp2f(lb[4 * g + i] + (base + loc[4 * g + i]));
      hg += T[g] + PT[g];
    }
    if (diag) {
#pragma unroll
      for (int i = 0; i < 16; ++i) if (crow(i, h) >= r) av[i] = 0.f;
    }
    R = hg;
    bf16x8 pk[2]; pk[0] = pack8(av); pk[1] = pack8(av + 8);
#pragma unroll
    for (int s = 0; s < 4; ++s) O[s >> 1] = MFMA32(vf[s], pk[s & 1], O[s >> 1]);
#pragma unroll
    for (int s = 0; s < 4; ++s) { kf[s] = kn[s]; vf[s] = vn[s]; }
    if (__all(R < -104.f * 1.4426950408889634f)) break;
  }
  store_gated<2>(O, (float*)smem + (tid >> 6) * 4608, p.P + (tok - r) * NP + 2560 + hd * 64, p.y + (tok - r) * DM + hd * 64, nullptr, lane);
}

DI float wave_sum(float v) { for (int o = 32; o > 0; o >>= 1) v += __shfl_xor(v, o); return v; }
DI float wave_max(float v) { for (int o = 32; o > 0; o >>= 1) v = fmaxf(v, __shfl_xor(v, o)); return v; }

DI bool gemm_sched(int rd, int ntn, int& mti, int& nti) {
  const int nb = gridDim.x, bid = blockIdx.x;
  if (nb == 256) {
    const int xcd = bid & 7, li = bid >> 3, ti = rd * 32 + li;
    if (ti >= 8 * ntn) return false;
    mti = xcd * 8 + (ti & 7); nti = ti >> 3; return true;
  }
  const int t = rd * nb + bid;
  if (t >= 64 * ntn) return false;
  mti = t / ntn; nti = t % ntn; return true;
}

DI void proj_phase(const Params& p, int layer, bf16_t* smem) {
  const int nb = gridDim.x, bid = blockIdx.x;
  if (nb == 256) {
    const int xcd = bid & 7, li = bid >> 3;
    for (int rd = 0; rd < 3; ++rd) { const int ti = rd * 32 + li; proj_tile<4>(p, layer, (xcd * 8 + (ti & 7)) * 256, ti >> 3, smem); }
    { const int ti = 96 + (li >> 1); proj_tile<2>(p, layer, (xcd * 8 + (ti & 7)) * 256 + (li & 1) * 128, ti >> 3, smem); }
  } else {
    for (int t = bid; t < 64 * 14; t += nb) proj_tile<4>(p, layer, (t / 14) * 256, t % 14, smem);
  }
}

DI void grid_barrier(unsigned* bar, unsigned& target) {
  asm volatile("s_waitcnt vmcnt(0)" ::: "memory");
  __syncthreads();
  if (threadIdx.x == 0) {
    __builtin_amdgcn_fence(__ATOMIC_RELEASE, "agent");
    asm volatile("s_waitcnt vmcnt(0)" ::: "memory");
    (void)__hip_atomic_fetch_add(bar, 1u, __ATOMIC_RELAXED, __HIP_MEMORY_SCOPE_AGENT);
    target += gridDim.x;
    while ((int)(__hip_atomic_load(bar, __ATOMIC_RELAXED, __HIP_MEMORY_SCOPE_AGENT) - target) < 0) __builtin_amdgcn_s_sleep(1);
    __builtin_amdgcn_fence(__ATOMIC_ACQUIRE, "agent");
    asm volatile("s_waitcnt vmcnt(0)" ::: "memory");
  }
  __syncthreads();
}

__global__ void __launch_bounds__(512, 2) yoco_fwd(Params p) {
  extern __shared__ __attribute__((aligned(16))) bf16_t smem[];
  cg::grid_group grid = cg::this_grid();
  const int tid = threadIdx.x, lane = tid & 63, wid = tid >> 6, nb = gridDim.x, bid = blockIdx.x, grp = wid >> 2, wq = wid & 3;
  int* s_unit = (int*)(smem + LDS_ELEMS);
  const float LOG2E = 1.4426950408889634f;
  unsigned* bar = (unsigned*)(p.ctr + 64);
  unsigned btarget = 0;
  if (tid == 0) btarget = __hip_atomic_load(bar + 64, __ATOMIC_RELAXED, __HIP_MEMORY_SCOPE_AGENT);
  if (bid == 0 && tid < 64) p.ctr[tid] = 0;
  if (p.out == nullptr) grid.sync();

  phase0(p, smem);
  grid_barrier(bar, btarget);

  proj_phase(p, 0, smem);
  grid_barrier(bar, btarget);

  {
    const float d1 = wave_sum(p.lq1[lane] * p.lk1[lane]), d2 = wave_sum(p.lq2[lane] * p.lk2[lane]);
    const float lam = __expf(d1) - __expf(d2) + 0.2f;
    const float mqa = wave_max(fabsf(p.a_q_norm[lane])), mka = wave_max(fabsf(p.a_k_norm[lane]));
    const float mqm = wave_max(fabsf(p.mem_q_norm[lane])), mkm = wave_max(fabsf(p.mem_k_norm[lane]));
    const float sc2 = 0.125f * LOG2E;
    const float msh_a = 8.f * mqa * mka * LOG2E, msh_m = 8.f * mqm * mkm * LOG2E;
    unsigned* kvflag = (unsigned*)(p.ctr + 16);
    bool memkv_ready = false;
    const int xq = bid & 7;
    for (;;) {
      __syncthreads();
      if (tid == 0) *s_unit = atomicAdd(&p.ctr[40 + xq], 1);
      __syncthreads();
      const int u = *s_unit;
      if (u >= 1 + 96 + 32) break;
      if (u == 0) {
        mem_tile(p, xq >> 2, (xq >> 1) & 1, xq & 1, smem);
        if (xq < 4) {
          asm volatile("s_waitcnt vmcnt(0)" ::: "memory");
          __syncthreads();
          if (tid == 0) {
            __builtin_amdgcn_fence(__ATOMIC_RELEASE, "agent");
            asm volatile("s_waitcnt vmcnt(0)" ::: "memory");
            (void)__hip_atomic_fetch_add(kvflag, 1u, __ATOMIC_RELAXED, __HIP_MEMORY_SCOPE_AGENT);
          }
        }
      } else if (u < 1 + 96) {
        const int a = u - 1;
        int bh, qb;
        if (a < 32) { bh = 8 + (xq >> 1); qb = 62 + (xq & 1) - 2 * a; } else { bh = xq; qb = 63 - (a - 32); }
        attn_a_unit(p, bh / 6, bh % 6, qb, smem, lam, msh_a);
      } else {
        if (!memkv_ready) {
          if (tid == 0) {
            while (__hip_atomic_load(kvflag, __ATOMIC_RELAXED, __HIP_MEMORY_SCOPE_AGENT) < 4u) __builtin_amdgcn_s_sleep(1);
            __builtin_amdgcn_fence(__ATOMIC_ACQUIRE, "agent");
            asm volatile("s_waitcnt vmcnt(0)" ::: "memory");
          }
          __syncthreads();
          memkv_ready = true;
        }
        const int v = (xq * 32 + (u - 97)) * 2 + grp; mem_wave(p, 0, v >> 8, v & 3, ((v & 255) >> 2) * 128 + wq * 32, sc2, msh_m, smem);
      }
    }
  }
  grid_barrier(bar, btarget);

  {
    int mti, nti;
    for (int rd = 0; gemm_sched(rd, 4, mti, nti); ++rd) out_tile(p, p.W2t, true, mti, nti, smem);
  }
  grid_barrier(bar, btarget);

  proj_phase(p, 1, smem);
  grid_barrier(bar, btarget);

  {
    const float mqm = wave_max(fabsf(p.mem_q_norm[64 + lane])), mkm = wave_max(fabsf(p.mem_k_norm[64 + lane]));
    const float sc2 = 0.125f * LOG2E, msh_m = 8.f * mqm * mkm * LOG2E;
    for (int u = bid + nb * wid; u < 6144 + 2048; u += nb * 8) {
      if (u < 6144) { const int qb = 63 - u / 96, rem = u % 96, bh = rem >> 2; sb_wave(p, bh / 12, bh % 12, qb * 128 + (rem & 3) * 32, smem); }
      else { const int v = u - 6144, rem = v & 1023; mem_wave(p, 1, v >> 10, (rem >> 2) & 3, (rem >> 4) * 128 + (rem & 3) * 32, sc2, msh_m, smem); }
    }
  }
  grid_barrier(bar, btarget);
  if (bid == 0 && tid == 0) __hip_atomic_store(bar + 64, btarget, __ATOMIC_RELAXED, __HIP_MEMORY_SCOPE_AGENT);

  {
    int mti, nti;
    for (int rd = 0; gemm_sched(rd, 4, mti, nti); ++rd) out_tile(p, p.W4t, false, mti, nti, smem);
  }
}

extern "C" void kernel_launch(void* const* d_in, const int* in_sizes, int n_in, void* d_out, int out_size, void* d_ws, size_t ws_size, hipStream_t stream) {
  static int grid_blocks = 0;
  if (!grid_blocks) {
    int dev = 0, cus = 0, per_cu = 0;
    (void)hipGetDevice(&dev);
    (void)hipDeviceGetAttribute(&cus, hipDeviceAttributeMultiprocessorCount, dev);
    (void)hipFuncSetAttribute((const void*)yoco_fwd, hipFuncAttributeMaxDynamicSharedMemorySize, LDS_BYTES);
    (void)hipOccupancyMaxActiveBlocksPerMultiprocessor(&per_cu, yoco_fwd, NT, LDS_BYTES);
    if (per_cu > 1) per_cu = 1;
    if (per_cu < 1) per_cu = 1;
    grid_blocks = cus * per_cu;
  }
  Params p;
  memset(&p, 0, sizeof(p));
  const float* const* in = (const float* const*)d_in;
  p.x = in[0]; p.mem = in[1]; p.pos = (const int*)d_in[2];
  p.a_q_norm = in[5]; p.a_k_norm = in[6]; p.lq1 = in[7]; p.lk1 = in[8]; p.lq2 = in[9]; p.lk2 = in[10]; p.a_subln = in[11];
  p.mem_q_norm = in[20]; p.mem_k_norm = in[21];
  p.out = (float*)d_out;
  char* w = (char*)d_ws;
  size_t off = 0;
  auto take = [&](size_t bytes) { char* q = w + off; off += (bytes + 255) & ~(size_t)255; return q; };
  p.ctr = (int*)take(1024);
  p.P = (bf16_t*)take((size_t)NTOK * NP * 2);
  p.Vt = (bf16_t*)take((size_t)2 * 768 * SEQ * 2);
  p.xb = (bf16_t*)take((size_t)NTOK * DM * 2);
  p.y = (bf16_t*)take((size_t)NTOK * DM * 2);
  p.Ksb = (bf16_t*)take((size_t)2 * 768 * SEQ * 2);
  p.W1t = (bf16_t*)take((size_t)3584 * DM * 2);
  p.W2t = (bf16_t*)take((size_t)1024 * DM * 2);
  p.W3t = (bf16_t*)take((size_t)3584 * DM * 2);
  p.W4t = (bf16_t*)take((size_t)1024 * DM * 2);
  p.Wmt = (bf16_t*)take((size_t)2 * 512 * DM * 2);
  p.memb = (bf16_t*)take((size_t)512 * DM * 2);
  p.Km = (bf16_t*)take((size_t)2 * 512 * 256 * 2);
  p.Vmt = (bf16_t*)take((size_t)2 * 512 * 256 * 2);
  p.ssq0 = (float*)take((size_t)NTOK * 16 * 4);
  p.ssq1 = (float*)take((size_t)NTOK * 16 * 4);
  p.ssqm = (float*)take((size_t)512 * 16 * 4);
  p.cs = (float*)take((size_t)NTOK * 16 * 4);
  const float* a_norm = in[3]; const float* a_w_in = in[4]; const float* a_w_out = in[12]; const float* kv_norm = in[13]; const float* w_kv = in[14];
  const float* b_norm = in[15]; const float* b_w_in = in[16]; const float* b_w_out = in[17]; const float* mem_norm = in[18]; const float* mem_w_kv = in[19];
  auto setseg = [&](int i, const float* src, const float* gain, bf16_t* dst, int ld, int col0, int ncols) {
    p.seg[i].src = src; p.seg[i].gain = gain; p.seg[i].dst = dst; p.seg[i].ld = ld; p.seg[i].col0 = col0; p.seg[i].ncols = ncols; p.seg[i].pad = 0; };
  setseg(0, a_w_in, a_norm, p.W1t, 3584, 0, 3584);
  setseg(1, a_w_out, nullptr, p.W2t, 1024, 0, 1024);
  setseg(2, b_w_in, b_norm, p.W3t, 2048, 0, 768);
  setseg(3, w_kv, kv_norm, p.W3t + (size_t)768 * DM, 1536, 0, 1536);
  setseg(4, b_w_in, b_norm, p.W3t + (size_t)2304 * DM, 2048, 768, 1280);
  setseg(5, b_w_out, nullptr, p.W4t, 1024, 0, 1024);
  setseg(6, mem_w_kv, mem_norm, p.Wmt, 512, 0, 512);
  setseg(7, mem_w_kv + (size_t)1024 * 512, mem_norm + 1024, p.Wmt + (size_t)512 * DM, 512, 0, 512);
  for (int i = 0; i < 8; ++i) p.inv[i] = (float)pow(500000.0, -(double)i / 8.0);
  void* args[] = {&p};
  hipError_t e = hipLaunchCooperativeKernel((const void*)yoco_fwd, dim3(grid_blocks), dim3(NT), args, LDS_BYTES, stream);
  if (e != hipSuccess) fprintf(stderr, "cooperative launch failed: %s (grid %d)\n", hipGetErrorString(e), grid_blocks);
}
```

```cpp
#include <hip/hip_runtime.h>
#include <hip/hip_cooperative_groups.h>
#include <cstdio>
#include <cmath>
#include <cstring>
namespace cg = cooperative_groups;

typedef unsigned short bf16_t;
typedef short bf16x8 __attribute__((ext_vector_type(8)));
typedef short bf16x4 __attribute__((ext_vector_type(4)));
typedef float f32x16 __attribute__((ext_vector_type(16)));
typedef float f32x4 __attribute__((ext_vector_type(4)));
typedef float f32x2 __attribute__((ext_vector_type(2)));
typedef unsigned u32x4 __attribute__((ext_vector_type(4)));
typedef unsigned u32x2 __attribute__((ext_vector_type(2)));
typedef __bf16 bf2_t __attribute__((ext_vector_type(2)));

#define DI __device__ __forceinline__
#define MFMA32(a, b, c) __builtin_amdgcn_mfma_f32_32x32x16_bf16((a), (b), (c), 0, 0, 0)

constexpr int SEQ = 8192, DM = 1024, NTOK = 16384, NP = 3584;
constexpr int NT = 512;
constexpr float EPS = 1e-6f;
constexpr int LDS_ELEMS = 2 * 512 * 72;
constexpr int LDS_BYTES = LDS_ELEMS * 2 + 16;

struct Seg { const float* src; const float* gain; bf16_t* dst; int ld; int col0; int ncols; int pad; };

struct Params {
  const float* x; const float* mem; const int* pos;
  const float* a_q_norm; const float* a_k_norm; const float* lq1; const float* lk1; const float* lq2; const float* lk2; const float* a_subln;
  const float* mem_q_norm; const float* mem_k_norm;
  float* out;
  bf16_t* xb; bf16_t* memb; bf16_t* P; bf16_t* Vt; bf16_t* y;
  bf16_t* Ksb; bf16_t* W1t; bf16_t* W2t; bf16_t* W3t; bf16_t* W4t; bf16_t* Wmt; bf16_t* Km; bf16_t* Vmt;
  float* ssq0; float* ssq1; float* ssqm; float* cs; int* ctr; unsigned* xbw;
  Seg seg[8];
  float inv[8];
};

DI unsigned pk2(float a, float b) { f32x2 v = {a, b}; bf2_t r = __builtin_convertvector(v, bf2_t); return __builtin_bit_cast(unsigned, r); }
DI bf16_t f2bf(float a) { return (bf16_t)(pk2(a, 0.f) & 0xffffu); }
DI float bflo(unsigned w) { return __uint_as_float(w << 16); }
DI float bfhi(unsigned w) { return __uint_as_float(w & 0xffff0000u); }
DI int crow(int reg, int h) { return (reg & 3) + 8 * (reg >> 2) + 4 * h; }
DI int perm16(int kk) { return ((kk >> 2) & 1) * 8 + (kk >> 3) * 4 + (kk & 3); }
DI bf16x8 pack8(const float* v) {
  u32x4 w; w.x = pk2(v[0], v[1]); w.y = pk2(v[2], v[3]); w.z = pk2(v[4], v[5]); w.w = pk2(v[6], v[7]);
  return __builtin_bit_cast(bf16x8, w);
}
DI int opaque_tid() { int t = threadIdx.x; asm volatile("" : "+v"(t)); return t; }
DI f32x16 zero16() { f32x16 z; for (int i = 0; i < 16; ++i) z[i] = 0.f; return z; }

__device__ void phase0(const Params& p, bf16_t* smem) {
  const int tid = opaque_tid(), lane = tid & 63, wid = tid >> 6, nb = gridDim.x, bid = blockIdx.x;
  for (int row0 = (bid * 8 + wid) * 2; row0 < NTOK + 512; row0 += nb * 16) {
    f32x4 v[2][4];
#pragma unroll
    for (int q = 0; q < 2; ++q) {
      const int row = row0 + q;
      const float* src = (row < NTOK) ? p.x + (size_t)row * DM : p.mem + (size_t)(row - NTOK) * DM;
#pragma unroll
      for (int j = 0; j < 4; ++j) v[q][j] = *(const f32x4*)(src + 256 * j + 4 * lane);
    }
#pragma unroll
    for (int q = 0; q < 2; ++q) {
      const int row = row0 + q;
      bf16_t* dst; float* sq;
      if (row < NTOK) { dst = p.xb + (size_t)row * DM; sq = p.ssq0 + (size_t)row * 16; }
      else { const int r2 = row - NTOK; dst = p.memb + (size_t)r2 * DM; sq = p.ssqm + (size_t)r2 * 16; }
#pragma unroll
      for (int j = 0; j < 4; ++j) {
        const f32x4 t = v[q][j];
        float s = t.x * t.x + t.y * t.y + t.z * t.z + t.w * t.w;
        u32x2 w; w.x = pk2(t.x, t.y); w.y = pk2(t.z, t.w);
        *(u32x2*)(dst + 256 * j + 4 * lane) = w;
        s += __shfl_xor(s, 1); s += __shfl_xor(s, 2); s += __shfl_xor(s, 4); s += __shfl_xor(s, 8);
        if ((lane & 15) == 0) sq[4 * j + (lane >> 4)] = s;
      }
    }
  }
  for (int i = bid * NT + tid; i < NTOK * 8; i += nb * NT) {
    const int token = i >> 3, f = i & 7;
    const float ang = (float)p.pos[token] * p.inv[f];
    double rev = (double)ang * 0.15915494309189535;
    rev -= floor(rev);
    const double q4 = rint(rev * 4.0);
    const double a = (rev - q4 * 0.25) * 6.283185307179586;
    const int q = ((int)q4) & 3;
    const double a2 = a * a;
    double sn = -1.0 / 39916800.0; sn = sn * a2 + 1.0 / 362880.0; sn = sn * a2 - 1.0 / 5040.0; sn = sn * a2 + 1.0 / 120.0; sn = sn * a2 - 1.0 / 6.0; sn = sn * a2 + 1.0; sn *= a;
    double cn = 1.0 / 479001600.0; cn = cn * a2 - 1.0 / 3628800.0; cn = cn * a2 + 1.0 / 40320.0; cn = cn * a2 - 1.0 / 720.0; cn = cn * a2 + 1.0 / 24.0; cn = cn * a2 - 0.5; cn = cn * a2 + 1.0;
    double c, s;
    if (q == 0) { c = cn; s = sn; } else if (q == 1) { c = -sn; s = cn; } else if (q == 2) { c = -cn; s = -sn; } else { c = sn; s = -cn; }
    p.cs[(size_t)token * 16 + f] = (float)c;
    p.cs[(size_t)token * 16 + 8 + f] = (float)s;
  }
  {
    f32x4 nv[2]; float ng[2]; bf16_t* ndst = nullptr;
    auto fetch = [&](int t) {
      int ct = t >> 4; const int k0 = (t & 15) * 64;
      int si = 0;
      while (ct >= (p.seg[si].ncols >> 6)) { ct -= (p.seg[si].ncols >> 6); ++si; }
      const Seg sg = p.seg[si];
      const int n0 = ct * 64;
#pragma unroll
      for (int j = 0; j < 2; ++j) {
        const int i = tid + NT * j, kr = i >> 4, c4 = i & 15;
        nv[j] = *(const f32x4*)(sg.src + (size_t)(k0 + kr) * sg.ld + sg.col0 + n0 + c4 * 4);
        ng[j] = sg.gain ? sg.gain[k0 + kr] : 1.f;
      }
      ndst = sg.dst + (size_t)(n0 + (tid >> 3)) * DM + k0 + (tid & 7) * 8;
    };
    if (bid < 2560) fetch(bid);
    for (int t = bid; t < 2560; t += nb) {
      const f32x4 v0 = nv[0], v1 = nv[1]; const float g0 = ng[0], g1 = ng[1]; bf16_t* dst = ndst;
      if (t + nb < 2560) fetch(t + nb);
      __syncthreads();
      {
        const int kr = tid >> 4, c4 = tid & 15;
        smem[(c4 * 4 + 0) * 72 + kr] = f2bf(v0.x * g0); smem[(c4 * 4 + 1) * 72 + kr] = f2bf(v0.y * g0);
        smem[(c4 * 4 + 2) * 72 + kr] = f2bf(v0.z * g0); smem[(c4 * 4 + 3) * 72 + kr] = f2bf(v0.w * g0);
        smem[(c4 * 4 + 0) * 72 + kr + 32] = f2bf(v1.x * g1); smem[(c4 * 4 + 1) * 72 + kr + 32] = f2bf(v1.y * g1);
        smem[(c4 * 4 + 2) * 72 + kr + 32] = f2bf(v1.z * g1); smem[(c4 * 4 + 3) * 72 + kr + 32] = f2bf(v1.w * g1);
      }
      __syncthreads();
      *(u32x4*)dst = *(const u32x4*)(smem + (tid >> 3) * 72 + (tid & 7) * 8);
    }
  }
  __syncthreads();
}

template <int MT>
DI void gemm_core(const bf16_t* __restrict__ Wt, const bf16_t* __restrict__ X, int n0, int m0, f32x16 (&acc)[2][MT], bf16_t* smem) {
  const int tid = opaque_tid(), lane = tid & 63, wid = tid >> 6, wn = wid >> 1, wm = wid & 1, r = lane & 31, h = lane >> 5;
  bf16_t* Ws = smem;
  bf16_t* Xs = smem + 2 * 256 * 72;
  const char* wub = (const char*)(Wt + (size_t)n0 * DM);
  const char* xub = (const char*)(X + (size_t)m0 * DM);
  const unsigned voff = (unsigned)(((tid >> 3) * DM + (tid & 7) * 8) * 2);
#define GLD_W(i, k) (*(const u32x4*)(wub + ((size_t)(i) * 64 * DM * 2 + (size_t)(k) * 128) + voff))
#define GLD_X(i, k) (*(const u32x4*)(xub + ((size_t)(i) * 64 * DM * 2 + (size_t)(k) * 128) + voff))
  const int so = (tid >> 3) * 72 + (tid & 7) * 8;
  u32x4 wr[4], xr[MT];
#pragma unroll
  for (int i = 0; i < 4; ++i) wr[i] = GLD_W(i, 0);
#pragma unroll
  for (int i = 0; i < MT; ++i) xr[i] = GLD_X(i, 0);
  __syncthreads();
#pragma unroll
  for (int i = 0; i < 4; ++i) *(u32x4*)(Ws + so + i * 64 * 72) = wr[i];
#pragma unroll
  for (int i = 0; i < MT; ++i) *(u32x4*)(Xs + so + i * 64 * 72) = xr[i];
#pragma unroll
  for (int i = 0; i < 4; ++i) wr[i] = GLD_W(i, 1);
#pragma unroll
  for (int i = 0; i < MT; ++i) xr[i] = GLD_X(i, 1);
  __syncthreads();
  const int ao = (wn * 64 + r) * 72 + h * 8, bo = (wm * (MT * 32) + r) * 72 + h * 8;
  for (int kt = 0; kt < 16; ++kt) {
    const int cur = (kt & 1) * 256 * 72, nxt = ((kt + 1) & 1) * 256 * 72;
#pragma unroll
    for (int s = 0; s < 4; ++s) {
      bf16x8 a[2], b[MT];
#pragma unroll
      for (int nt = 0; nt < 2; ++nt) a[nt] = *(const bf16x8*)(Ws + cur + ao + nt * 32 * 72 + s * 16);
#pragma unroll
      for (int mt = 0; mt < MT; ++mt) b[mt] = *(const bf16x8*)(Xs + cur + bo + mt * 32 * 72 + s * 16);
      if (kt + 1 < 16) {
        *(u32x4*)(Ws + nxt + so + s * 64 * 72) = wr[s];
        if (s < MT) *(u32x4*)(Xs + nxt + so + s * 64 * 72) = xr[s < MT ? s : 0];
        if (kt + 2 < 16) {
          wr[s] = GLD_W(s, kt + 2);
          if (s < MT) xr[s < MT ? s : 0] = GLD_X(s, kt + 2);
        }
      }
#pragma unroll
      for (int nt = 0; nt < 2; ++nt)
#pragma unroll
        for (int mt = 0; mt < MT; ++mt) acc[nt][mt] = MFMA32(a[nt], b[mt], acc[nt][mt]);
    }
    __syncthreads();
  }
}

DI float row_rinv(const float* ssq, int token) {
  const f32x4* q = (const f32x4*)(ssq + (size_t)token * 16);
  const f32x4 a = q[0], b = q[1], c = q[2], d = q[3];
  const float s = ((a.x + a.y) + (a.z + a.w)) + ((b.x + b.y) + (b.z + b.w)) + ((c.x + c.y) + (c.z + c.w)) + ((d.x + d.y) + (d.z + d.w));
  return rsqrtf(s * (1.f / 1024.f) + EPS);
}

enum { EK_QKROPE = 0, EK_NORM = 1, EK_PLAIN = 2, EK_VT = 3, EK_SILU = 4, EK_VBLK = 5 };

template <int MT>
DI void epi_proj(const f32x16 (&acc)[2][MT], int kind, const float* __restrict__ ssq0, const float* __restrict__ gain, const float* __restrict__ cs0,
                 bf16_t* __restrict__ dbase, int ld, bf16_t* __restrict__ vbase, int vt_ld, bf16_t* smem, float qscale) {
  const int tid = opaque_tid(), lane = tid & 63, wid = tid >> 6, r = lane & 31, h = lane >> 5;
  bf16_t* wreg = smem + wid * 9216;
#pragma unroll
  for (int mt = 0; mt < MT; ++mt) {
    const float rs = row_rinv(ssq0, mt * 32);
    float v[2][16];
#pragma unroll
    for (int nt = 0; nt < 2; ++nt)
#pragma unroll
      for (int i = 0; i < 16; ++i) v[nt][i] = acc[nt][mt][i] * rs;
    if (kind <= EK_NORM) {
      float ss = 0.f;
#pragma unroll
      for (int nt = 0; nt < 2; ++nt)
#pragma unroll
        for (int i = 0; i < 16; ++i) ss += v[nt][i] * v[nt][i];
      ss += __shfl_xor(ss, 32);
      const float rn = rsqrtf(ss * (1.f / 64.f) + EPS);
#pragma unroll
      for (int nt = 0; nt < 2; ++nt)
#pragma unroll
        for (int g = 0; g < 4; ++g) {
          const f32x4 gg = *(const f32x4*)(gain + nt * 32 + 8 * g + 4 * h);
          v[nt][4 * g + 0] *= rn * gg.x; v[nt][4 * g + 1] *= rn * gg.y; v[nt][4 * g + 2] *= rn * gg.z; v[nt][4 * g + 3] *= rn * gg.w;
        }
      if (kind == EK_QKROPE) {
        const f32x4 c = *(const f32x4*)(cs0 + mt * 32 * 16 + 4 * h);
        const f32x4 s = *(const f32x4*)(cs0 + mt * 32 * 16 + 8 + 4 * h);
#pragma unroll
        for (int i = 0; i < 4; ++i) {
          const float x1 = v[0][i], x2 = v[0][4 + i];
          v[0][i] = x1 * c[i] - x2 * s[i];
          v[0][4 + i] = x2 * c[i] + x1 * s[i];
        }
#pragma unroll
        for (int nt = 0; nt < 2; ++nt)
#pragma unroll
          for (int i = 0; i < 16; ++i) v[nt][i] *= qscale;
      }
    } else if (kind == EK_PLAIN) {
#pragma unroll
      for (int nt = 0; nt < 2; ++nt)
#pragma unroll
        for (int i = 0; i < 16; ++i) v[nt][i] *= qscale;
    } else if (kind == EK_SILU) {
#pragma unroll
      for (int nt = 0; nt < 2; ++nt)
#pragma unroll
        for (int i = 0; i < 16; ++i) v[nt][i] = v[nt][i] * __builtin_amdgcn_rcpf(1.f + __builtin_amdgcn_exp2f(-1.4426950408889634f * v[nt][i]));
    }
    if (kind == EK_VT || kind == EK_VBLK) {
#pragma unroll
      for (int nt = 0; nt < 2; ++nt)
#pragma unroll
        for (int i = 0; i < 16; ++i) wreg[(nt * 32 + crow(i, h)) * 136 + mt * 32 + (r & 16) + perm16(r & 15)] = f2bf(v[nt][i]);
    } else {
#pragma unroll
      for (int nt = 0; nt < 2; ++nt)
#pragma unroll
        for (int g = 0; g < 4; ++g) {
          u32x2 w; w.x = pk2(v[nt][4 * g], v[nt][4 * g + 1]); w.y = pk2(v[nt][4 * g + 2], v[nt][4 * g + 3]);
          *(u32x2*)(wreg + (mt * 32 + r) * 72 + nt * 32 + 8 * g + 4 * h) = w;
        }
    }
  }
  __syncthreads();
  constexpr int CPR = MT * 4, RPI = 64 / CPR;
  if (kind == EK_VT) {
#pragma unroll
    for (int j = 0; j < CPR; ++j) {
      const int n = j * RPI + lane / CPR, c = lane % CPR;
      *(u32x4*)(vbase + (size_t)n * vt_ld + c * 8) = *(const u32x4*)(wreg + n * 136 + c * 8);
    }
  } else if (kind == EK_VBLK) {
#pragma unroll
    for (int j = 0; j < CPR; ++j) {
      const int n = j * RPI + lane / CPR, c = lane % CPR;
      *(u32x4*)(vbase + (size_t)(c >> 2) * 2048 + n * 32 + (c & 3) * 8) = *(const u32x4*)(wreg + n * 136 + c * 8);
    }
  } else {
#pragma unroll
    for (int j = 0; j < MT * 4; ++j) {
      const int row = j * 8 + (lane >> 3), c = lane & 7;
      *(u32x4*)(dbase + (size_t)row * ld + c * 8) = *(const u32x4*)(wreg + row * 72 + c * 8);
    }
  }
}

template <int MT>
DI void zero_acc(f32x16 (&acc)[2][MT]) {
#pragma unroll
  for (int a = 0; a < 2; ++a)
#pragma unroll
    for (int b = 0; b < MT; ++b) acc[a][b] = zero16();
}

template <int MT>
__device__ void proj_tile(const Params& p, int layer, int m0, int nti, bf16_t* smem) {
  const int tid = opaque_tid(), lane = tid & 63, wid = tid >> 6, wn = wid >> 1, wm = wid & 1, r = lane & 31, h = lane >> 5;
  const int n0 = nti * 256;
  f32x16 acc[2][MT];
  zero_acc<MT>(acc);
  gemm_core<MT>(layer ? p.W3t : p.W1t, p.xb, n0, m0, acc, smem);
  const float* ssq = layer ? p.ssq1 : p.ssq0;
  const int tok = m0 + wm * (MT * 32) + r;
  const int cc = n0 + wn * 64;
  int kind; const float* gain = p.a_q_norm;
  if (cc < 1536) { kind = layer ? EK_PLAIN : EK_QKROPE; gain = (cc < 768) ? p.a_q_norm : p.a_k_norm; }
  else if (cc < 2304) kind = EK_VT;
  else if (cc < 2560) { kind = EK_NORM; gain = p.mem_q_norm + layer * 64; }
  else kind = EK_SILU;
  const int tok0 = m0 + wm * (MT * 32), b = tok0 >> 13;
  bf16_t* vtb = p.Vt + ((size_t)b * 768 + (cc - 1536)) * SEQ + (tok0 & (SEQ - 1));
  bf16_t* dbase = p.P + (size_t)tok0 * NP + cc;
  int ld = NP;
  if (layer && cc >= 768 && cc < 1536) {
    dbase = p.Ksb + (((size_t)b * 12 + ((cc - 768) >> 6)) * SEQ + (tok0 & (SEQ - 1))) * 64; ld = 64;
  } else if (layer && kind == EK_VT) {
    kind = EK_VBLK;
    vtb = p.Vt + (((size_t)b * 12 + ((cc - 1536) >> 6)) * 256 + ((tok0 & (SEQ - 1)) >> 5)) * 2048;
  }
  epi_proj<MT>(acc, kind, ssq + (size_t)tok * 16, gain, p.cs + (size_t)tok * 16, dbase, ld, vtb, SEQ, smem, (cc < 768) ? 0.125f * 1.4426950408889634f : 1.f);
}

__device__ void mem_tile(const Params& p, int l, int mti, int nti, bf16_t* smem) {
  const int tid = opaque_tid(), lane = tid & 63, wid = tid >> 6, wn = wid >> 1, wm = wid & 1, r = lane & 31, h = lane >> 5;
  const int m0 = mti * 256, n0 = nti * 256;
  f32x16 acc[2][4];
  zero_acc<4>(acc);
  gemm_core<4>(p.Wmt + (size_t)l * 512 * DM, p.memb, n0, m0, acc, smem);
  const int tok = m0 + wm * 128 + r;
  const int cc = n0 + wn * 64;
  const int kind = (cc < 256) ? EK_NORM : EK_VT;
  const int tok0 = m0 + wm * 128, b = tok0 >> 8;
  bf16_t* vtb = p.Vmt + ((size_t)(l * 2 + b) * 256 + (cc - 256)) * 256 + (tok0 & 255);
  epi_proj<4>(acc, kind, p.ssqm + (size_t)tok * 16, p.mem_k_norm + l * 64, p.cs, p.Km + ((size_t)l * 512 + tok0) * 256 + cc, 256, vtb, 256, smem, 1.f);
}

__device__ void out_tile(const Params& p, const bf16_t* Wt, bool first, int mti, int nti, bf16_t* smem) {
  const int tid = opaque_tid(), lane = tid & 63, wid = tid >> 6, wn = wid >> 1, wm = wid & 1, r = lane & 31, h = lane >> 5;
  const int m0 = mti * 256, n0 = nti * 256;
  f32x16 acc[2][4];
  zero_acc<4>(acc);
  gemm_core<4>(Wt, p.y, n0, m0, acc, smem);
  const int cc = n0 + wn * 64;
  float* freg = (float*)smem + wid * 4608;
#pragma unroll
  for (int half = 0; half < 2; ++half) {
#pragma unroll
    for (int mtl = 0; mtl < 2; ++mtl)
#pragma unroll
      for (int nt = 0; nt < 2; ++nt)
#pragma unroll
        for (int g = 0; g < 4; ++g) {
          f32x4 o; o.x = acc[nt][half * 2 + mtl][4 * g + 0]; o.y = acc[nt][half * 2 + mtl][4 * g + 1]; o.z = acc[nt][half * 2 + mtl][4 * g + 2]; o.w = acc[nt][half * 2 + mtl][4 * g + 3];
          *(f32x4*)(freg + (mtl * 32 + r) * 68 + nt * 32 + 8 * g + 4 * h) = o;
        }
    __syncthreads();
#pragma unroll
    for (int j = 0; j < 16; ++j) {
      const int row = j * 4 + (lane >> 4), c = lane & 15;
      const int tok = m0 + wm * 128 + half * 64 + row;
      const size_t off = (size_t)tok * DM + cc + c * 4;
      const f32x4 a = *(const f32x4*)(freg + row * 68 + c * 4);
      f32x4 o;
      if (first) {
        o = *(const f32x4*)(p.x + off);
        o.x += a.x; o.y += a.y; o.z += a.z; o.w += a.w;
        u32x2 w; w.x = pk2(o.x, o.y); w.y = pk2(o.z, o.w);
        *(u32x2*)(p.xb + off) = w;
        float ss = o.x * o.x + o.y * o.y + o.z * o.z + o.w * o.w;
        ss += __shfl_xor(ss, 1); ss += __shfl_xor(ss, 2); ss += __shfl_xor(ss, 4); ss += __shfl_xor(ss, 8);
        if (c == 0) p.ssq1[(size_t)tok * 16 + (cc >> 6)] = ss;
      } else {
        const u32x2 w = *(const u32x2*)(p.xb + off);
        o.x = bflo(w.x) + a.x; o.y = bfhi(w.x) + a.y; o.z = bflo(w.y) + a.z; o.w = bfhi(w.y) + a.w;
        *(f32x4*)(p.out + off) = o;
      }
      if ((j & 3) == 3) __builtin_amdgcn_sched_barrier(0);
    }
    __syncthreads();
  }
}

template <int NDT>
DI void store_gated(const f32x16 (&O)[NDT], float* reg, const bf16_t* __restrict__ grow0, bf16_t* __restrict__ yrow0, const float* __restrict__ gain, int lane) {
  constexpr int RS = NDT * 32 + 4, LPR = NDT * 8, RPI = 64 / LPR;
  const int r = lane & 31, h = lane >> 5;
#pragma unroll
  for (int dvt = 0; dvt < NDT; ++dvt)
#pragma unroll
    for (int g = 0; g < 4; ++g) {
      f32x4 o; o.x = O[dvt][4 * g + 0]; o.y = O[dvt][4 * g + 1]; o.z = O[dvt][4 * g + 2]; o.w = O[dvt][4 * g + 3];
      *(f32x4*)(reg + r * RS + dvt * 32 + 8 * g + 4 * h) = o;
    }
  asm volatile("s_waitcnt lgkmcnt(0)" ::: "memory");
  const int c = lane % LPR;
  f32x4 gg; gg.x = 1.f; gg.y = 1.f; gg.z = 1.f; gg.w = 1.f;
  if (gain) gg = *(const f32x4*)(gain + c * 4);
#pragma unroll
  for (int j = 0; j < 32 / RPI; ++j) {
    const int row = j * RPI + lane / LPR;
    const f32x4 v = *(const f32x4*)(reg + row * RS + c * 4);
    const u32x2 gw = *(const u32x2*)(grow0 + (size_t)row * NP + c * 4);
    u32x2 w;
    w.x = pk2(v.x * gg.x * bflo(gw.x), v.y * gg.y * bfhi(gw.x));
    w.y = pk2(v.z * gg.z * bflo(gw.y), v.w * gg.w * bfhi(gw.y));
    *(u32x2*)(yrow0 + (size_t)row * DM + c * 4) = w;
  }
  asm volatile("s_waitcnt lgkmcnt(0)" ::: "memory");
}

__device__ void attn_a_unit(const Params& p, int b, int hd, int qb, bf16_t* smem, float lam, float msh) {
  const int tid = opaque_tid(), lane = tid & 63, wid = tid >> 6, r = lane & 31, h = lane >> 5, grp = wid >> 2, wq = wid & 3;
  const bf16_t* Pb = p.P + (size_t)b * SEQ * NP;
  const bf16_t* Vb = p.Vt + ((size_t)b * 768 + hd * 128) * SEQ;
  const int q0 = qb * 128 + wq * 32;
  bf16x8 qf[4];
#pragma unroll
  for (int s = 0; s < 4; ++s) qf[s] = *(const bf16x8*)(Pb + (size_t)(q0 + r) * NP + grp * 384 + hd * 64 + s * 16 + h * 8);
  f32x16 O[4];
#pragma unroll
  for (int i = 0; i < 4; ++i) O[i] = zero16();
  float l = 0.f;
  const int nkt = 2 * (qb + 1);
  constexpr int VOFF = 9216, SSTR = 18432;
  const char* kub = (const char*)(Pb + 768 + hd * 64);
  const char* vub = (const char*)Vb;
  const unsigned kvo = (unsigned)(((tid >> 3) * NP + (tid & 7) * 8) * 2);
  const unsigned vvo = (unsigned)(((tid >> 3) * SEQ + (tid & 7) * 8) * 2);
#define GLD_K(i, t) (*(const u32x4*)(kub + ((size_t)(t) * 64 * NP * 2 + (size_t)(i) * 768) + kvo))
#define GLD_V(i, t) (*(const u32x4*)(vub + ((size_t)(i) * 64 * SEQ * 2 + (size_t)(t) * 128) + vvo))
  const int kso = (tid >> 3) * 72 + (tid & 7) * 8;
  const int vso = VOFF + (tid >> 3) * 72 + (tid & 7) * 8;
  const int kro = grp * 64 * 72 + r * 72 + h * 8;
  const int vro = VOFF + r * 72 + 8 * h;
  u32x4 kr[2], vr[2];
#pragma unroll
  for (int i = 0; i < 2; ++i) { kr[i] = GLD_K(i, 0); vr[i] = GLD_V(i, 0); }
#pragma unroll
  for (int i = 0; i < 2; ++i) {
    *(u32x4*)(smem + kso + i * 64 * 72) = kr[i];
    *(u32x4*)(smem + vso + i * 64 * 72) = vr[i];
  }
#pragma unroll
  for (int i = 0; i < 2; ++i) { kr[i] = GLD_K(i, 1); vr[i] = GLD_V(i, 1); }
  __syncthreads();
  for (int kt = 0; kt < nkt; ++kt) {
    const int cur = (kt & 1) * SSTR, nxt = ((kt + 1) & 1) * SSTR;
    if (kt + 1 < nkt) {
#pragma unroll
      for (int i = 0; i < 2; ++i) {
        *(u32x4*)(smem + nxt + kso + i * 64 * 72) = kr[i];
        *(u32x4*)(smem + nxt + vso + i * 64 * 72) = vr[i];
      }
      if (kt + 2 < nkt) {
#pragma unroll
        for (int i = 0; i < 2; ++i) { kr[i] = GLD_K(i, kt + 2); vr[i] = GLD_V(i, kt + 2); }
      }
    }
    const int k0 = kt * 64;
    if (k0 <= q0 + 31) {
      bf16x8 kfr[8], vfa[8], vfb[8];
#pragma unroll
      for (int s = 0; s < 8; ++s) kfr[s] = *(const bf16x8*)(smem + cur + kro + (s >> 2) * 32 * 72 + (s & 3) * 16);
      __builtin_amdgcn_sched_barrier(0);
      f32x16 S0 = zero16(), S1 = zero16();
#pragma unroll
      for (int s = 0; s < 4; ++s) S0 = MFMA32(kfr[s], qf[s], S0);
#pragma unroll
      for (int s = 0; s < 8; ++s) vfa[s] = *(const bf16x8*)(smem + cur + vro + (s >> 1) * 32 * 72 + (s & 1) * 16);
#pragma unroll
      for (int s = 0; s < 4; ++s) S1 = MFMA32(kfr[4 + s], qf[s], S1);
      __builtin_amdgcn_sched_barrier(0);
      const int dq = q0 + r - k0 - 4 * h;
      float pv[16]; bf16x8 pk[2];
#pragma unroll
      for (int s = 0; s < 8; ++s) vfb[s] = *(const bf16x8*)(smem + cur + vro + (s >> 1) * 32 * 72 + 32 + (s & 1) * 16);
#pragma unroll
      for (int i = 0; i < 16; ++i) pv[i] = __builtin_amdgcn_exp2f(S0[i]);
      if (k0 + 31 > q0) {
#pragma unroll
        for (int i = 0; i < 16; ++i) if ((i & 3) + 8 * (i >> 2) > dq) pv[i] = 0.f;
      }
#pragma unroll
      for (int i = 0; i < 16; ++i) l += pv[i];
      pk[0] = pack8(pv); pk[1] = pack8(pv + 8);
      __builtin_amdgcn_sched_barrier(0);
#pragma unroll
      for (int s = 0; s < 8; ++s) O[s >> 1] = MFMA32(vfa[s], pk[s & 1], O[s >> 1]);
#pragma unroll
      for (int i = 0; i < 16; ++i) pv[i] = __builtin_amdgcn_exp2f(S1[i]);
      if (k0 + 63 > q0) {
#pragma unroll
        for (int i = 0; i < 16; ++i) if (32 + (i & 3) + 8 * (i >> 2) > dq) pv[i] = 0.f;
      }
#pragma unroll
      for (int i = 0; i < 16; ++i) l += pv[i];
      bf16x8 pq[2]; pq[0] = pack8(pv); pq[1] = pack8(pv + 8);
      __builtin_amdgcn_sched_barrier(0);
#pragma unroll
      for (int s = 0; s < 8; ++s) O[s >> 1] = MFMA32(vfb[s], pq[s & 1], O[s >> 1]);
    }
    __syncthreads();
  }
  l += __shfl_xor(l, 32);
  float* xch = (float*)smem + (size_t)wq * 65 * 64 + lane;
  if (grp == 1) {
#pragma unroll
    for (int dvt = 0; dvt < 4; ++dvt)
#pragma unroll
      for (int i = 0; i < 16; ++i) xch[(dvt * 16 + i) * 64] = O[dvt][i];
    xch[64 * 64] = l;
  }
  __syncthreads();
  if (grp == 0) {
    const float i1 = 1.f / l, i2 = lam / xch[64 * 64];
    float ss = 0.f;
#pragma unroll
    for (int dvt = 0; dvt < 4; ++dvt)
#pragma unroll
      for (int i = 0; i < 16; ++i) { const float o = O[dvt][i] * i1 - xch[(dvt * 16 + i) * 64] * i2; O[dvt][i] = o; ss += o * o; }
    ss += __shfl_xor(ss, 32);
    const float rn = rsqrtf(ss * (1.f / 128.f) + EPS) * 0.8f;
#pragma unroll
    for (int dvt = 0; dvt < 4; ++dvt)
#pragma unroll
      for (int i = 0; i < 16; ++i) O[dvt][i] *= rn;
    const size_t tok0 = (size_t)b * SEQ + q0;
    store_gated<4>(O, (float*)smem + 16640 + wq * 4352, p.P + tok0 * NP + 2560 + hd * 128, p.y + tok0 * DM + hd * 128, p.a_subln, lane);
  }
}

__device__ void mem_wave(const Params& p, int l, int b, int mh, int q0, float sc2, float msh, bf16_t* smem) {
  const int tid = opaque_tid(), lane = tid & 63, r = lane & 31, h = lane >> 5;
  const size_t tok = (size_t)b * SEQ + q0 + r;
  const bf16_t* prow = p.P + tok * NP;
  bf16x8 qf[4];
#pragma unroll
  for (int s = 0; s < 4; ++s) qf[s] = *(const bf16x8*)(prow + 2304 + mh * 64 + s * 16 + h * 8);
  const bf16_t* Kl = p.Km + ((size_t)(l * 2 + b) * 256 + r) * 256 + mh * 64 + h * 8;
  const bf16_t* Vl = p.Vmt + ((size_t)(l * 2 + b) * 256 + mh * 64 + r) * 256 + 8 * h;
  f32x16 O[2]; O[0] = zero16(); O[1] = zero16();
  float lsum = 0.f;
  bf16x8 kf[4], vf[4], kn[4], vn[4];
#pragma unroll
  for (int s = 0; s < 4; ++s) { kf[s] = *(const bf16x8*)(Kl + s * 16); vf[s] = *(const bf16x8*)(Vl + (s >> 1) * 32 * 256 + (s & 1) * 16); }
#pragma unroll
  for (int s = 0; s < 4; ++s) { kn[s] = kf[s]; vn[s] = vf[s]; }
  for (int kt = 0; kt < 8; ++kt) {
    if (kt + 1 < 8) {
      const int k1 = (kt + 1) * 32;
#pragma unroll
      for (int s = 0; s < 4; ++s) { kn[s] = *(const bf16x8*)(Kl + (size_t)k1 * 256 + s * 16); vn[s] = *(const bf16x8*)(Vl + (s >> 1) * 32 * 256 + k1 + (s & 1) * 16); }
    }
    __builtin_amdgcn_sched_barrier(0);
    f32x16 S = zero16();
#pragma unroll
    for (int s = 0; s < 4; ++s) S = MFMA32(kf[s], qf[s], S);
    float pv[16];
#pragma unroll
    for (int i = 0; i < 16; ++i) { pv[i] = __builtin_amdgcn_exp2f(S[i] * sc2 - msh); lsum += pv[i]; }
    bf16x8 pk[2]; pk[0] = pack8(pv); pk[1] = pack8(pv + 8);
#pragma unroll
    for (int s = 0; s < 4; ++s) O[s >> 1] = MFMA32(vf[s], pk[s & 1], O[s >> 1]);
#pragma unroll
    for (int s = 0; s < 4; ++s) { kf[s] = kn[s]; vf[s] = vn[s]; }
  }
  lsum += __shfl_xor(lsum, 32);
  const float inv = __builtin_amdgcn_rcpf(lsum);
#pragma unroll
  for (int dvt = 0; dvt < 2; ++dvt)
#pragma unroll
    for (int i = 0; i < 16; ++i) O[dvt][i] *= inv;
  store_gated<2>(O, (float*)smem + (tid >> 6) * 4608, prow - (size_t)r * NP + 2560 + 768 + mh * 64, p.y + (tok - r) * DM + 768 + mh * 64, nullptr, lane);
}

__device__ void sb_wave(const Params& p, int b, int hd, int q0, bf16_t* smem) {
  const int tid = opaque_tid(), lane = tid & 63, r = lane & 31, h = lane >> 5;
  const bf16_t* Pb = p.P + (size_t)b * SEQ * NP;
  const bf16_t* Kl = p.Ksb + (((size_t)b * 12 + hd) * SEQ + r) * 64 + h * 8;
  const bf16_t* Vl = p.Vt + ((size_t)b * 12 + hd) * 256 * 2048 + r * 32 + 8 * h;
  const size_t tok = (size_t)b * SEQ + q0 + r;
  bf16x8 qf[4];
#pragma unroll
  for (int s = 0; s < 4; ++s) qf[s] = *(const bf16x8*)(Pb + (size_t)(q0 + r) * NP + hd * 64 + s * 16 + h * 8);
  f32x16 O[2]; O[0] = zero16(); O[1] = zero16();
  float R = 0.f;
  const int ktd = q0 >> 5;
  bf16x8 kf[4], kn[4], vf[4];
#pragma unroll
  for (int s = 0; s < 4; ++s) { kf[s] = *(const bf16x8*)(Kl + (size_t)q0 * 64 + s * 16); kn[s] = kf[s]; }
  for (int kt = ktd; kt >= 0; --kt) {
    const int k0 = kt * 32;
    const bool diag = (kt == ktd);
#pragma unroll
    for (int s = 0; s < 4; ++s) vf[s] = *(const bf16x8*)(Vl + (size_t)kt * 2048 + (s >> 1) * 32 * 32 + (s & 1) * 16);
    if (kt > 0) {
#pragma unroll
      for (int s = 0; s < 4; ++s) kn[s] = *(const bf16x8*)(Kl + (size_t)(k0 - 32) * 64 + s * 16);
    }
    __builtin_amdgcn_sched_barrier(0);
    f32x16 S = zero16();
#pragma unroll
    for (int s = 0; s < 4; ++s) S = MFMA32(kf[s], qf[s], S);
    float lb[16], f[16];
#pragma unroll
    for (int i = 0; i < 16; ++i) {
      const float z = S[i];
      const float L = __builtin_amdgcn_logf(1.f + __builtin_amdgcn_exp2f(-fabsf(z)));
      const float lbv = fminf(z, 0.f) - L;
      lb[i] = lbv; f[i] = lbv - z;
    }
    if (diag) {
#pragma unroll
      for (int i = 0; i < 16; ++i) if (crow(i, h) >= r) f[i] = 0.f;
    }
    float T[4], PT[4], loc[16];
#pragma unroll
    for (int g = 0; g < 4; ++g) {
      loc[4 * g + 3] = 0.f;
      loc[4 * g + 2] = f[4 * g + 3];
      loc[4 * g + 1] = loc[4 * g + 2] + f[4 * g + 2];
      loc[4 * g + 0] = loc[4 * g + 1] + f[4 * g + 1];
      T[g] = loc[4 * g + 0] + f[4 * g + 0];
    }
#pragma unroll
    for (int g = 0; g < 4; ++g) PT[g] = __shfl_xor(T[g], 32);
    float hg = R;
    float av[16];
#pragma unroll
    for (int g = 3; g >= 0; --g) {
      const float base = hg + (h == 0 ? PT[g] : 0.f);
#pragma unroll
      for (int i = 0; i < 4; ++i) av[4 * g + i] = __builtin_amdgcn_exp2f(lb[4 * g + i] + (base + loc[4 * g + i]));
      hg += T[g] + PT[g];
    }
    if (diag) {
#pragma unroll
      for (int i = 0; i < 16; ++i) if (crow(i, h) >= r) av[i] = 0.f;
    }
    R = hg;
    bf16x8 pk[2]; pk[0] = pack8(av); pk[1] = pack8(av + 8);
#pragma unroll
    for (int s = 0; s < 4; ++s) O[s >> 1] = MFMA32(vf[s], pk[s & 1], O[s >> 1]);
#pragma unroll
    for (int s = 0; s < 4; ++s) kf[s] = kn[s];
    if (__all(R < -104.f * 1.4426950408889634f)) break;
  }
  store_gated<2>(O, (float*)smem + (tid >> 6) * 4608, p.P + (tok - r) * NP + 2560 + hd * 64, p.y + (tok - r) * DM + hd * 64, nullptr, lane);
}

DI float wave_sum(float v) { for (int o = 32; o > 0; o >>= 1) v += __shfl_xor(v, o); return v; }
DI float wave_max(float v) { for (int o = 32; o > 0; o >>= 1) v = fmaxf(v, __shfl_xor(v, o)); return v; }

DI bool gemm_sched(int rd, int ntn, int& mti, int& nti) {
  const int nb = gridDim.x, bid = blockIdx.x;
  if (nb == 256) {
    const int xcd = bid & 7, li = bid >> 3, ti = rd * 32 + li;
    if (ti >= 8 * ntn) return false;
    mti = xcd * 8 + (ti & 7); nti = ti >> 3; return true;
  }
  const int t = rd * nb + bid;
  if (t >= 64 * ntn) return false;
  mti = t / ntn; nti = t % ntn; return true;
}

DI void proj_phase(const Params& p, int layer, bf16_t* smem) {
  const int nb = gridDim.x, bid = blockIdx.x;
  if (nb == 256) {
    const int xcd = bid & 7, li = bid >> 3;
    for (int rd = 0; rd < 3; ++rd) { const int ti = rd * 32 + li; proj_tile<4>(p, layer, (xcd * 8 + (ti & 7)) * 256, ti >> 3, smem); }
    { const int ti = 96 + (li >> 1); proj_tile<2>(p, layer, (xcd * 8 + (ti & 7)) * 256 + (li & 1) * 128, ti >> 3, smem); }
  } else {
    for (int t = bid; t < 64 * 14; t += nb) proj_tile<4>(p, layer, (t / 14) * 256, t % 14, smem);
  }
}

DI unsigned xb_ld(unsigned* q) { return __hip_atomic_load(q, __ATOMIC_RELAXED, __HIP_MEMORY_SCOPE_AGENT); }
DI unsigned xb_add(unsigned* q, unsigned v) { return __hip_atomic_fetch_add(q, v, __ATOMIC_RELAXED, __HIP_MEMORY_SCOPE_AGENT); }
DI void xb_st(unsigned* q, unsigned v) { __hip_atomic_store(q, v, __ATOMIC_RELAXED, __HIP_MEMORY_SCOPE_AGENT); }
struct XB { unsigned* w; unsigned x, nx, nxcc, bsub, bgen, btop, btg, k; };
#define XB_SPIN(cond) do { unsigned sp_ = 0; while (cond) { __builtin_amdgcn_s_sleep(1); if (++sp_ > (1u << 21)) break; } } while (0)
DI void xb_init(XB& b, unsigned* w) {
  b.w = w; b.k = 0; b.nx = 0; b.nxcc = 0;
  b.x = (unsigned)__builtin_amdgcn_s_getreg((3 << 11) | 20) & 0xFu;
  b.bsub = xb_ld(w + 4096 + 1024 + 64 * b.x); b.bgen = xb_ld(w + 4096 + 2048 + 64 * b.x);
  b.btop = xb_ld(w + 4096 + 3072); b.btg = xb_ld(w + 4096 + 3136);
  (void)xb_add(w + 64 * b.x, 1u);
}
DI void grid_barrier(XB& b, bool last) {
  asm volatile("s_waitcnt vmcnt(0)" ::: "memory");
  __syncthreads();
  if (threadIdx.x == 0) {
    unsigned* w = b.w;
    if (b.k == 0) {
      unsigned tot = 0, nx = 0, nxcc = 0, sp = 0;
      for (;;) {
        tot = 0; nx = 0; nxcc = 0;
        for (unsigned j = 0; j < 16; ++j) { const unsigned c = xb_ld(w + 64 * j) - xb_ld(w + 4096 + 64 * j); tot += c; nxcc += (c != 0u); if (j == b.x) nx = c; }
        if (tot == gridDim.x || ++sp > (1u << 18)) break;
        __builtin_amdgcn_s_sleep(1);
      }
      b.nx = nx; b.nxcc = nxcc;
    }
    b.k += 1;
    const unsigned old = xb_add(w + 1024 + 64 * b.x, 1u);
    if (old - b.bsub + 1u == b.k * b.nx) {
      __builtin_amdgcn_fence(__ATOMIC_RELEASE, "agent");
      asm volatile("s_waitcnt vmcnt(0)" ::: "memory");
      const unsigned ot = xb_add(w + 3072, 1u);
      if (ot - b.btop + 1u == b.k * b.nxcc) {
        if (last) { xb_st(w + 4096 + 3072, b.btop + b.k * b.nxcc); xb_st(w + 4096 + 3136, b.btg + b.k); }
        (void)xb_add(w + 3136, 1u);
      }
      XB_SPIN((int)(xb_ld(w + 3136) - b.btg - b.k) < 0);
      if (last) { xb_st(w + 4096 + 64 * b.x, xb_ld(w + 64 * b.x)); xb_st(w + 4096 + 1024 + 64 * b.x, b.bsub + b.k * b.nx); xb_st(w + 4096 + 2048 + 64 * b.x, b.bgen + b.k); }
      (void)xb_add(w + 2048 + 64 * b.x, 1u);
    } else {
      XB_SPIN((int)(xb_ld(w + 2048 + 64 * b.x) - b.bgen - b.k) < 0);
    }
    __builtin_amdgcn_fence(__ATOMIC_ACQUIRE, "agent");
    asm volatile("s_waitcnt vmcnt(0)" ::: "memory");
  }
  __syncthreads();
}

__global__ void __launch_bounds__(512, 2) yoco_fwd(Params p) {
  extern __shared__ __attribute__((aligned(16))) bf16_t smem[];
  cg::grid_group grid = cg::this_grid();
  const int tid = threadIdx.x, lane = tid & 63, wid = tid >> 6, nb = gridDim.x, bid = blockIdx.x, grp = wid >> 2, wq = wid & 3;
  int* s_unit = (int*)(smem + LDS_ELEMS);
  const float LOG2E = 1.4426950408889634f;
  XB xb = {};
  if (tid == 0) xb_init(xb, p.xbw);
  if (bid == 0 && tid < 64) p.ctr[tid] = 0;
  if (p.out == nullptr) grid.sync();

  phase0(p, smem);
  grid_barrier(xb, false);

  proj_phase(p, 0, smem);
  grid_barrier(xb, false);

  {
    const float d1 = wave_sum(p.lq1[lane] * p.lk1[lane]), d2 = wave_sum(p.lq2[lane] * p.lk2[lane]);
    const float lam = __expf(d1) - __expf(d2) + 0.2f;
    const float mqa = wave_max(fabsf(p.a_q_norm[lane])), mka = wave_max(fabsf(p.a_k_norm[lane]));
    const float mqm = wave_max(fabsf(p.mem_q_norm[lane])), mkm = wave_max(fabsf(p.mem_k_norm[lane]));
    const float sc2 = 0.125f * LOG2E;
    const float msh_a = 8.f * mqa * mka * LOG2E, msh_m = 8.f * mqm * mkm * LOG2E;
    unsigned* kvflag = (unsigned*)(p.ctr + 16);
    bool memkv_ready = false;
    const int xq = bid & 7;
    for (;;) {
      __syncthreads();
      if (tid == 0) *s_unit = atomicAdd(&p.ctr[40 + xq], 1);
      __syncthreads();
      const int u = *s_unit;
      if (u >= 1 + 96 + 32) break;
      if (u == 0) {
        mem_tile(p, xq >> 2, (xq >> 1) & 1, xq & 1, smem);
        if (xq < 4) {
          asm volatile("s_waitcnt vmcnt(0)" ::: "memory");
          __syncthreads();
          if (tid == 0) {
            __builtin_amdgcn_fence(__ATOMIC_RELEASE, "agent");
            asm volatile("s_waitcnt vmcnt(0)" ::: "memory");
            (void)__hip_atomic_fetch_add(kvflag, 1u, __ATOMIC_RELAXED, __HIP_MEMORY_SCOPE_AGENT);
          }
        }
      } else if (u < 1 + 96) {
        const int a = u - 1;
        int bh, qb;
        if (a < 32) { bh = 8 + (xq >> 1); qb = 62 + (xq & 1) - 2 * a; } else { bh = xq; qb = 63 - (a - 32); }
        attn_a_unit(p, bh / 6, bh % 6, qb, smem, lam, msh_a);
      } else {
        if (!memkv_ready) {
          if (tid == 0) {
            while (__hip_atomic_load(kvflag, __ATOMIC_RELAXED, __HIP_MEMORY_SCOPE_AGENT) < 4u) __builtin_amdgcn_s_sleep(1);
            __builtin_amdgcn_fence(__ATOMIC_ACQUIRE, "agent");
            asm volatile("s_waitcnt vmcnt(0)" ::: "memory");
          }
          __syncthreads();
          memkv_ready = true;
        }
        const int v = (xq * 32 + (u - 97)) * 2 + grp; mem_wave(p, 0, v >> 8, v & 3, ((v & 255) >> 2) * 128 + wq * 32, sc2, msh_m, smem);
      }
    }
  }
  grid_barrier(xb, false);

  {
    int mti, nti;
    for (int rd = 0; gemm_sched(rd, 4, mti, nti); ++rd) out_tile(p, p.W2t, true, mti, nti, smem);
  }
  grid_barrier(xb, false);

  proj_phase(p, 1, smem);
  grid_barrier(xb, false);

  {
    const float mqm = wave_max(fabsf(p.mem_q_norm[64 + lane])), mkm = wave_max(fabsf(p.mem_k_norm[64 + lane]));
    const float sc2 = 0.125f * LOG2E, msh_m = 8.f * mqm * mkm * LOG2E;
    for (int u = bid + nb * wid; u < 6144 + 2048; u += nb * 8) {
      if (u < 6144) { const int qb = 63 - u / 96, rem = u % 96, bh = rem >> 2; sb_wave(p, bh / 12, bh % 12, qb * 128 + (rem & 3) * 32, smem); }
      else { const int v = u - 6144, rem = v & 1023; mem_wave(p, 1, v >> 10, (rem >> 2) & 3, (rem >> 4) * 128 + (rem & 3) * 32, sc2, msh_m, smem); }
    }
  }
  grid_barrier(xb, true);

  {
    int mti, nti;
    for (int rd = 0; gemm_sched(rd, 4, mti, nti); ++rd) out_tile(p, p.W4t, false, mti, nti, smem);
  }
}

extern "C" void kernel_launch(void* const* d_in, const int* in_sizes, int n_in, void* d_out, int out_size, void* d_ws, size_t ws_size, hipStream_t stream) {
  static int grid_blocks = 0;
  if (!grid_blocks) {
    int dev = 0, cus = 0, per_cu = 0;
    (void)hipGetDevice(&dev);
    (void)hipDeviceGetAttribute(&cus, hipDeviceAttributeMultiprocessorCount, dev);
    (void)hipFuncSetAttribute((const void*)yoco_fwd, hipFuncAttributeMaxDynamicSharedMemorySize, LDS_BYTES);
    (void)hipOccupancyMaxActiveBlocksPerMultiprocessor(&per_cu, yoco_fwd, NT, LDS_BYTES);
    if (per_cu > 1) per_cu = 1;
    if (per_cu < 1) per_cu = 1;
    grid_blocks = cus * per_cu;
  }
  Params p;
  memset(&p, 0, sizeof(p));
  const float* const* in = (const float* const*)d_in;
  p.x = in[0]; p.mem = in[1]; p.pos = (const int*)d_in[2];
  p.a_q_norm = in[5]; p.a_k_norm = in[6]; p.lq1 = in[7]; p.lk1 = in[8]; p.lq2 = in[9]; p.lk2 = in[10]; p.a_subln = in[11];
  p.mem_q_norm = in[20]; p.mem_k_norm = in[21];
  p.out = (float*)d_out;
  char* w = (char*)d_ws;
  size_t off = 0;
  auto take = [&](size_t bytes) { char* q = w + off; off += (bytes + 255) & ~(size_t)255; return q; };
  p.ctr = (int*)take(1024);
  p.xbw = (unsigned*)take(32768);
  p.P = (bf16_t*)take((size_t)NTOK * NP * 2);
  p.Vt = (bf16_t*)take((size_t)2 * 768 * SEQ * 2);
  p.xb = (bf16_t*)take((size_t)NTOK * DM * 2);
  p.y = (bf16_t*)take((size_t)NTOK * DM * 2);
  p.Ksb = (bf16_t*)take((size_t)2 * 768 * SEQ * 2);
  p.W1t = (bf16_t*)take((size_t)3584 * DM * 2);
  p.W2t = (bf16_t*)take((size_t)1024 * DM * 2);
  p.W3t = (bf16_t*)take((size_t)3584 * DM * 2);
  p.W4t = (bf16_t*)take((size_t)1024 * DM * 2);
  p.Wmt = (bf16_t*)take((size_t)2 * 512 * DM * 2);
  p.memb = (bf16_t*)take((size_t)512 * DM * 2);
  p.Km = (bf16_t*)take((size_t)2 * 512 * 256 * 2);
  p.Vmt = (bf16_t*)take((size_t)2 * 512 * 256 * 2);
  p.ssq0 = (float*)take((size_t)NTOK * 16 * 4);
  p.ssq1 = (float*)take((size_t)NTOK * 16 * 4);
  p.ssqm = (float*)take((size_t)512 * 16 * 4);
  p.cs = (float*)take((size_t)NTOK * 16 * 4);
  const float* a_norm = in[3]; const float* a_w_in = in[4]; const float* a_w_out = in[12]; const float* kv_norm = in[13]; const float* w_kv = in[14];
  const float* b_norm = in[15]; const float* b_w_in = in[16]; const float* b_w_out = in[17]; const float* mem_norm = in[18]; const float* mem_w_kv = in[19];
  auto setseg = [&](int i, const float* src, const float* gain, bf16_t* dst, int ld, int col0, int ncols) {
    p.seg[i].src = src; p.seg[i].gain = gain; p.seg[i].dst = dst; p.seg[i].ld = ld; p.seg[i].col0 = col0; p.seg[i].ncols = ncols; p.seg[i].pad = 0; };
  setseg(0, a_w_in, a_norm, p.W1t, 3584, 0, 3584);
  setseg(1, a_w_out, nullptr, p.W2t, 1024, 0, 1024);
  setseg(2, b_w_in, b_norm, p.W3t, 2048, 0, 768);
  setseg(3, w_kv, kv_norm, p.W3t + (size_t)768 * DM, 1536, 0, 1536);
  setseg(4, b_w_in, b_norm, p.W3t + (size_t)2304 * DM, 2048, 768, 1280);
  setseg(5, b_w_out, nullptr, p.W4t, 1024, 0, 1024);
  setseg(6, mem_w_kv, mem_norm, p.Wmt, 512, 0, 512);
  setseg(7, mem_w_kv + (size_t)1024 * 512, mem_norm + 1024, p.Wmt + (size_t)512 * DM, 512, 0, 512);
  for (int i = 0; i < 8; ++i) p.inv[i] = (float)pow(500000.0, -(double)i / 8.0);
  void* args[] = {&p};
  hipError_t e = hipLaunchCooperativeKernel((const void*)yoco_fwd, dim3(grid_blocks), dim3(NT), args, LDS_BYTES, stream);
  if (e != hipSuccess) fprintf(stderr, "cooperative launch failed: %s (grid %d)\n", hipGetErrorString(e), grid_blocks);
}
```

```cpp
#include <hip/hip_runtime.h>
#include <hip/hip_cooperative_groups.h>
#include <cstdio>
#include <cmath>
#include <cstring>
namespace cg = cooperative_groups;

typedef unsigned short bf16_t;
typedef short bf16x8 __attribute__((ext_vector_type(8)));
typedef short bf16x4 __attribute__((ext_vector_type(4)));
typedef float f32x16 __attribute__((ext_vector_type(16)));
typedef float f32x4 __attribute__((ext_vector_type(4)));
typedef float f32x2 __attribute__((ext_vector_type(2)));
typedef unsigned u32x4 __attribute__((ext_vector_type(4)));
typedef unsigned u32x2 __attribute__((ext_vector_type(2)));
typedef __bf16 bf2_t __attribute__((ext_vector_type(2)));

#define DI __device__ __forceinline__
#define MFMA32(a, b, c) __builtin_amdgcn_mfma_f32_32x32x16_bf16((a), (b), (c), 0, 0, 0)

constexpr int SEQ = 8192, DM = 1024, NTOK = 16384, NP = 3584;
constexpr int NT = 512;
constexpr float EPS = 1e-6f;
constexpr int LDS_ELEMS = 2 * 512 * 72;
constexpr int LDS_BYTES = LDS_ELEMS * 2 + 16;

struct Seg { const float* src; const float* gain; bf16_t* dst; int ld; int col0; int ncols; int pad; };

struct Params {
  const float* x; const float* mem; const int* pos;
  const float* a_q_norm; const float* a_k_norm; const float* lq1; const float* lk1; const float* lq2; const float* lk2; const float* a_subln;
  const float* mem_q_norm; const float* mem_k_norm;
  float* out;
  bf16_t* xb; bf16_t* memb; bf16_t* P; bf16_t* Vt; bf16_t* y;
  bf16_t* Ksb; bf16_t* W1t; bf16_t* W2t; bf16_t* W3t; bf16_t* W4t; bf16_t* Wmt; bf16_t* Km; bf16_t* Vmt;
  float* ssq0; float* ssq1; float* ssqm; float* cs; int* ctr; unsigned* xbw;
  Seg seg[8];
  float inv[8];
};

DI unsigned pk2(float a, float b) { f32x2 v = {a, b}; bf2_t r = __builtin_convertvector(v, bf2_t); return __builtin_bit_cast(unsigned, r); }
DI bf16_t f2bf(float a) { return (bf16_t)(pk2(a, 0.f) & 0xffffu); }
DI float bflo(unsigned w) { return __uint_as_float(w << 16); }
DI float bfhi(unsigned w) { return __uint_as_float(w & 0xffff0000u); }
DI int crow(int reg, int h) { return (reg & 3) + 8 * (reg >> 2) + 4 * h; }
DI int perm16(int kk) { return ((kk >> 2) & 1) * 8 + (kk >> 3) * 4 + (kk & 3); }
DI bf16x8 pack8(const float* v) {
  u32x4 w; w.x = pk2(v[0], v[1]); w.y = pk2(v[2], v[3]); w.z = pk2(v[4], v[5]); w.w = pk2(v[6], v[7]);
  return __builtin_bit_cast(bf16x8, w);
}
DI int opaque_tid() { int t = threadIdx.x; asm volatile("" : "+v"(t)); return t; }
DI f32x16 zero16() { f32x16 z; for (int i = 0; i < 16; ++i) z[i] = 0.f; return z; }

__device__ void phase0(const Params& p, bf16_t* smem) {
  const int tid = opaque_tid(), lane = tid & 63, wid = tid >> 6, nb = gridDim.x, bid = blockIdx.x;
  for (int row0 = (bid * 8 + wid) * 2; row0 < NTOK + 512; row0 += nb * 16) {
    f32x4 v[2][4];
#pragma unroll
    for (int q = 0; q < 2; ++q) {
      const int row = row0 + q;
      const float* src = (row < NTOK) ? p.x + (size_t)row * DM : p.mem + (size_t)(row - NTOK) * DM;
#pragma unroll
      for (int j = 0; j < 4; ++j) v[q][j] = *(const f32x4*)(src + 256 * j + 4 * lane);
    }
#pragma unroll
    for (int q = 0; q < 2; ++q) {
      const int row = row0 + q;
      bf16_t* dst; float* sq;
      if (row < NTOK) { dst = p.xb + (size_t)row * DM; sq = p.ssq0 + (size_t)row * 16; }
      else { const int r2 = row - NTOK; dst = p.memb + (size_t)r2 * DM; sq = p.ssqm + (size_t)r2 * 16; }
#pragma unroll
      for (int j = 0; j < 4; ++j) {
        const f32x4 t = v[q][j];
        float s = t.x * t.x + t.y * t.y + t.z * t.z + t.w * t.w;
        u32x2 w; w.x = pk2(t.x, t.y); w.y = pk2(t.z, t.w);
        *(u32x2*)(dst + 256 * j + 4 * lane) = w;
        s += __shfl_xor(s, 1); s += __shfl_xor(s, 2); s += __shfl_xor(s, 4); s += __shfl_xor(s, 8);
        if ((lane & 15) == 0) sq[4 * j + (lane >> 4)] = s;
      }
    }
  }
  for (int i = bid * NT + tid; i < NTOK * 8; i += nb * NT) {
    const int token = i >> 3, f = i & 7;
    const float ang = (float)p.pos[token] * p.inv[f];
    double rev = (double)ang * 0.15915494309189535;
    rev -= floor(rev);
    const double q4 = rint(rev * 4.0);
    const double a = (rev - q4 * 0.25) * 6.283185307179586;
    const int q = ((int)q4) & 3;
    const double a2 = a * a;
    double sn = -1.0 / 39916800.0; sn = sn * a2 + 1.0 / 362880.0; sn = sn * a2 - 1.0 / 5040.0; sn = sn * a2 + 1.0 / 120.0; sn = sn * a2 - 1.0 / 6.0; sn = sn * a2 + 1.0; sn *= a;
    double cn = 1.0 / 479001600.0; cn = cn * a2 - 1.0 / 3628800.0; cn = cn * a2 + 1.0 / 40320.0; cn = cn * a2 - 1.0 / 720.0; cn = cn * a2 + 1.0 / 24.0; cn = cn * a2 - 0.5; cn = cn * a2 + 1.0;
    double c, s;
    if (q == 0) { c = cn; s = sn; } else if (q == 1) { c = -sn; s = cn; } else if (q == 2) { c = -cn; s = -sn; } else { c = sn; s = -cn; }
    p.cs[(size_t)token * 16 + f] = (float)c;
    p.cs[(size_t)token * 16 + 8 + f] = (float)s;
  }
  {
    f32x4 nv[2]; float ng[2]; bf16_t* ndst = nullptr;
    auto fetch = [&](int t) {
      int ct = t >> 4; const int k0 = (t & 15) * 64;
      int si = 0;
      while (ct >= (p.seg[si].ncols >> 6)) { ct -= (p.seg[si].ncols >> 6); ++si; }
      const Seg sg = p.seg[si];
      const int n0 = ct * 64;
#pragma unroll
      for (int j = 0; j < 2; ++j) {
        const int i = tid + NT * j, kr = i >> 4, c4 = i & 15;
        nv[j] = *(const f32x4*)(sg.src + (size_t)(k0 + kr) * sg.ld + sg.col0 + n0 + c4 * 4);
        ng[j] = sg.gain ? sg.gain[k0 + kr] : 1.f;
      }
      ndst = sg.dst + (size_t)(n0 + (tid >> 3)) * DM + k0 + (tid & 7) * 8;
    };
    if (bid < 2560) fetch(bid);
    for (int t = bid; t < 2560; t += nb) {
      const f32x4 v0 = nv[0], v1 = nv[1]; const float g0 = ng[0], g1 = ng[1]; bf16_t* dst = ndst;
      if (t + nb < 2560) fetch(t + nb);
      __syncthreads();
      {
        const int kr = tid >> 4, c4 = tid & 15;
        smem[(c4 * 4 + 0) * 72 + kr] = f2bf(v0.x * g0); smem[(c4 * 4 + 1) * 72 + kr] = f2bf(v0.y * g0);
        smem[(c4 * 4 + 2) * 72 + kr] = f2bf(v0.z * g0); smem[(c4 * 4 + 3) * 72 + kr] = f2bf(v0.w * g0);
        smem[(c4 * 4 + 0) * 72 + kr + 32] = f2bf(v1.x * g1); smem[(c4 * 4 + 1) * 72 + kr + 32] = f2bf(v1.y * g1);
        smem[(c4 * 4 + 2) * 72 + kr + 32] = f2bf(v1.z * g1); smem[(c4 * 4 + 3) * 72 + kr + 32] = f2bf(v1.w * g1);
      }
      __syncthreads();
      *(u32x4*)dst = *(const u32x4*)(smem + (tid >> 3) * 72 + (tid & 7) * 8);
    }
  }
  __syncthreads();
}

template <int MT>
DI void gemm_core(const bf16_t* __restrict__ Wt, const bf16_t* __restrict__ X, int n0, int m0, f32x16 (&acc)[2][MT], bf16_t* smem) {
  const int tid = opaque_tid(), lane = tid & 63, wid = tid >> 6, wn = wid >> 1, wm = wid & 1, r = lane & 31, h = lane >> 5;
  bf16_t* Ws = smem;
  bf16_t* Xs = smem + 2 * 256 * 72;
  const char* wub = (const char*)(Wt + (size_t)n0 * DM);
  const char* xub = (const char*)(X + (size_t)m0 * DM);
  const unsigned voff = (unsigned)(((tid >> 3) * DM + (tid & 7) * 8) * 2);
#define GLD_W(i, k) (*(const u32x4*)(wub + ((size_t)(i) * 64 * DM * 2 + (size_t)(k) * 128) + voff))
#define GLD_X(i, k) (*(const u32x4*)(xub + ((size_t)(i) * 64 * DM * 2 + (size_t)(k) * 128) + voff))
  const int so = (tid >> 3) * 72 + (tid & 7) * 8;
  u32x4 wr[4], xr[MT];
#pragma unroll
  for (int i = 0; i < 4; ++i) wr[i] = GLD_W(i, 0);
#pragma unroll
  for (int i = 0; i < MT; ++i) xr[i] = GLD_X(i, 0);
  __syncthreads();
#pragma unroll
  for (int i = 0; i < 4; ++i) *(u32x4*)(Ws + so + i * 64 * 72) = wr[i];
#pragma unroll
  for (int i = 0; i < MT; ++i) *(u32x4*)(Xs + so + i * 64 * 72) = xr[i];
#pragma unroll
  for (int i = 0; i < 4; ++i) wr[i] = GLD_W(i, 1);
#pragma unroll
  for (int i = 0; i < MT; ++i) xr[i] = GLD_X(i, 1);
  __syncthreads();
  const int ao = (wn * 64 + r) * 72 + h * 8, bo = (wm * (MT * 32) + r) * 72 + h * 8;
  for (int kt = 0; kt < 16; ++kt) {
    const int cur = (kt & 1) * 256 * 72, nxt = ((kt + 1) & 1) * 256 * 72;
#pragma unroll
    for (int s = 0; s < 4; ++s) {
      bf16x8 a[2], b[MT];
#pragma unroll
      for (int nt = 0; nt < 2; ++nt) a[nt] = *(const bf16x8*)(Ws + cur + ao + nt * 32 * 72 + s * 16);
#pragma unroll
      for (int mt = 0; mt < MT; ++mt) b[mt] = *(const bf16x8*)(Xs + cur + bo + mt * 32 * 72 + s * 16);
      if (kt + 1 < 16) {
        *(u32x4*)(Ws + nxt + so + s * 64 * 72) = wr[s];
        if (s < MT) *(u32x4*)(Xs + nxt + so + s * 64 * 72) = xr[s < MT ? s : 0];
        if (kt + 2 < 16) {
          wr[s] = GLD_W(s, kt + 2);
          if (s < MT) xr[s < MT ? s : 0] = GLD_X(s, kt + 2);
        }
      }
#pragma unroll
      for (int nt = 0; nt < 2; ++nt)
#pragma unroll
        for (int mt = 0; mt < MT; ++mt) acc[nt][mt] = MFMA32(a[nt], b[mt], acc[nt][mt]);
    }
    __syncthreads();
  }
}

DI float row_rinv(const float* ssq, int token) {
  const f32x4* q = (const f32x4*)(ssq + (size_t)token * 16);
  const f32x4 a = q[0], b = q[1], c = q[2], d = q[3];
  const float s = ((a.x + a.y) + (a.z + a.w)) + ((b.x + b.y) + (b.z + b.w)) + ((c.x + c.y) + (c.z + c.w)) + ((d.x + d.y) + (d.z + d.w));
  return rsqrtf(s * (1.f / 1024.f) + EPS);
}

enum { EK_QKROPE = 0, EK_NORM = 1, EK_PLAIN = 2, EK_VT = 3, EK_SILU = 4, EK_VBLK = 5 };

template <int MT>
DI void epi_proj(const f32x16 (&acc)[2][MT], int kind, const float* __restrict__ ssq0, const float* __restrict__ gain, const float* __restrict__ cs0,
                 bf16_t* __restrict__ dbase, int ld, bf16_t* __restrict__ vbase, int vt_ld, bf16_t* smem, float qscale) {
  const int tid = opaque_tid(), lane = tid & 63, wid = tid >> 6, r = lane & 31, h = lane >> 5;
  bf16_t* wreg = smem + wid * 9216;
#pragma unroll
  for (int mt = 0; mt < MT; ++mt) {
    const float rs = row_rinv(ssq0, mt * 32);
    float v[2][16];
#pragma unroll
    for (int nt = 0; nt < 2; ++nt)
#pragma unroll
      for (int i = 0; i < 16; ++i) v[nt][i] = acc[nt][mt][i] * rs;
    if (kind <= EK_NORM) {
      float ss = 0.f;
#pragma unroll
      for (int nt = 0; nt < 2; ++nt)
#pragma unroll
        for (int i = 0; i < 16; ++i) ss += v[nt][i] * v[nt][i];
      ss += __shfl_xor(ss, 32);
      const float rn = rsqrtf(ss * (1.f / 64.f) + EPS);
#pragma unroll
      for (int nt = 0; nt < 2; ++nt)
#pragma unroll
        for (int g = 0; g < 4; ++g) {
          const f32x4 gg = *(const f32x4*)(gain + nt * 32 + 8 * g + 4 * h);
          v[nt][4 * g + 0] *= rn * gg.x; v[nt][4 * g + 1] *= rn * gg.y; v[nt][4 * g + 2] *= rn * gg.z; v[nt][4 * g + 3] *= rn * gg.w;
        }
      if (kind == EK_QKROPE) {
        const f32x4 c = *(const f32x4*)(cs0 + mt * 32 * 16 + 4 * h);
        const f32x4 s = *(const f32x4*)(cs0 + mt * 32 * 16 + 8 + 4 * h);
#pragma unroll
        for (int i = 0; i < 4; ++i) {
          const float x1 = v[0][i], x2 = v[0][4 + i];
          v[0][i] = x1 * c[i] - x2 * s[i];
          v[0][4 + i] = x2 * c[i] + x1 * s[i];
        }
#pragma unroll
        for (int nt = 0; nt < 2; ++nt)
#pragma unroll
          for (int i = 0; i < 16; ++i) v[nt][i] *= qscale;
      }
    } else if (kind == EK_PLAIN) {
#pragma unroll
      for (int nt = 0; nt < 2; ++nt)
#pragma unroll
        for (int i = 0; i < 16; ++i) v[nt][i] *= qscale;
    } else if (kind == EK_SILU) {
#pragma unroll
      for (int nt = 0; nt < 2; ++nt)
#pragma unroll
        for (int i = 0; i < 16; ++i) v[nt][i] = v[nt][i] * __builtin_amdgcn_rcpf(1.f + __builtin_amdgcn_exp2f(-1.4426950408889634f * v[nt][i]));
    }
    if (kind == EK_VT || kind == EK_VBLK) {
#pragma unroll
      for (int nt = 0; nt < 2; ++nt)
#pragma unroll
        for (int i = 0; i < 16; ++i) wreg[(nt * 32 + crow(i, h)) * 136 + mt * 32 + (r & 16) + perm16(r & 15)] = f2bf(v[nt][i]);
    } else {
#pragma unroll
      for (int nt = 0; nt < 2; ++nt)
#pragma unroll
        for (int g = 0; g < 4; ++g) {
          u32x2 w; w.x = pk2(v[nt][4 * g], v[nt][4 * g + 1]); w.y = pk2(v[nt][4 * g + 2], v[nt][4 * g + 3]);
          *(u32x2*)(wreg + (mt * 32 + r) * 72 + nt * 32 + 8 * g + 4 * h) = w;
        }
    }
  }
  __syncthreads();
  constexpr int CPR = MT * 4, RPI = 64 / CPR;
  if (kind == EK_VT) {
#pragma unroll
    for (int j = 0; j < CPR; ++j) {
      const int n = j * RPI + lane / CPR, c = lane % CPR;
      *(u32x4*)(vbase + (size_t)n * vt_ld + c * 8) = *(const u32x4*)(wreg + n * 136 + c * 8);
    }
  } else if (kind == EK_VBLK) {
#pragma unroll
    for (int j = 0; j < CPR; ++j) {
      const int n = j * RPI + lane / CPR, c = lane % CPR;
      *(u32x4*)(vbase + (size_t)(c >> 2) * 2048 + n * 32 + (c & 3) * 8) = *(const u32x4*)(wreg + n * 136 + c * 8);
    }
  } else {
#pragma unroll
    for (int j = 0; j < MT * 4; ++j) {
      const int row = j * 8 + (lane >> 3), c = lane & 7;
      *(u32x4*)(dbase + (size_t)row * ld + c * 8) = *(const u32x4*)(wreg + row * 72 + c * 8);
    }
  }
}

template <int MT>
DI void zero_acc(f32x16 (&acc)[2][MT]) {
#pragma unroll
  for (int a = 0; a < 2; ++a)
#pragma unroll
    for (int b = 0; b < MT; ++b) acc[a][b] = zero16();
}

template <int MT>
__device__ void proj_tile(const Params& p, int layer, int m0, int nti, bf16_t* smem) {
  const int tid = opaque_tid(), lane = tid & 63, wid = tid >> 6, wn = wid >> 1, wm = wid & 1, r = lane & 31, h = lane >> 5;
  const int n0 = nti * 256;
  f32x16 acc[2][MT];
  zero_acc<MT>(acc);
  gemm_core<MT>(layer ? p.W3t : p.W1t, p.xb, n0, m0, acc, smem);
  const float* ssq = layer ? p.ssq1 : p.ssq0;
  const int tok = m0 + wm * (MT * 32) + r;
  const int cc = n0 + wn * 64;
  int kind; const float* gain = p.a_q_norm;
  if (cc < 1536) { kind = layer ? EK_PLAIN : EK_QKROPE; gain = (cc < 768) ? p.a_q_norm : p.a_k_norm; }
  else if (cc < 2304) kind = EK_VT;
  else if (cc < 2560) { kind = EK_NORM; gain = p.mem_q_norm + layer * 64; }
  else kind = EK_SILU;
  const int tok0 = m0 + wm * (MT * 32), b = tok0 >> 13;
  bf16_t* vtb = p.Vt + ((size_t)b * 768 + (cc - 1536)) * SEQ + (tok0 & (SEQ - 1));
  bf16_t* dbase = p.P + (size_t)tok0 * NP + cc;
  int ld = NP;
  if (layer && cc >= 768 && cc < 1536) {
    dbase = p.Ksb + (((size_t)b * 12 + ((cc - 768) >> 6)) * SEQ + (tok0 & (SEQ - 1))) * 64; ld = 64;
  } else if (layer && kind == EK_VT) {
    kind = EK_VBLK;
    vtb = p.Vt + (((size_t)b * 12 + ((cc - 1536) >> 6)) * 256 + ((tok0 & (SEQ - 1)) >> 5)) * 2048;
  }
  epi_proj<MT>(acc, kind, ssq + (size_t)tok * 16, gain, p.cs + (size_t)tok * 16, dbase, ld, vtb, SEQ, smem, (cc < 768) ? 0.125f * 1.4426950408889634f : 1.f);
}

__device__ void mem_tile(const Params& p, int l, int mti, int nti, bf16_t* smem) {
  const int tid = opaque_tid(), lane = tid & 63, wid = tid >> 6, wn = wid >> 1, wm = wid & 1, r = lane & 31, h = lane >> 5;
  const int m0 = mti * 256, n0 = nti * 256;
  f32x16 acc[2][4];
  zero_acc<4>(acc);
  gemm_core<4>(p.Wmt + (size_t)l * 512 * DM, p.memb, n0, m0, acc, smem);
  const int tok = m0 + wm * 128 + r;
  const int cc = n0 + wn * 64;
  const int kind = (cc < 256) ? EK_NORM : EK_VT;
  const int tok0 = m0 + wm * 128, b = tok0 >> 8;
  bf16_t* vtb = p.Vmt + ((size_t)(l * 2 + b) * 256 + (cc - 256)) * 256 + (tok0 & 255);
  epi_proj<4>(acc, kind, p.ssqm + (size_t)tok * 16, p.mem_k_norm + l * 64, p.cs, p.Km + ((size_t)l * 512 + tok0) * 256 + cc, 256, vtb, 256, smem, 1.f);
}

__device__ void out_tile(const Params& p, const bf16_t* Wt, bool first, int mti, int nti, bf16_t* smem) {
  const int tid = opaque_tid(), lane = tid & 63, wid = tid >> 6, wn = wid >> 1, wm = wid & 1, r = lane & 31, h = lane >> 5;
  const int m0 = mti * 256, n0 = nti * 256;
  f32x16 acc[2][4];
  zero_acc<4>(acc);
  gemm_core<4>(Wt, p.y, n0, m0, acc, smem);
  const int cc = n0 + wn * 64;
  float* freg = (float*)smem + wid * 4608;
#pragma unroll
  for (int half = 0; half < 2; ++half) {
#pragma unroll
    for (int mtl = 0; mtl < 2; ++mtl)
#pragma unroll
      for (int nt = 0; nt < 2; ++nt)
#pragma unroll
        for (int g = 0; g < 4; ++g) {
          f32x4 o; o.x = acc[nt][half * 2 + mtl][4 * g + 0]; o.y = acc[nt][half * 2 + mtl][4 * g + 1]; o.z = acc[nt][half * 2 + mtl][4 * g + 2]; o.w = acc[nt][half * 2 + mtl][4 * g + 3];
          *(f32x4*)(freg + (mtl * 32 + r) * 68 + nt * 32 + 8 * g + 4 * h) = o;
        }
    __syncthreads();
#pragma unroll
    for (int j = 0; j < 16; ++j) {
      const int row = j * 4 + (lane >> 4), c = lane & 15;
      const int tok = m0 + wm * 128 + half * 64 + row;
      const size_t off = (size_t)tok * DM + cc + c * 4;
      const f32x4 a = *(const f32x4*)(freg + row * 68 + c * 4);
      f32x4 o;
      if (first) {
        o = *(const f32x4*)(p.x + off);
        o.x += a.x; o.y += a.y; o.z += a.z; o.w += a.w;
        u32x2 w; w.x = pk2(o.x, o.y); w.y = pk2(o.z, o.w);
        *(u32x2*)(p.xb + off) = w;
        float ss = o.x * o.x + o.y * o.y + o.z * o.z + o.w * o.w;
        ss += __shfl_xor(ss, 1); ss += __shfl_xor(ss, 2); ss += __shfl_xor(ss, 4); ss += __shfl_xor(ss, 8);
        if (c == 0) p.ssq1[(size_t)tok * 16 + (cc >> 6)] = ss;
      } else {
        const u32x2 w = *(const u32x2*)(p.xb + off);
        o.x = bflo(w.x) + a.x; o.y = bfhi(w.x) + a.y; o.z = bflo(w.y) + a.z; o.w = bfhi(w.y) + a.w;
        *(f32x4*)(p.out + off) = o;
      }
      if ((j & 3) == 3) __builtin_amdgcn_sched_barrier(0);
    }
    __syncthreads();
  }
}

template <int NDT>
DI void store_gated(const f32x16 (&O)[NDT], float* reg, const bf16_t* __restrict__ grow0, bf16_t* __restrict__ yrow0, const float* __restrict__ gain, int lane) {
  constexpr int RS = NDT * 32 + 4, LPR = NDT * 8, RPI = 64 / LPR;
  const int r = lane & 31, h = lane >> 5;
#pragma unroll
  for (int dvt = 0; dvt < NDT; ++dvt)
#pragma unroll
    for (int g = 0; g < 4; ++g) {
      f32x4 o; o.x = O[dvt][4 * g + 0]; o.y = O[dvt][4 * g + 1]; o.z = O[dvt][4 * g + 2]; o.w = O[dvt][4 * g + 3];
      *(f32x4*)(reg + r * RS + dvt * 32 + 8 * g + 4 * h) = o;
    }
  asm volatile("s_waitcnt lgkmcnt(0)" ::: "memory");
  const int c = lane % LPR;
  f32x4 gg; gg.x = 1.f; gg.y = 1.f; gg.z = 1.f; gg.w = 1.f;
  if (gain) gg = *(const f32x4*)(gain + c * 4);
#pragma unroll
  for (int j = 0; j < 32 / RPI; ++j) {
    const int row = j * RPI + lane / LPR;
    const f32x4 v = *(const f32x4*)(reg + row * RS + c * 4);
    const u32x2 gw = *(const u32x2*)(grow0 + (size_t)row * NP + c * 4);
    u32x2 w;
    w.x = pk2(v.x * gg.x * bflo(gw.x), v.y * gg.y * bfhi(gw.x));
    w.y = pk2(v.z * gg.z * bflo(gw.y), v.w * gg.w * bfhi(gw.y));
    *(u32x2*)(yrow0 + (size_t)row * DM + c * 4) = w;
  }
  asm volatile("s_waitcnt lgkmcnt(0)" ::: "memory");
}

__device__ void attn_a_unit(const Params& p, int b, int hd, int qb, bf16_t* smem, float lam, float msh) {
  const int tid = opaque_tid(), lane = tid & 63, wid = tid >> 6, r = lane & 31, h = lane >> 5, grp = wid >> 2, wq = wid & 3;
  const bf16_t* Pb = p.P + (size_t)b * SEQ * NP;
  const bf16_t* Vb = p.Vt + ((size_t)b * 768 + hd * 128) * SEQ;
  const int q0 = qb * 128 + wq * 32;
  bf16x8 qf[4];
#pragma unroll
  for (int s = 0; s < 4; ++s) qf[s] = *(const bf16x8*)(Pb + (size_t)(q0 + r) * NP + grp * 384 + hd * 64 + s * 16 + h * 8);
  f32x16 O[4];
#pragma unroll
  for (int i = 0; i < 4; ++i) O[i] = zero16();
  float l = 0.f;
  const int nkt = 2 * (qb + 1);
  constexpr int VOFF = 9216, SSTR = 18432;
  const char* kub = (const char*)(Pb + 768 + hd * 64);
  const char* vub = (const char*)Vb;
  const unsigned kvo = (unsigned)(((tid >> 3) * NP + (tid & 7) * 8) * 2);
  const unsigned vvo = (unsigned)(((tid >> 3) * SEQ + (tid & 7) * 8) * 2);
#define GLD_K(i, t) (*(const u32x4*)(kub + ((size_t)(t) * 64 * NP * 2 + (size_t)(i) * 768) + kvo))
#define GLD_V(i, t) (*(const u32x4*)(vub + ((size_t)(i) * 64 * SEQ * 2 + (size_t)(t) * 128) + vvo))
  const int kso = (tid >> 3) * 72 + (tid & 7) * 8;
  const int vso = VOFF + (tid >> 3) * 72 + (tid & 7) * 8;
  const int kro = grp * 64 * 72 + r * 72 + h * 8;
  const int vro = VOFF + r * 72 + 8 * h;
  u32x4 kr[2], vr[2];
#pragma unroll
  for (int i = 0; i < 2; ++i) { kr[i] = GLD_K(i, 0); vr[i] = GLD_V(i, 0); }
#pragma unroll
  for (int i = 0; i < 2; ++i) {
    *(u32x4*)(smem + kso + i * 64 * 72) = kr[i];
    *(u32x4*)(smem + vso + i * 64 * 72) = vr[i];
  }
#pragma unroll
  for (int i = 0; i < 2; ++i) { kr[i] = GLD_K(i, 1); vr[i] = GLD_V(i, 1); }
  __syncthreads();
  for (int kt = 0; kt < nkt; ++kt) {
    const int cur = (kt & 1) * SSTR, nxt = ((kt + 1) & 1) * SSTR;
    if (kt + 1 < nkt) {
#pragma unroll
      for (int i = 0; i < 2; ++i) {
        *(u32x4*)(smem + nxt + kso + i * 64 * 72) = kr[i];
        *(u32x4*)(smem + nxt + vso + i * 64 * 72) = vr[i];
      }
      if (kt + 2 < nkt) {
#pragma unroll
        for (int i = 0; i < 2; ++i) { kr[i] = GLD_K(i, kt + 2); vr[i] = GLD_V(i, kt + 2); }
      }
    }
    const int k0 = kt * 64;
    if (k0 <= q0 + 31) {
      bf16x8 kfr[8], vfa[8], vfb[8];
#pragma unroll
      for (int s = 0; s < 8; ++s) kfr[s] = *(const bf16x8*)(smem + cur + kro + (s >> 2) * 32 * 72 + (s & 3) * 16);
      __builtin_amdgcn_sched_barrier(0);
      f32x16 S0 = zero16(), S1 = zero16();
#pragma unroll
      for (int s = 0; s < 4; ++s) S0 = MFMA32(kfr[s], qf[s], S0);
#pragma unroll
      for (int s = 0; s < 8; ++s) vfa[s] = *(const bf16x8*)(smem + cur + vro + (s >> 1) * 32 * 72 + (s & 1) * 16);
#pragma unroll
      for (int s = 0; s < 4; ++s) S1 = MFMA32(kfr[4 + s], qf[s], S1);
      __builtin_amdgcn_sched_barrier(0);
      const int dq = q0 + r - k0 - 4 * h;
      float pv[16]; bf16x8 pk[2];
#pragma unroll
      for (int s = 0; s < 8; ++s) vfb[s] = *(const bf16x8*)(smem + cur + vro + (s >> 1) * 32 * 72 + 32 + (s & 1) * 16);
#pragma unroll
      for (int i = 0; i < 16; ++i) pv[i] = __builtin_amdgcn_exp2f(S0[i]);
      if (k0 + 31 > q0) {
#pragma unroll
        for (int i = 0; i < 16; ++i) if ((i & 3) + 8 * (i >> 2) > dq) pv[i] = 0.f;
      }
#pragma unroll
      for (int i = 0; i < 16; ++i) l += pv[i];
      pk[0] = pack8(pv); pk[1] = pack8(pv + 8);
      __builtin_amdgcn_sched_barrier(0);
#pragma unroll
      for (int s = 0; s < 8; ++s) O[s >> 1] = MFMA32(vfa[s], pk[s & 1], O[s >> 1]);
#pragma unroll
      for (int i = 0; i < 16; ++i) pv[i] = __builtin_amdgcn_exp2f(S1[i]);
      if (k0 + 63 > q0) {
#pragma unroll
        for (int i = 0; i < 16; ++i) if (32 + (i & 3) + 8 * (i >> 2) > dq) pv[i] = 0.f;
      }
#pragma unroll
      for (int i = 0; i < 16; ++i) l += pv[i];
      bf16x8 pq[2]; pq[0] = pack8(pv); pq[1] = pack8(pv + 8);
      __builtin_amdgcn_sched_barrier(0);
#pragma unroll
      for (int s = 0; s < 8; ++s) O[s >> 1] = MFMA32(vfb[s], pq[s & 1], O[s >> 1]);
    }
    __syncthreads();
  }
  l += __shfl_xor(l, 32);
  float* xch = (float*)smem + (size_t)wq * 65 * 64 + lane;
  if (grp == 1) {
#pragma unroll
    for (int dvt = 0; dvt < 4; ++dvt)
#pragma unroll
      for (int i = 0; i < 16; ++i) xch[(dvt * 16 + i) * 64] = O[dvt][i];
    xch[64 * 64] = l;
  }
  __syncthreads();
  if (grp == 0) {
    const float i1 = 1.f / l, i2 = lam / xch[64 * 64];
    float ss = 0.f;
#pragma unroll
    for (int dvt = 0; dvt < 4; ++dvt)
#pragma unroll
      for (int i = 0; i < 16; ++i) { const float o = O[dvt][i] * i1 - xch[(dvt * 16 + i) * 64] * i2; O[dvt][i] = o; ss += o * o; }
    ss += __shfl_xor(ss, 32);
    const float rn = rsqrtf(ss * (1.f / 128.f) + EPS) * 0.8f;
#pragma unroll
    for (int dvt = 0; dvt < 4; ++dvt)
#pragma unroll
      for (int i = 0; i < 16; ++i) O[dvt][i] *= rn;
    const size_t tok0 = (size_t)b * SEQ + q0;
    store_gated<4>(O, (float*)smem + 16640 + wq * 4352, p.P + tok0 * NP + 2560 + hd * 128, p.y + tok0 * DM + hd * 128, p.a_subln, lane);
  }
}

__device__ void mem_wave(const Params& p, int l, int b, int mh, int q0, float sc2, float msh, bf16_t* smem) {
  const int tid = opaque_tid(), lane = tid & 63, r = lane & 31, h = lane >> 5;
  const size_t tok = (size_t)b * SEQ + q0 + r;
  const bf16_t* prow = p.P + tok * NP;
  bf16x8 qf[4];
#pragma unroll
  for (int s = 0; s < 4; ++s) qf[s] = *(const bf16x8*)(prow + 2304 + mh * 64 + s * 16 + h * 8);
  const bf16_t* Kl = p.Km + ((size_t)(l * 2 + b) * 256 + r) * 256 + mh * 64 + h * 8;
  const bf16_t* Vl = p.Vmt + ((size_t)(l * 2 + b) * 256 + mh * 64 + r) * 256 + 8 * h;
  f32x16 O[2]; O[0] = zero16(); O[1] = zero16();
  float lsum = 0.f;
  bf16x8 kf[4], vf[4], kn[4], vn[4];
#pragma unroll
  for (int s = 0; s < 4; ++s) { kf[s] = *(const bf16x8*)(Kl + s * 16); vf[s] = *(const bf16x8*)(Vl + (s >> 1) * 32 * 256 + (s & 1) * 16); }
#pragma unroll
  for (int s = 0; s < 4; ++s) { kn[s] = kf[s]; vn[s] = vf[s]; }
  for (int kt = 0; kt < 8; ++kt) {
    if (kt + 1 < 8) {
      const int k1 = (kt + 1) * 32;
#pragma unroll
      for (int s = 0; s < 4; ++s) { kn[s] = *(const bf16x8*)(Kl + (size_t)k1 * 256 + s * 16); vn[s] = *(const bf16x8*)(Vl + (s >> 1) * 32 * 256 + k1 + (s & 1) * 16); }
    }
    __builtin_amdgcn_sched_barrier(0);
    f32x16 S = zero16();
#pragma unroll
    for (int s = 0; s < 4; ++s) S = MFMA32(kf[s], qf[s], S);
    float pv[16];
#pragma unroll
    for (int i = 0; i < 16; ++i) { pv[i] = __builtin_amdgcn_exp2f(S[i] * sc2 - msh); lsum += pv[i]; }
    bf16x8 pk[2]; pk[0] = pack8(pv); pk[1] = pack8(pv + 8);
#pragma unroll
    for (int s = 0; s < 4; ++s) O[s >> 1] = MFMA32(vf[s], pk[s & 1], O[s >> 1]);
#pragma unroll
    for (int s = 0; s < 4; ++s) { kf[s] = kn[s]; vf[s] = vn[s]; }
  }
  lsum += __shfl_xor(lsum, 32);
  const float inv = __builtin_amdgcn_rcpf(lsum);
#pragma unroll
  for (int dvt = 0; dvt < 2; ++dvt)
#pragma unroll
    for (int i = 0; i < 16; ++i) O[dvt][i] *= inv;
  store_gated<2>(O, (float*)smem + (tid >> 6) * 4608, prow - (size_t)r * NP + 2560 + 768 + mh * 64, p.y + (tok - r) * DM + 768 + mh * 64, nullptr, lane);
}

__device__ void sb_wave(const Params& p, int b, int hd, int q0, bf16_t* smem) {
  const int tid = opaque_tid(), lane = tid & 63, r = lane & 31, h = lane >> 5;
  const bf16_t* Pb = p.P + (size_t)b * SEQ * NP;
  const bf16_t* Kl = p.Ksb + (((size_t)b * 12 + hd) * SEQ + r) * 64 + h * 8;
  const bf16_t* Vl = p.Vt + ((size_t)b * 12 + hd) * 256 * 2048 + r * 32 + 8 * h;
  const size_t tok = (size_t)b * SEQ + q0 + r;
  bf16x8 qf[4];
#pragma unroll
  for (int s = 0; s < 4; ++s) qf[s] = *(const bf16x8*)(Pb + (size_t)(q0 + r) * NP + hd * 64 + s * 16 + h * 8);
  f32x16 O[2]; O[0] = zero16(); O[1] = zero16();
  float R = 0.f;
  const int ktd = q0 >> 5;
  bf16x8 kf[4], kn[4], vf[4];
#pragma unroll
  for (int s = 0; s < 4; ++s) { kf[s] = *(const bf16x8*)(Kl + (size_t)q0 * 64 + s * 16); kn[s] = kf[s]; }
  for (int kt = ktd; kt >= 0; --kt) {
    const int k0 = kt * 32;
    const bool diag = (kt == ktd);
#pragma unroll
    for (int s = 0; s < 4; ++s) vf[s] = *(const bf16x8*)(Vl + (size_t)kt * 2048 + (s >> 1) * 32 * 32 + (s & 1) * 16);
    if (kt > 0) {
#pragma unroll
      for (int s = 0; s < 4; ++s) kn[s] = *(const bf16x8*)(Kl + (size_t)(k0 - 32) * 64 + s * 16);
    }
    __builtin_amdgcn_sched_barrier(0);
    f32x16 S = zero16();
#pragma unroll
    for (int s = 0; s < 4; ++s) S = MFMA32(kf[s], qf[s], S);
    float lb[16], f[16];
#pragma unroll
    for (int i = 0; i < 16; ++i) {
      const float z = S[i];
      const float L = __builtin_amdgcn_logf(1.f + __builtin_amdgcn_exp2f(-fabsf(z)));
      const float lbv = fminf(z, 0.f) - L;
      lb[i] = lbv; f[i] = lbv - z;
    }
    if (diag) {
#pragma unroll
      for (int i = 0; i < 16; ++i) if (crow(i, h) >= r) f[i] = 0.f;
    }
    float T[4], PT[4], loc[16];
#pragma unroll
    for (int g = 0; g < 4; ++g) {
      loc[4 * g + 3] = 0.f;
      loc[4 * g + 2] = f[4 * g + 3];
      loc[4 * g + 1] = loc[4 * g + 2] + f[4 * g + 2];
      loc[4 * g + 0] = loc[4 * g + 1] + f[4 * g + 1];
      T[g] = loc[4 * g + 0] + f[4 * g + 0];
    }
#pragma unroll
    for (int g = 0; g < 4; ++g) PT[g] = __shfl_xor(T[g], 32);
    float hg = R;
    float av[16];
#pragma unroll
    for (int g = 3; g >= 0; --g) {
      const float base = hg + (h == 0 ? PT[g] : 0.f);
#pragma unroll
      for (int i = 0; i < 4; ++i) av[4 * g + i] = __builtin_amdgcn_exp2f(lb[4 * g + i] + (base + loc[4 * g + i]));
      hg += T[g] + PT[g];
    }
    if (diag) {
#pragma unroll
      for (int i = 0; i < 16; ++i) if (crow(i, h) >= r) av[i] = 0.f;
    }
    R = hg;
    bf16x8 pk[2]; pk[0] = pack8(av); pk[1] = pack8(av + 8);
#pragma unroll
    for (int s = 0; s < 4; ++s) O[s >> 1] = MFMA32(vf[s], pk[s & 1], O[s >> 1]);
#pragma unroll
    for (int s = 0; s < 4; ++s) kf[s] = kn[s];
    if (__all(R < -104.f * 1.4426950408889634f)) break;
  }
  store_gated<2>(O, (float*)smem + (tid >> 6) * 4608, p.P + (tok - r) * NP + 2560 + hd * 64, p.y + (tok - r) * DM + hd * 64, nullptr, lane);
}

DI float wave_sum(float v) { for (int o = 32; o > 0; o >>= 1) v += __shfl_xor(v, o); return v; }
DI float wave_max(float v) { for (int o = 32; o > 0; o >>= 1) v = fmaxf(v, __shfl_xor(v, o)); return v; }

DI bool gemm_sched(int rd, int ntn, int& mti, int& nti) {
  const int nb = gridDim.x, bid = blockIdx.x;
  if (nb == 256) {
    const int xcd = bid & 7, li = bid >> 3, ti = rd * 32 + li;
    if (ti >= 8 * ntn) return false;
    mti = xcd * 8 + (ti & 7); nti = ti >> 3; return true;
  }
  const int t = rd * nb + bid;
  if (t >= 64 * ntn) return false;
  mti = t / ntn; nti = t % ntn; return true;
}

DI void proj_phase(const Params& p, int layer, bf16_t* smem) {
  const int nb = gridDim.x, bid = blockIdx.x;
  if (nb == 256) {
    const int xcd = bid & 7, li = bid >> 3;
    for (int rd = 0; rd < 3; ++rd) { const int ti = rd * 32 + li; proj_tile<4>(p, layer, (xcd * 8 + (ti & 7)) * 256, ti >> 3, smem); }
    { const int ti = 96 + (li >> 1); proj_tile<2>(p, layer, (xcd * 8 + (ti & 7)) * 256 + (li & 1) * 128, ti >> 3, smem); }
  } else {
    for (int t = bid; t < 64 * 14; t += nb) proj_tile<4>(p, layer, (t / 14) * 256, t % 14, smem);
  }
}

DI unsigned xb_ld(unsigned* q) { return __hip_atomic_load(q, __ATOMIC_RELAXED, __HIP_MEMORY_SCOPE_AGENT); }
DI unsigned xb_add(unsigned* q, unsigned v) { return __hip_atomic_fetch_add(q, v, __ATOMIC_RELAXED, __HIP_MEMORY_SCOPE_AGENT); }
DI void xb_st(unsigned* q, unsigned v) { __hip_atomic_store(q, v, __ATOMIC_RELAXED, __HIP_MEMORY_SCOPE_AGENT); }
struct XB { unsigned* w; unsigned x, nx, nxcc, bsub, bgen, btop, btg, k; };
#define XB_SPIN(cond) do { unsigned sp_ = 0; while (cond) { __builtin_amdgcn_s_sleep(1); if (++sp_ > (1u << 21)) break; } } while (0)
DI void xb_init(XB& b, unsigned* w) {
  b.w = w; b.k = 0; b.nx = 0; b.nxcc = 0;
  b.x = (unsigned)__builtin_amdgcn_s_getreg((3 << 11) | 20) & 0xFu;
  b.bsub = xb_ld(w + 4096 + 1024 + 64 * b.x); b.bgen = xb_ld(w + 4096 + 2048 + 64 * b.x);
  b.btop = xb_ld(w + 4096 + 3072); b.btg = xb_ld(w + 4096 + 3136);
  (void)xb_add(w + 64 * b.x, 1u);
}
DI void grid_barrier(XB& b, bool last) {
  asm volatile("s_waitcnt vmcnt(0)" ::: "memory");
  __syncthreads();
  if (threadIdx.x == 0) {
    unsigned* w = b.w;
    if (b.k == 0) {
      unsigned tot = 0, nx = 0, nxcc = 0, sp = 0;
      for (;;) {
        tot = 0; nx = 0; nxcc = 0;
        for (unsigned j = 0; j < 16; ++j) { const unsigned c = xb_ld(w + 64 * j) - xb_ld(w + 4096 + 64 * j); tot += c; nxcc += (c != 0u); if (j == b.x) nx = c; }
        if (tot == gridDim.x || ++sp > (1u << 18)) break;
        __builtin_amdgcn_s_sleep(1);
      }
      b.nx = nx; b.nxcc = nxcc;
    }
    b.k += 1;
    const unsigned old = xb_add(w + 1024 + 64 * b.x, 1u);
    if (old - b.bsub + 1u == b.k * b.nx) {
      __builtin_amdgcn_fence(__ATOMIC_RELEASE, "agent");
      asm volatile("s_waitcnt vmcnt(0)" ::: "memory");
      const unsigned ot = xb_add(w + 3072, 1u);
      if (ot - b.btop + 1u == b.k * b.nxcc) {
        if (last) { xb_st(w + 4096 + 3072, b.btop + b.k * b.nxcc); xb_st(w + 4096 + 3136, b.btg + b.k); }
        (void)xb_add(w + 3136, 1u);
      }
      XB_SPIN((int)(xb_ld(w + 3136) - b.btg - b.k) < 0);
      if (last) { xb_st(w + 4096 + 64 * b.x, xb_ld(w + 64 * b.x)); xb_st(w + 4096 + 1024 + 64 * b.x, b.bsub + b.k * b.nx); xb_st(w + 4096 + 2048 + 64 * b.x, b.bgen + b.k); }
      (void)xb_add(w + 2048 + 64 * b.x, 1u);
    } else {
      XB_SPIN((int)(xb_ld(w + 2048 + 64 * b.x) - b.bgen - b.k) < 0);
    }
    __builtin_amdgcn_fence(__ATOMIC_ACQUIRE, "agent");
    asm volatile("s_waitcnt vmcnt(0)" ::: "memory");
  }
  __syncthreads();
}

__global__ void __launch_bounds__(512, 2) yoco_fwd(Params p) {
  extern __shared__ __attribute__((aligned(16))) bf16_t smem[];
  cg::grid_group grid = cg::this_grid();
  const int tid = threadIdx.x, lane = tid & 63, wid = tid >> 6, nb = gridDim.x, bid = blockIdx.x, grp = wid >> 2, wq = wid & 3;
  int* s_unit = (int*)(smem + LDS_ELEMS);
  const float LOG2E = 1.4426950408889634f;
  XB xb = {};
  if (tid == 0) xb_init(xb, p.xbw);
  if (bid == 0 && tid < 64) p.ctr[tid] = 0;
  if (p.out == nullptr) grid.sync();

  phase0(p, smem);
  grid_barrier(xb, false);

  proj_phase(p, 0, smem);
  grid_barrier(xb, false);

  {
    const float d1 = wave_sum(p.lq1[lane] * p.lk1[lane]), d2 = wave_sum(p.lq2[lane] * p.lk2[lane]);
    const float lam = __expf(d1) - __expf(d2) + 0.2f;
    const float mqa = wave_max(fabsf(p.a_q_norm[lane])), mka = wave_max(fabsf(p.a_k_norm[lane]));
    const float mqm = wave_max(fabsf(p.mem_q_norm[lane])), mkm = wave_max(fabsf(p.mem_k_norm[lane]));
    const float sc2 = 0.125f * LOG2E;
    const float msh_a = 8.f * mqa * mka * LOG2E, msh_m = 8.f * mqm * mkm * LOG2E;
    unsigned* kvflag = (unsigned*)(p.ctr + 16);
    bool memkv_ready = false;
    const int xq = bid & 7;
    for (;;) {
      __syncthreads();
      if (tid == 0) *s_unit = atomicAdd(&p.ctr[40 + xq], 1);
      __syncthreads();
      const int u = *s_unit;
      if (u >= 1 + 96 + 32) break;
      if (u == 0) {
        mem_tile(p, xq >> 2, (xq >> 1) & 1, xq & 1, smem);
        if (xq < 4) {
          asm volatile("s_waitcnt vmcnt(0)" ::: "memory");
          __syncthreads();
          if (tid == 0) {
            __builtin_amdgcn_fence(__ATOMIC_RELEASE, "agent");
            asm volatile("s_waitcnt vmcnt(0)" ::: "memory");
            (void)__hip_atomic_fetch_add(kvflag, 1u, __ATOMIC_RELAXED, __HIP_MEMORY_SCOPE_AGENT);
          }
        }
      } else if (u < 1 + 96) {
        const int a = u - 1;
        int bh, qb;
        if (a < 32) { bh = 8 + (xq >> 1); qb = 62 + (xq & 1) - 2 * a; } else { bh = xq; qb = 63 - (a - 32); }
        attn_a_unit(p, bh / 6, bh % 6, qb, smem, lam, msh_a);
      } else {
        if (!memkv_ready) {
          if (tid == 0) {
            while (__hip_atomic_load(kvflag, __ATOMIC_RELAXED, __HIP_MEMORY_SCOPE_AGENT) < 4u) __builtin_amdgcn_s_sleep(1);
            __builtin_amdgcn_fence(__ATOMIC_ACQUIRE, "agent");
            asm volatile("s_waitcnt vmcnt(0)" ::: "memory");
          }
          __syncthreads();
          memkv_ready = true;
        }
        const int v = (xq * 32 + (u - 97)) * 2 + grp; mem_wave(p, 0, v >> 8, v & 3, ((v & 255) >> 2) * 128 + wq * 32, sc2, msh_m, smem);
      }
    }
  }
  grid_barrier(xb, false);

  {
    int mti, nti;
    for (int rd = 0; gemm_sched(rd, 4, mti, nti); ++rd) out_tile(p, p.W2t, true, mti, nti, smem);
  }
  grid_barrier(xb, false);

  proj_phase(p, 1, smem);
  grid_barrier(xb, false);

  {
    const float mqm = wave_max(fabsf(p.mem_q_norm[64 + lane])), mkm = wave_max(fabsf(p.mem_k_norm[64 + lane]));
    const float sc2 = 0.125f * LOG2E, msh_m = 8.f * mqm * mkm * LOG2E;
    for (int u = bid * 8 + wid; u < 6144 + 2048; u += nb * 8) {
      if (u < 6144) { const int qb = 63 - u / 96, rem = u % 96, bh = rem >> 2; sb_wave(p, bh / 12, bh % 12, qb * 128 + (rem & 3) * 32, smem); }
      else { const int v = u - 6144, rem = v & 1023; mem_wave(p, 1, v >> 10, (rem >> 2) & 3, (rem >> 4) * 128 + (rem & 3) * 32, sc2, msh_m, smem); }
    }
  }
  grid_barrier(xb, true);

  {
    int mti, nti;
    for (int rd = 0; gemm_sched(rd, 4, mti, nti); ++rd) out_tile(p, p.W4t, false, mti, nti, smem);
  }
}

extern "C" void kernel_launch(void* const* d_in, const int* in_sizes, int n_in, void* d_out, int out_size, void* d_ws, size_t ws_size, hipStream_t stream) {
  static int grid_blocks = 0;
  if (!grid_blocks) {
    int dev = 0, cus = 0, per_cu = 0;
    (void)hipGetDevice(&dev);
    (void)hipDeviceGetAttribute(&cus, hipDeviceAttributeMultiprocessorCount, dev);
    (void)hipFuncSetAttribute((const void*)yoco_fwd, hipFuncAttributeMaxDynamicSharedMemorySize, LDS_BYTES);
    (void)hipOccupancyMaxActiveBlocksPerMultiprocessor(&per_cu, yoco_fwd, NT, LDS_BYTES);
    if (per_cu > 1) per_cu = 1;
    if (per_cu < 1) per_cu = 1;
    grid_blocks = cus * per_cu;
  }
  Params p;
  memset(&p, 0, sizeof(p));
  const float* const* in = (const float* const*)d_in;
  p.x = in[0]; p.mem = in[1]; p.pos = (const int*)d_in[2];
  p.a_q_norm = in[5]; p.a_k_norm = in[6]; p.lq1 = in[7]; p.lk1 = in[8]; p.lq2 = in[9]; p.lk2 = in[10]; p.a_subln = in[11];
  p.mem_q_norm = in[20]; p.mem_k_norm = in[21];
  p.out = (float*)d_out;
  char* w = (char*)d_ws;
  size_t off = 0;
  auto take = [&](size_t bytes) { char* q = w + off; off += (bytes + 255) & ~(size_t)255; return q; };
  p.ctr = (int*)take(1024);
  p.xbw = (unsigned*)take(32768);
  p.P = (bf16_t*)take((size_t)NTOK * NP * 2);
  p.Vt = (bf16_t*)take((size_t)2 * 768 * SEQ * 2);
  p.xb = (bf16_t*)take((size_t)NTOK * DM * 2);
  p.y = (bf16_t*)take((size_t)NTOK * DM * 2);
  p.Ksb = (bf16_t*)take((size_t)2 * 768 * SEQ * 2);
  p.W1t = (bf16_t*)take((size_t)3584 * DM * 2);
  p.W2t = (bf16_t*)take((size_t)1024 * DM * 2);
  p.W3t = (bf16_t*)take((size_t)3584 * DM * 2);
  p.W4t = (bf16_t*)take((size_t)1024 * DM * 2);
  p.Wmt = (bf16_t*)take((size_t)2 * 512 * DM * 2);
  p.memb = (bf16_t*)take((size_t)512 * DM * 2);
  p.Km = (bf16_t*)take((size_t)2 * 512 * 256 * 2);
  p.Vmt = (bf16_t*)take((size_t)2 * 512 * 256 * 2);
  p.ssq0 = (float*)take((size_t)NTOK * 16 * 4);
  p.ssq1 = (float*)take((size_t)NTOK * 16 * 4);
  p.ssqm = (float*)take((size_t)512 * 16 * 4);
  p.cs = (float*)take((size_t)NTOK * 16 * 4);
  const float* a_norm = in[3]; const float* a_w_in = in[4]; const float* a_w_out = in[12]; const float* kv_norm = in[13]; const float* w_kv = in[14];
  const float* b_norm = in[15]; const float* b_w_in = in[16]; const float* b_w_out = in[17]; const float* mem_norm = in[18]; const float* mem_w_kv = in[19];
  auto setseg = [&](int i, const float* src, const float* gain, bf16_t* dst, int ld, int col0, int ncols) {
    p.seg[i].src = src; p.seg[i].gain = gain; p.seg[i].dst = dst; p.seg[i].ld = ld; p.seg[i].col0 = col0; p.seg[i].ncols = ncols; p.seg[i].pad = 0; };
  setseg(0, a_w_in, a_norm, p.W1t, 3584, 0, 3584);
  setseg(1, a_w_out, nullptr, p.W2t, 1024, 0, 1024);
  setseg(2, b_w_in, b_norm, p.W3t, 2048, 0, 768);
  setseg(3, w_kv, kv_norm, p.W3t + (size_t)768 * DM, 1536, 0, 1536);
  setseg(4, b_w_in, b_norm, p.W3t + (size_t)2304 * DM, 2048, 768, 1280);
  setseg(5, b_w_out, nullptr, p.W4t, 1024, 0, 1024);
  setseg(6, mem_w_kv, mem_norm, p.Wmt, 512, 0, 512);
  setseg(7, mem_w_kv + (size_t)1024 * 512, mem_norm + 1024, p.Wmt + (size_t)512 * DM, 512, 0, 512);
  for (int i = 0; i < 8; ++i) p.inv[i] = (float)pow(500000.0, -(double)i / 8.0);
  void* args[] = {&p};
  hipError_t e = hipLaunchCooperativeKernel((const void*)yoco_fwd, dim3(grid_blocks), dim3(NT), args, LDS_BYTES, stream);
  if (e != hipSuccess) fprintf(stderr, "cooperative launch failed: %s (grid %d)\n", hipGetErrorString(e), grid_blocks);
}
```

```cpp
#include <hip/hip_runtime.h>
#include <hip/hip_cooperative_groups.h>
#include <cstdio>
#include <cmath>
#include <cstring>
namespace cg = cooperative_groups;

typedef unsigned short bf16_t;
typedef short bf16x8 __attribute__((ext_vector_type(8)));
typedef short bf16x4 __attribute__((ext_vector_type(4)));
typedef float f32x16 __attribute__((ext_vector_type(16)));
typedef float f32x4 __attribute__((ext_vector_type(4)));
typedef float f32x2 __attribute__((ext_vector_type(2)));
typedef unsigned u32x4 __attribute__((ext_vector_type(4)));
typedef unsigned u32x2 __attribute__((ext_vector_type(2)));
typedef __bf16 bf2_t __attribute__((ext_vector_type(2)));

#define DI __device__ __forceinline__
#define MFMA32(a, b, c) __builtin_amdgcn_mfma_f32_32x32x16_bf16((a), (b), (c), 0, 0, 0)

constexpr int SEQ = 8192, DM = 1024, NTOK = 16384, NP = 3584;
constexpr int NT = 512;
constexpr float EPS = 1e-6f;
constexpr int LDS_ELEMS = 2 * 512 * 72;
constexpr int LDS_BYTES = LDS_ELEMS * 2 + 16;

struct Seg { const float* src; const float* gain; bf16_t* dst; int ld; int col0; int ncols; int pad; };

struct Params {
  const float* x; const float* mem; const int* pos;
  const float* a_q_norm; const float* a_k_norm; const float* lq1; const float* lk1; const float* lq2; const float* lk2; const float* a_subln;
  const float* mem_q_norm; const float* mem_k_norm;
  float* out;
  bf16_t* xb; bf16_t* memb; bf16_t* P; bf16_t* Vt; bf16_t* y;
  bf16_t* Ksb; bf16_t* W1t; bf16_t* W2t; bf16_t* W3t; bf16_t* W4t; bf16_t* Wmt; bf16_t* Km; bf16_t* Vmt;
  float* ssq0; float* ssq1; float* ssqm; float* cs; int* ctr; unsigned* xbw;
  Seg seg[8];
  float inv[8];
};

DI unsigned pk2(float a, float b) { f32x2 v = {a, b}; bf2_t r = __builtin_convertvector(v, bf2_t); return __builtin_bit_cast(unsigned, r); }
DI bf16_t f2bf(float a) { return (bf16_t)(pk2(a, 0.f) & 0xffffu); }
DI float bflo(unsigned w) { return __uint_as_float(w << 16); }
DI float bfhi(unsigned w) { return __uint_as_float(w & 0xffff0000u); }
DI int crow(int reg, int h) { return (reg & 3) + 8 * (reg >> 2) + 4 * h; }
DI int perm16(int kk) { return ((kk >> 2) & 1) * 8 + (kk >> 3) * 4 + (kk & 3); }
DI bf16x8 pack8(const float* v) {
  u32x4 w; w.x = pk2(v[0], v[1]); w.y = pk2(v[2], v[3]); w.z = pk2(v[4], v[5]); w.w = pk2(v[6], v[7]);
  return __builtin_bit_cast(bf16x8, w);
}
DI int opaque_tid() { int t = threadIdx.x; asm volatile("" : "+v"(t)); return t; }
DI f32x16 zero16() { f32x16 z; for (int i = 0; i < 16; ++i) z[i] = 0.f; return z; }

__device__ void phase0(const Params& p, bf16_t* smem) {
  const int tid = opaque_tid(), lane = tid & 63, wid = tid >> 6, nb = gridDim.x, bid = blockIdx.x;
  for (int row0 = (bid * 8 + wid) * 2; row0 < NTOK + 512; row0 += nb * 16) {
    f32x4 v[2][4];
#pragma unroll
    for (int q = 0; q < 2; ++q) {
      const int row = row0 + q;
      const float* src = (row < NTOK) ? p.x + (size_t)row * DM : p.mem + (size_t)(row - NTOK) * DM;
#pragma unroll
      for (int j = 0; j < 4; ++j) v[q][j] = *(const f32x4*)(src + 256 * j + 4 * lane);
    }
#pragma unroll
    for (int q = 0; q < 2; ++q) {
      const int row = row0 + q;
      bf16_t* dst; float* sq;
      if (row < NTOK) { dst = p.xb + (size_t)row * DM; sq = p.ssq0 + (size_t)row * 16; }
      else { const int r2 = row - NTOK; dst = p.memb + (size_t)r2 * DM; sq = p.ssqm + (size_t)r2 * 16; }
#pragma unroll
      for (int j = 0; j < 4; ++j) {
        const f32x4 t = v[q][j];
        float s = t.x * t.x + t.y * t.y + t.z * t.z + t.w * t.w;
        u32x2 w; w.x = pk2(t.x, t.y); w.y = pk2(t.z, t.w);
        *(u32x2*)(dst + 256 * j + 4 * lane) = w;
        s += __shfl_xor(s, 1); s += __shfl_xor(s, 2); s += __shfl_xor(s, 4); s += __shfl_xor(s, 8);
        if ((lane & 15) == 0) sq[4 * j + (lane >> 4)] = s;
      }
    }
  }
  for (int i = bid * NT + tid; i < NTOK * 8; i += nb * NT) {
    const int token = i >> 3, f = i & 7;
    const float ang = (float)p.pos[token] * p.inv[f];
    double rev = (double)ang * 0.15915494309189535;
    rev -= floor(rev);
    const double q4 = rint(rev * 4.0);
    const double a = (rev - q4 * 0.25) * 6.283185307179586;
    const int q = ((int)q4) & 3;
    const double a2 = a * a;
    double sn = -1.0 / 39916800.0; sn = sn * a2 + 1.0 / 362880.0; sn = sn * a2 - 1.0 / 5040.0; sn = sn * a2 + 1.0 / 120.0; sn = sn * a2 - 1.0 / 6.0; sn = sn * a2 + 1.0; sn *= a;
    double cn = 1.0 / 479001600.0; cn = cn * a2 - 1.0 / 3628800.0; cn = cn * a2 + 1.0 / 40320.0; cn = cn * a2 - 1.0 / 720.0; cn = cn * a2 + 1.0 / 24.0; cn = cn * a2 - 0.5; cn = cn * a2 + 1.0;
    double c, s;
    if (q == 0) { c = cn; s = sn; } else if (q == 1) { c = -sn; s = cn; } else if (q == 2) { c = -cn; s = -sn; } else { c = sn; s = -cn; }
    p.cs[(size_t)token * 16 + f] = (float)c;
    p.cs[(size_t)token * 16 + 8 + f] = (float)s;
  }
  {
    f32x4 nv[2]; float ng[2]; bf16_t* ndst = nullptr;
    auto fetch = [&](int t) {
      int ct = t >> 4; const int k0 = (t & 15) * 64;
      int si = 0;
      while (ct >= (p.seg[si].ncols >> 6)) { ct -= (p.seg[si].ncols >> 6); ++si; }
      const Seg sg = p.seg[si];
      const int n0 = ct * 64;
#pragma unroll
      for (int j = 0; j < 2; ++j) {
        const int i = tid + NT * j, kr = i >> 4, c4 = i & 15;
        nv[j] = *(const f32x4*)(sg.src + (size_t)(k0 + kr) * sg.ld + sg.col0 + n0 + c4 * 4);
        ng[j] = sg.gain ? sg.gain[k0 + kr] : 1.f;
      }
      ndst = sg.dst + (size_t)(n0 + (tid >> 3)) * DM + k0 + (tid & 7) * 8;
    };
    if (bid < 2560) fetch(bid);
    for (int t = bid; t < 2560; t += nb) {
      const f32x4 v0 = nv[0], v1 = nv[1]; const float g0 = ng[0], g1 = ng[1]; bf16_t* dst = ndst;
      if (t + nb < 2560) fetch(t + nb);
      __syncthreads();
      {
        const int kr = tid >> 4, c4 = tid & 15;
        smem[(c4 * 4 + 0) * 72 + kr] = f2bf(v0.x * g0); smem[(c4 * 4 + 1) * 72 + kr] = f2bf(v0.y * g0);
        smem[(c4 * 4 + 2) * 72 + kr] = f2bf(v0.z * g0); smem[(c4 * 4 + 3) * 72 + kr] = f2bf(v0.w * g0);
        smem[(c4 * 4 + 0) * 72 + kr + 32] = f2bf(v1.x * g1); smem[(c4 * 4 + 1) * 72 + kr + 32] = f2bf(v1.y * g1);
        smem[(c4 * 4 + 2) * 72 + kr + 32] = f2bf(v1.z * g1); smem[(c4 * 4 + 3) * 72 + kr + 32] = f2bf(v1.w * g1);
      }
      __syncthreads();
      *(u32x4*)dst = *(const u32x4*)(smem + (tid >> 3) * 72 + (tid & 7) * 8);
    }
  }
  __syncthreads();
}

template <int MT>
DI void gemm_core(const bf16_t* __restrict__ Wt, const bf16_t* __restrict__ X, int n0, int m0, f32x16 (&acc)[2][MT], bf16_t* smem) {
  const int tid = opaque_tid(), lane = tid & 63, wid = tid >> 6, wn = wid >> 1, wm = wid & 1, r = lane & 31, h = lane >> 5;
  bf16_t* Ws = smem;
  bf16_t* Xs = smem + 2 * 256 * 72;
  const char* wub = (const char*)(Wt + (size_t)n0 * DM);
  const char* xub = (const char*)(X + (size_t)m0 * DM);
  const unsigned voff = (unsigned)(((tid >> 3) * DM + (tid & 7) * 8) * 2);
#define GLD_W(i, k) (*(const u32x4*)(wub + ((size_t)(i) * 64 * DM * 2 + (size_t)(k) * 128) + voff))
#define GLD_X(i, k) (*(const u32x4*)(xub + ((size_t)(i) * 64 * DM * 2 + (size_t)(k) * 128) + voff))
  const int so = (tid >> 3) * 72 + (tid & 7) * 8;
  u32x4 wr[4], xr[MT];
#pragma unroll
  for (int i = 0; i < 4; ++i) wr[i] = GLD_W(i, 0);
#pragma unroll
  for (int i = 0; i < MT; ++i) xr[i] = GLD_X(i, 0);
  __syncthreads();
#pragma unroll
  for (int i = 0; i < 4; ++i) *(u32x4*)(Ws + so + i * 64 * 72) = wr[i];
#pragma unroll
  for (int i = 0; i < MT; ++i) *(u32x4*)(Xs + so + i * 64 * 72) = xr[i];
#pragma unroll
  for (int i = 0; i < 4; ++i) wr[i] = GLD_W(i, 1);
#pragma unroll
  for (int i = 0; i < MT; ++i) xr[i] = GLD_X(i, 1);
  __syncthreads();
  const int ao = (wn * 64 + r) * 72 + h * 8, bo = (wm * (MT * 32) + r) * 72 + h * 8;
  for (int kt = 0; kt < 16; ++kt) {
    const int cur = (kt & 1) * 256 * 72, nxt = ((kt + 1) & 1) * 256 * 72;
#pragma unroll
    for (int s = 0; s < 4; ++s) {
      bf16x8 a[2], b[MT];
#pragma unroll
      for (int nt = 0; nt < 2; ++nt) a[nt] = *(const bf16x8*)(Ws + cur + ao + nt * 32 * 72 + s * 16);
#pragma unroll
      for (int mt = 0; mt < MT; ++mt) b[mt] = *(const bf16x8*)(Xs + cur + bo + mt * 32 * 72 + s * 16);
      if (kt + 1 < 16) {
        *(u32x4*)(Ws + nxt + so + s * 64 * 72) = wr[s];
        if (s < MT) *(u32x4*)(Xs + nxt + so + s * 64 * 72) = xr[s < MT ? s : 0];
        if (kt + 2 < 16) {
          wr[s] = GLD_W(s, kt + 2);
          if (s < MT) xr[s < MT ? s : 0] = GLD_X(s, kt + 2);
        }
      }
#pragma unroll
      for (int nt = 0; nt < 2; ++nt)
#pragma unroll
        for (int mt = 0; mt < MT; ++mt) acc[nt][mt] = MFMA32(a[nt], b[mt], acc[nt][mt]);
    }
    __syncthreads();
  }
}

DI float row_rinv(const float* ssq, int token) {
  const f32x4* q = (const f32x4*)(ssq + (size_t)token * 16);
  const f32x4 a = q[0], b = q[1], c = q[2], d = q[3];
  const float s = ((a.x + a.y) + (a.z + a.w)) + ((b.x + b.y) + (b.z + b.w)) + ((c.x + c.y) + (c.z + c.w)) + ((d.x + d.y) + (d.z + d.w));
  return rsqrtf(s * (1.f / 1024.f) + EPS);
}

enum { EK_QKROPE = 0, EK_NORM = 1, EK_PLAIN = 2, EK_VT = 3, EK_SILU = 4, EK_VBLK = 5 };

template <int MT>
DI void epi_proj(const f32x16 (&acc)[2][MT], int kind, const float* __restrict__ ssq0, const float* __restrict__ gain, const float* __restrict__ cs0,
                 bf16_t* __restrict__ dbase, int ld, bf16_t* __restrict__ vbase, int vt_ld, bf16_t* smem, float qscale) {
  const int tid = opaque_tid(), lane = tid & 63, wid = tid >> 6, r = lane & 31, h = lane >> 5;
  bf16_t* wreg = smem + wid * 9216;
#pragma unroll
  for (int mt = 0; mt < MT; ++mt) {
    const float rs = row_rinv(ssq0, mt * 32);
    float v[2][16];
#pragma unroll
    for (int nt = 0; nt < 2; ++nt)
#pragma unroll
      for (int i = 0; i < 16; ++i) v[nt][i] = acc[nt][mt][i] * rs;
    if (kind <= EK_NORM) {
      float ss = 0.f;
#pragma unroll
      for (int nt = 0; nt < 2; ++nt)
#pragma unroll
        for (int i = 0; i < 16; ++i) ss += v[nt][i] * v[nt][i];
      ss += __shfl_xor(ss, 32);
      const float rn = rsqrtf(ss * (1.f / 64.f) + EPS);
#pragma unroll
      for (int nt = 0; nt < 2; ++nt)
#pragma unroll
        for (int g = 0; g < 4; ++g) {
          const f32x4 gg = *(const f32x4*)(gain + nt * 32 + 8 * g + 4 * h);
          v[nt][4 * g + 0] *= rn * gg.x; v[nt][4 * g + 1] *= rn * gg.y; v[nt][4 * g + 2] *= rn * gg.z; v[nt][4 * g + 3] *= rn * gg.w;
        }
      if (kind == EK_QKROPE) {
        const f32x4 c = *(const f32x4*)(cs0 + mt * 32 * 16 + 4 * h);
        const f32x4 s = *(const f32x4*)(cs0 + mt * 32 * 16 + 8 + 4 * h);
#pragma unroll
        for (int i = 0; i < 4; ++i) {
          const float x1 = v[0][i], x2 = v[0][4 + i];
          v[0][i] = x1 * c[i] - x2 * s[i];
          v[0][4 + i] = x2 * c[i] + x1 * s[i];
        }
#pragma unroll
        for (int nt = 0; nt < 2; ++nt)
#pragma unroll
          for (int i = 0; i < 16; ++i) v[nt][i] *= qscale;
      }
    } else if (kind == EK_PLAIN) {
#pragma unroll
      for (int nt = 0; nt < 2; ++nt)
#pragma unroll
        for (int i = 0; i < 16; ++i) v[nt][i] *= qscale;
    } else if (kind == EK_SILU) {
#pragma unroll
      for (int nt = 0; nt < 2; ++nt)
#pragma unroll
        for (int i = 0; i < 16; ++i) v[nt][i] = v[nt][i] * __builtin_amdgcn_rcpf(1.f + __builtin_amdgcn_exp2f(-1.4426950408889634f * v[nt][i]));
    }
    if (kind == EK_VT || kind == EK_VBLK) {
#pragma unroll
      for (int nt = 0; nt < 2; ++nt)
#pragma unroll
        for (int i = 0; i < 16; ++i) wreg[(nt * 32 + crow(i, h)) * 136 + mt * 32 + (r & 16) + perm16(r & 15)] = f2bf(v[nt][i]);
    } else {
#pragma unroll
      for (int nt = 0; nt < 2; ++nt)
#pragma unroll
        for (int g = 0; g < 4; ++g) {
          u32x2 w; w.x = pk2(v[nt][4 * g], v[nt][4 * g + 1]); w.y = pk2(v[nt][4 * g + 2], v[nt][4 * g + 3]);
          *(u32x2*)(wreg + (mt * 32 + r) * 72 + nt * 32 + 8 * g + 4 * h) = w;
        }
    }
  }
  __syncthreads();
  constexpr int CPR = MT * 4, RPI = 64 / CPR;
  if (kind == EK_VT) {
#pragma unroll
    for (int j = 0; j < CPR; ++j) {
      const int n = j * RPI + lane / CPR, c = lane % CPR;
      *(u32x4*)(vbase + (size_t)n * vt_ld + c * 8) = *(const u32x4*)(wreg + n * 136 + c * 8);
    }
  } else if (kind == EK_VBLK) {
#pragma unroll
    for (int j = 0; j < CPR; ++j) {
      const int n = j * RPI + lane / CPR, c = lane % CPR;
      *(u32x4*)(vbase + (size_t)(c >> 2) * 2048 + n * 32 + (c & 3) * 8) = *(const u32x4*)(wreg + n * 136 + c * 8);
    }
  } else {
#pragma unroll
    for (int j = 0; j < MT * 4; ++j) {
      const int row = j * 8 + (lane >> 3), c = lane & 7;
      *(u32x4*)(dbase + (size_t)row * ld + c * 8) = *(const u32x4*)(wreg + row * 72 + c * 8);
    }
  }
}

template <int MT>
DI void zero_acc(f32x16 (&acc)[2][MT]) {
#pragma unroll
  for (int a = 0; a < 2; ++a)
#pragma unroll
    for (int b = 0; b < MT; ++b) acc[a][b] = zero16();
}

template <int MT>
__device__ void proj_tile(const Params& p, int layer, int m0, int nti, bf16_t* smem) {
  const int tid = opaque_tid(), lane = tid & 63, wid = tid >> 6, wn = wid >> 1, wm = wid & 1, r = lane & 31, h = lane >> 5;
  const int n0 = nti * 256;
  f32x16 acc[2][MT];
  zero_acc<MT>(acc);
  gemm_core<MT>(layer ? p.W3t : p.W1t, p.xb, n0, m0, acc, smem);
  const float* ssq = layer ? p.ssq1 : p.ssq0;
  const int tok = m0 + wm * (MT * 32) + r;
  const int cc = n0 + wn * 64;
  int kind; const float* gain = p.a_q_norm;
  if (cc < 1536) { kind = layer ? EK_PLAIN : EK_QKROPE; gain = (cc < 768) ? p.a_q_norm : p.a_k_norm; }
  else if (cc < 2304) kind = EK_VT;
  else if (cc < 2560) { kind = EK_NORM; gain = p.mem_q_norm + layer * 64; }
  else kind = EK_SILU;
  const int tok0 = m0 + wm * (MT * 32), b = tok0 >> 13;
  bf16_t* vtb = p.Vt + ((size_t)b * 768 + (cc - 1536)) * SEQ + (tok0 & (SEQ - 1));
  bf16_t* dbase = p.P + (size_t)tok0 * NP + cc;
  int ld = NP;
  if (layer && cc >= 768 && cc < 1536) {
    dbase = p.Ksb + (((size_t)b * 12 + ((cc - 768) >> 6)) * SEQ + (tok0 & (SEQ - 1))) * 64; ld = 64;
  } else if (layer && kind == EK_VT) {
    kind = EK_VBLK;
    vtb = p.Vt + (((size_t)b * 12 + ((cc - 1536) >> 6)) * 256 + ((tok0 & (SEQ - 1)) >> 5)) * 2048;
  }
  epi_proj<MT>(acc, kind, ssq + (size_t)tok * 16, gain, p.cs + (size_t)tok * 16, dbase, ld, vtb, SEQ, smem, (cc < 768) ? 0.125f * 1.4426950408889634f : 1.f);
}

__device__ void mem_tile(const Params& p, int l, int mti, int nti, bf16_t* smem) {
  const int tid = opaque_tid(), lane = tid & 63, wid = tid >> 6, wn = wid >> 1, wm = wid & 1, r = lane & 31, h = lane >> 5;
  const int m0 = mti * 256, n0 = nti * 256;
  f32x16 acc[2][4];
  zero_acc<4>(acc);
  gemm_core<4>(p.Wmt + (size_t)l * 512 * DM, p.memb, n0, m0, acc, smem);
  const int tok = m0 + wm * 128 + r;
  const int cc = n0 + wn * 64;
  const int kind = (cc < 256) ? EK_NORM : EK_VT;
  const int tok0 = m0 + wm * 128, b = tok0 >> 8;
  bf16_t* vtb = p.Vmt + ((size_t)(l * 2 + b) * 256 + (cc - 256)) * 256 + (tok0 & 255);
  epi_proj<4>(acc, kind, p.ssqm + (size_t)tok * 16, p.mem_k_norm + l * 64, p.cs, p.Km + ((size_t)l * 512 + tok0) * 256 + cc, 256, vtb, 256, smem, 1.f);
}

__device__ void out_tile(const Params& p, const bf16_t* Wt, bool first, int mti, int nti, bf16_t* smem) {
  const int tid = opaque_tid(), lane = tid & 63, wid = tid >> 6, wn = wid >> 1, wm = wid & 1, r = lane & 31, h = lane >> 5;
  const int m0 = mti * 256, n0 = nti * 256;
  f32x16 acc[2][4];
  zero_acc<4>(acc);
  gemm_core<4>(Wt, p.y, n0, m0, acc, smem);
  const int cc = n0 + wn * 64;
  float* freg = (float*)smem + wid * 4608;
#pragma unroll
  for (int half = 0; half < 2; ++half) {
#pragma unroll
    for (int mtl = 0; mtl < 2; ++mtl)
#pragma unroll
      for (int nt = 0; nt < 2; ++nt)
#pragma unroll
        for (int g = 0; g < 4; ++g) {
          f32x4 o; o.x = acc[nt][half * 2 + mtl][4 * g + 0]; o.y = acc[nt][half * 2 + mtl][4 * g + 1]; o.z = acc[nt][half * 2 + mtl][4 * g + 2]; o.w = acc[nt][half * 2 + mtl][4 * g + 3];
          *(f32x4*)(freg + (mtl * 32 + r) * 68 + nt * 32 + 8 * g + 4 * h) = o;
        }
    __syncthreads();
#pragma unroll
    for (int j = 0; j < 16; ++j) {
      const int row = j * 4 + (lane >> 4), c = lane & 15;
      const int tok = m0 + wm * 128 + half * 64 + row;
      const size_t off = (size_t)tok * DM + cc + c * 4;
      const f32x4 a = *(const f32x4*)(freg + row * 68 + c * 4);
      f32x4 o;
      if (first) {
        o = *(const f32x4*)(p.x + off);
        o.x += a.x; o.y += a.y; o.z += a.z; o.w += a.w;
        u32x2 w; w.x = pk2(o.x, o.y); w.y = pk2(o.z, o.w);
        *(u32x2*)(p.xb + off) = w;
        float ss = o.x * o.x + o.y * o.y + o.z * o.z + o.w * o.w;
        ss += __shfl_xor(ss, 1); ss += __shfl_xor(ss, 2); ss += __shfl_xor(ss, 4); ss += __shfl_xor(ss, 8);
        if (c == 0) p.ssq1[(size_t)tok * 16 + (cc >> 6)] = ss;
      } else {
        const u32x2 w = *(const u32x2*)(p.xb + off);
        o.x = bflo(w.x) + a.x; o.y = bfhi(w.x) + a.y; o.z = bflo(w.y) + a.z; o.w = bfhi(w.y) + a.w;
        *(f32x4*)(p.out + off) = o;
      }
      if ((j & 3) == 3) __builtin_amdgcn_sched_barrier(0);
    }
    __syncthreads();
  }
}

template <int NDT>
DI void store_gated(const f32x16 (&O)[NDT], float* reg, const bf16_t* __restrict__ grow0, bf16_t* __restrict__ yrow0, const float* __restrict__ gain, int lane) {
  constexpr int RS = NDT * 32 + 4, LPR = NDT * 8, RPI = 64 / LPR;
  const int r = lane & 31, h = lane >> 5;
#pragma unroll
  for (int dvt = 0; dvt < NDT; ++dvt)
#pragma unroll
    for (int g = 0; g < 4; ++g) {
      f32x4 o; o.x = O[dvt][4 * g + 0]; o.y = O[dvt][4 * g + 1]; o.z = O[dvt][4 * g + 2]; o.w = O[dvt][4 * g + 3];
      *(f32x4*)(reg + r * RS + dvt * 32 + 8 * g + 4 * h) = o;
    }
  asm volatile("s_waitcnt lgkmcnt(0)" ::: "memory");
  const int c = lane % LPR;
  f32x4 gg; gg.x = 1.f; gg.y = 1.f; gg.z = 1.f; gg.w = 1.f;
  if (gain) gg = *(const f32x4*)(gain + c * 4);
#pragma unroll
  for (int j = 0; j < 32 / RPI; ++j) {
    const int row = j * RPI + lane / LPR;
    const f32x4 v = *(const f32x4*)(reg + row * RS + c * 4);
    const u32x2 gw = *(const u32x2*)(grow0 + (size_t)row * NP + c * 4);
    u32x2 w;
    w.x = pk2(v.x * gg.x * bflo(gw.x), v.y * gg.y * bfhi(gw.x));
    w.y = pk2(v.z * gg.z * bflo(gw.y), v.w * gg.w * bfhi(gw.y));
    *(u32x2*)(yrow0 + (size_t)row * DM + c * 4) = w;
  }
  asm volatile("s_waitcnt lgkmcnt(0)" ::: "memory");
}

__device__ void attn_a_unit(const Params& p, int b, int hd, int qb, bf16_t* smem, float lam, float msh) {
  const int tid = opaque_tid(), lane = tid & 63, wid = tid >> 6, r = lane & 31, h = lane >> 5, grp = wid >> 2, wq = wid & 3;
  const bf16_t* Pb = p.P + (size_t)b * SEQ * NP;
  const bf16_t* Vb = p.Vt + ((size_t)b * 768 + hd * 128) * SEQ;
  const int q0 = qb * 128 + wq * 32;
  bf16x8 qf[4];
#pragma unroll
  for (int s = 0; s < 4; ++s) qf[s] = *(const bf16x8*)(Pb + (size_t)(q0 + r) * NP + grp * 384 + hd * 64 + s * 16 + h * 8);
  f32x16 O[4];
#pragma unroll
  for (int i = 0; i < 4; ++i) O[i] = zero16();
  float l = 0.f;
  const int nkt = 2 * (qb + 1);
  constexpr int VOFF = 9216, SSTR = 18432;
  const char* kub = (const char*)(Pb + 768 + hd * 64);
  const char* vub = (const char*)Vb;
  const unsigned kvo = (unsigned)(((tid >> 3) * NP + (tid & 7) * 8) * 2);
  const unsigned vvo = (unsigned)(((tid >> 3) * SEQ + (tid & 7) * 8) * 2);
#define GLD_K(i, t) (*(const u32x4*)(kub + ((size_t)(t) * 64 * NP * 2 + (size_t)(i) * 768) + kvo))
#define GLD_V(i, t) (*(const u32x4*)(vub + ((size_t)(i) * 64 * SEQ * 2 + (size_t)(t) * 128) + vvo))
  const int kso = (tid >> 3) * 72 + (tid & 7) * 8;
  const int vso = VOFF + (tid >> 3) * 72 + (tid & 7) * 8;
  const int kro = grp * 64 * 72 + r * 72 + h * 8;
  const int vro = VOFF + r * 72 + 8 * h;
  u32x4 kr[2], vr[2];
#pragma unroll
  for (int i = 0; i < 2; ++i) { kr[i] = GLD_K(i, 0); vr[i] = GLD_V(i, 0); }
#pragma unroll
  for (int i = 0; i < 2; ++i) {
    *(u32x4*)(smem + kso + i * 64 * 72) = kr[i];
    *(u32x4*)(smem + vso + i * 64 * 72) = vr[i];
  }
#pragma unroll
  for (int i = 0; i < 2; ++i) { kr[i] = GLD_K(i, 1); vr[i] = GLD_V(i, 1); }
  __syncthreads();
  for (int kt = 0; kt < nkt; ++kt) {
    const int cur = (kt & 1) * SSTR, nxt = ((kt + 1) & 1) * SSTR;
    if (kt + 1 < nkt) {
#pragma unroll
      for (int i = 0; i < 2; ++i) {
        *(u32x4*)(smem + nxt + kso + i * 64 * 72) = kr[i];
        *(u32x4*)(smem + nxt + vso + i * 64 * 72) = vr[i];
      }
      if (kt + 2 < nkt) {
#pragma unroll
        for (int i = 0; i < 2; ++i) { kr[i] = GLD_K(i, kt + 2); vr[i] = GLD_V(i, kt + 2); }
      }
    }
    const int k0 = kt * 64;
    if (k0 <= q0 + 31) {
      bf16x8 kfr[8], vfa[8], vfb[8];
#pragma unroll
      for (int s = 0; s < 8; ++s) kfr[s] = *(const bf16x8*)(smem + cur + kro + (s >> 2) * 32 * 72 + (s & 3) * 16);
      __builtin_amdgcn_sched_barrier(0);
      f32x16 S0 = zero16(), S1 = zero16();
#pragma unroll
      for (int s = 0; s < 4; ++s) S0 = MFMA32(kfr[s], qf[s], S0);
#pragma unroll
      for (int s = 0; s < 8; ++s) vfa[s] = *(const bf16x8*)(smem + cur + vro + (s >> 1) * 32 * 72 + (s & 1) * 16);
#pragma unroll
      for (int s = 0; s < 4; ++s) S1 = MFMA32(kfr[4 + s], qf[s], S1);
      __builtin_amdgcn_sched_barrier(0);
      const int dq = q0 + r - k0 - 4 * h;
      float pv[16]; bf16x8 pk[2];
#pragma unroll
      for (int s = 0; s < 8; ++s) vfb[s] = *(const bf16x8*)(smem + cur + vro + (s >> 1) * 32 * 72 + 32 + (s & 1) * 16);
#pragma unroll
      for (int i = 0; i < 16; ++i) pv[i] = __builtin_amdgcn_exp2f(S0[i]);
      if (k0 + 31 > q0) {
#pragma unroll
        for (int i = 0; i < 16; ++i) if ((i & 3) + 8 * (i >> 2) > dq) pv[i] = 0.f;
      }
#pragma unroll
      for (int i = 0; i < 16; ++i) l += pv[i];
      pk[0] = pack8(pv); pk[1] = pack8(pv + 8);
      __builtin_amdgcn_sched_barrier(0);
#pragma unroll
      for (int s = 0; s < 8; ++s) O[s >> 1] = MFMA32(vfa[s], pk[s & 1], O[s >> 1]);
#pragma unroll
      for (int i = 0; i < 16; ++i) pv[i] = __builtin_amdgcn_exp2f(S1[i]);
      if (k0 + 63 > q0) {
#pragma unroll
        for (int i = 0; i < 16; ++i) if (32 + (i & 3) + 8 * (i >> 2) > dq) pv[i] = 0.f;
      }
#pragma unroll
      for (int i = 0; i < 16; ++i) l += pv[i];
      bf16x8 pq[2]; pq[0] = pack8(pv); pq[1] = pack8(pv + 8);
      __builtin_amdgcn_sched_barrier(0);
#pragma unroll
      for (int s = 0; s < 8; ++s) O[s >> 1] = MFMA32(vfb[s], pq[s & 1], O[s >> 1]);
    }
    __syncthreads();
  }
  l += __shfl_xor(l, 32);
  float* xch = (float*)smem + (size_t)wq * 65 * 64 + lane;
  if (grp == 1) {
#pragma unroll
    for (int dvt = 0; dvt < 4; ++dvt)
#pragma unroll
      for (int i = 0; i < 16; ++i) xch[(dvt * 16 + i) * 64] = O[dvt][i];
    xch[64 * 64] = l;
  }
  __syncthreads();
  if (grp == 0) {
    const float i1 = 1.f / l, i2 = lam / xch[64 * 64];
    float ss = 0.f;
#pragma unroll
    for (int dvt = 0; dvt < 4; ++dvt)
#pragma unroll
      for (int i = 0; i < 16; ++i) { const float o = O[dvt][i] * i1 - xch[(dvt * 16 + i) * 64] * i2; O[dvt][i] = o; ss += o * o; }
    ss += __shfl_xor(ss, 32);
    const float rn = rsqrtf(ss * (1.f / 128.f) + EPS) * 0.8f;
#pragma unroll
    for (int dvt = 0; dvt < 4; ++dvt)
#pragma unroll
      for (int i = 0; i < 16; ++i) O[dvt][i] *= rn;
    const size_t tok0 = (size_t)b * SEQ + q0;
    store_gated<4>(O, (float*)smem + 16640 + wq * 4352, p.P + tok0 * NP + 2560 + hd * 128, p.y + tok0 * DM + hd * 128, p.a_subln, lane);
  }
}

__device__ void mem_wave(const Params& p, int l, int b, int mh, int q0, float sc2, float msh, bf16_t* smem) {
  const int tid = opaque_tid(), lane = tid & 63, r = lane & 31, h = lane >> 5;
  const size_t tok = (size_t)b * SEQ + q0 + r;
  const bf16_t* prow = p.P + tok * NP;
  bf16x8 qf[4];
#pragma unroll
  for (int s = 0; s < 4; ++s) qf[s] = *(const bf16x8*)(prow + 2304 + mh * 64 + s * 16 + h * 8);
  const bf16_t* Kl = p.Km + ((size_t)(l * 2 + b) * 256 + r) * 256 + mh * 64 + h * 8;
  const bf16_t* Vl = p.Vmt + ((size_t)(l * 2 + b) * 256 + mh * 64 + r) * 256 + 8 * h;
  f32x16 O[2]; O[0] = zero16(); O[1] = zero16();
  float lsum = 0.f;
  bf16x8 kf[4], vf[4], kn[4], vn[4];
#pragma unroll
  for (int s = 0; s < 4; ++s) { kf[s] = *(const bf16x8*)(Kl + s * 16); vf[s] = *(const bf16x8*)(Vl + (s >> 1) * 32 * 256 + (s & 1) * 16); }
#pragma unroll
  for (int s = 0; s < 4; ++s) { kn[s] = kf[s]; vn[s] = vf[s]; }
  for (int kt = 0; kt < 8; ++kt) {
    if (kt + 1 < 8) {
      const int k1 = (kt + 1) * 32;
#pragma unroll
      for (int s = 0; s < 4; ++s) { kn[s] = *(const bf16x8*)(Kl + (size_t)k1 * 256 + s * 16); vn[s] = *(const bf16x8*)(Vl + (s >> 1) * 32 * 256 + k1 + (s & 1) * 16); }
    }
    __builtin_amdgcn_sched_barrier(0);
    f32x16 S = zero16();
#pragma unroll
    for (int s = 0; s < 4; ++s) S = MFMA32(kf[s], qf[s], S);
    float pv[16];
#pragma unroll
    for (int i = 0; i < 16; ++i) { pv[i] = __builtin_amdgcn_exp2f(S[i] * sc2 - msh); lsum += pv[i]; }
    bf16x8 pk[2]; pk[0] = pack8(pv); pk[1] = pack8(pv + 8);
#pragma unroll
    for (int s = 0; s < 4; ++s) O[s >> 1] = MFMA32(vf[s], pk[s & 1], O[s >> 1]);
#pragma unroll
    for (int s = 0; s < 4; ++s) { kf[s] = kn[s]; vf[s] = vn[s]; }
  }
  lsum += __shfl_xor(lsum, 32);
  const float inv = __builtin_amdgcn_rcpf(lsum);
#pragma unroll
  for (int dvt = 0; dvt < 2; ++dvt)
#pragma unroll
    for (int i = 0; i < 16; ++i) O[dvt][i] *= inv;
  store_gated<2>(O, (float*)smem + (tid >> 6) * 4608, prow - (size_t)r * NP + 2560 + 768 + mh * 64, p.y + (tok - r) * DM + 768 + mh * 64, nullptr, lane);
}

__device__ void sb_wave(const Params& p, int b, int hd, int q0, bf16_t* smem) {
  const int tid = opaque_tid(), lane = tid & 63, r = lane & 31, h = lane >> 5;
  const bf16_t* Pb = p.P + (size_t)b * SEQ * NP;
  const bf16_t* Kl = p.Ksb + (((size_t)b * 12 + hd) * SEQ + r) * 64 + h * 8;
  const bf16_t* Vl = p.Vt + ((size_t)b * 12 + hd) * 256 * 2048 + r * 32 + 8 * h;
  const size_t tok = (size_t)b * SEQ + q0 + r;
  bf16x8 qf[4];
#pragma unroll
  for (int s = 0; s < 4; ++s) qf[s] = *(const bf16x8*)(Pb + (size_t)(q0 + r) * NP + hd * 64 + s * 16 + h * 8);
  f32x16 O[2]; O[0] = zero16(); O[1] = zero16();
  float R = 0.f;
  const int ktd = q0 >> 5;
  bf16x8 kf[4], kn[4], vf[4];
#pragma unroll
  for (int s = 0; s < 4; ++s) { kf[s] = *(const bf16x8*)(Kl + (size_t)q0 * 64 + s * 16); kn[s] = kf[s]; }
  for (int kt = ktd; kt >= 0; --kt) {
    const int k0 = kt * 32;
    const bool diag = (kt == ktd);
#pragma unroll
    for (int s = 0; s < 4; ++s) vf[s] = *(const bf16x8*)(Vl + (size_t)kt * 2048 + (s >> 1) * 32 * 32 + (s & 1) * 16);
    if (kt > 0) {
#pragma unroll
      for (int s = 0; s < 4; ++s) kn[s] = *(const bf16x8*)(Kl + (size_t)(k0 - 32) * 64 + s * 16);
    }
    __builtin_amdgcn_sched_barrier(0);
    f32x16 S = zero16();
#pragma unroll
    for (int s = 0; s < 4; ++s) S = MFMA32(kf[s], qf[s], S);
    float lb[16], f[16];
#pragma unroll
    for (int i = 0; i < 16; ++i) {
      const float z = S[i];
      const float L = __builtin_amdgcn_logf(1.f + __builtin_amdgcn_exp2f(-fabsf(z)));
      const float lbv = fminf(z, 0.f) - L;
      lb[i] = lbv; f[i] = lbv - z;
    }
    if (diag) {
#pragma unroll
      for (int i = 0; i < 16; ++i) if (crow(i, h) >= r) f[i] = 0.f;
    }
    float T[4], PT[4], loc[16];
#pragma unroll
    for (int g = 0; g < 4; ++g) {
      loc[4 * g + 3] = 0.f;
      loc[4 * g + 2] = f[4 * g + 3];
      loc[4 * g + 1] = loc[4 * g + 2] + f[4 * g + 2];
      loc[4 * g + 0] = loc[4 * g + 1] + f[4 * g + 1];
      T[g] = loc[4 * g + 0] + f[4 * g + 0];
    }
#pragma unroll
    for (int g = 0; g < 4; ++g) PT[g] = __shfl_xor(T[g], 32);
    float hg = R;
    float av[16];
#pragma unroll
    for (int g = 3; g >= 0; --g) {
      const float base = hg + (h == 0 ? PT[g] : 0.f);
#pragma unroll
      for (int i = 0; i < 4; ++i) av[4 * g + i] = __builtin_amdgcn_exp2f(lb[4 * g + i] + (base + loc[4 * g + i]));
      hg += T[g] + PT[g];
    }
    if (diag) {
#pragma unroll
      for (int i = 0; i < 16; ++i) if (crow(i, h) >= r) av[i] = 0.f;
    }
    R = hg;
    bf16x8 pk[2]; pk[0] = pack8(av); pk[1] = pack8(av + 8);
#pragma unroll
    for (int s = 0; s < 4; ++s) O[s >> 1] = MFMA32(vf[s], pk[s & 1], O[s >> 1]);
#pragma unroll
    for (int s = 0; s < 4; ++s) kf[s] = kn[s];
    if (__all(R < -104.f * 1.4426950408889634f)) break;
  }
  store_gated<2>(O, (float*)smem + (tid >> 6) * 4608, p.P + (tok - r) * NP + 2560 + hd * 64, p.y + (tok - r) * DM + hd * 64, nullptr, lane);
}

DI float wave_sum(float v) { for (int o = 32; o > 0; o >>= 1) v += __shfl_xor(v, o); return v; }
DI float wave_max(float v) { for (int o = 32; o > 0; o >>= 1) v = fmaxf(v, __shfl_xor(v, o)); return v; }

DI bool gemm_sched(int rd, int ntn, int& mti, int& nti) {
  const int nb = gridDim.x, bid = blockIdx.x;
  if (nb == 256) {
    const int xcd = bid & 7, li = bid >> 3, ti = rd * 32 + li;
    if (ti >= 8 * ntn) return false;
    mti = xcd * 8 + (ti & 7); nti = ti >> 3; return true;
  }
  const int t = rd * nb + bid;
  if (t >= 64 * ntn) return false;
  mti = t / ntn; nti = t % ntn; return true;
}

DI void proj_phase(const Params& p, int layer, bf16_t* smem) {
  const int nb = gridDim.x, bid = blockIdx.x;
  if (nb == 256) {
    const int xcd = bid & 7, li = bid >> 3;
    for (int rd = 0; rd < 3; ++rd) { const int ti = rd * 32 + li; proj_tile<4>(p, layer, (xcd * 8 + (ti & 7)) * 256, ti >> 3, smem); }
    { const int ti = 96 + (li >> 1); proj_tile<2>(p, layer, (xcd * 8 + (ti & 7)) * 256 + (li & 1) * 128, ti >> 3, smem); }
  } else {
    for (int t = bid; t < 64 * 14; t += nb) proj_tile<4>(p, layer, (t / 14) * 256, t % 14, smem);
  }
}

DI unsigned xb_ld(unsigned* q) { return __hip_atomic_load(q, __ATOMIC_RELAXED, __HIP_MEMORY_SCOPE_AGENT); }
DI unsigned xb_add(unsigned* q, unsigned v) { return __hip_atomic_fetch_add(q, v, __ATOMIC_RELAXED, __HIP_MEMORY_SCOPE_AGENT); }
DI void xb_st(unsigned* q, unsigned v) { __hip_atomic_store(q, v, __ATOMIC_RELAXED, __HIP_MEMORY_SCOPE_AGENT); }
struct XB { unsigned* w; unsigned x, nx, nxcc, bsub, bgen, btop, btg, k; };
#define XB_SPIN(cond) do { unsigned sp_ = 0; while (cond) { __builtin_amdgcn_s_sleep(1); if (++sp_ > (1u << 21)) break; } } while (0)
DI void xb_init(XB& b, unsigned* w) {
  b.w = w; b.k = 0; b.nx = 0; b.nxcc = 0;
  b.x = (unsigned)__builtin_amdgcn_s_getreg((3 << 11) | 20) & 0xFu;
  b.bsub = xb_ld(w + 4096 + 1024 + 64 * b.x); b.bgen = xb_ld(w + 4096 + 2048 + 64 * b.x);
  b.btop = xb_ld(w + 4096 + 3072); b.btg = xb_ld(w + 4096 + 3136);
  (void)xb_add(w + 64 * b.x, 1u);
}
DI void grid_barrier(XB& b, bool last) {
  asm volatile("s_waitcnt vmcnt(0)" ::: "memory");
  __syncthreads();
  if (threadIdx.x == 0) {
    unsigned* w = b.w;
    if (b.k == 0) {
      unsigned tot = 0, nx = 0, nxcc = 0, sp = 0;
      for (;;) {
        tot = 0; nx = 0; nxcc = 0;
        for (unsigned j = 0; j < 16; ++j) { const unsigned c = xb_ld(w + 64 * j) - xb_ld(w + 4096 + 64 * j); tot += c; nxcc += (c != 0u); if (j == b.x) nx = c; }
        if (tot == gridDim.x || ++sp > (1u << 18)) break;
        __builtin_amdgcn_s_sleep(1);
      }
      b.nx = nx; b.nxcc = nxcc;
    }
    b.k += 1;
    const unsigned old = xb_add(w + 1024 + 64 * b.x, 1u);
    if (old - b.bsub + 1u == b.k * b.nx) {
      __builtin_amdgcn_fence(__ATOMIC_RELEASE, "agent");
      asm volatile("s_waitcnt vmcnt(0)" ::: "memory");
      const unsigned ot = xb_add(w + 3072, 1u);
      if (ot - b.btop + 1u == b.k * b.nxcc) {
        if (last) { xb_st(w + 4096 + 3072, b.btop + b.k * b.nxcc); xb_st(w + 4096 + 3136, b.btg + b.k); }
        (void)xb_add(w + 3136, 1u);
      }
      XB_SPIN((int)(xb_ld(w + 3136) - b.btg - b.k) < 0);
      if (last) { xb_st(w + 4096 + 64 * b.x, xb_ld(w + 64 * b.x)); xb_st(w + 4096 + 1024 + 64 * b.x, b.bsub + b.k * b.nx); xb_st(w + 4096 + 2048 + 64 * b.x, b.bgen + b.k); }
      (void)xb_add(w + 2048 + 64 * b.x, 1u);
    } else {
      XB_SPIN((int)(xb_ld(w + 2048 + 64 * b.x) - b.bgen - b.k) < 0);
    }
    __builtin_amdgcn_fence(__ATOMIC_ACQUIRE, "agent");
    asm volatile("s_waitcnt vmcnt(0)" ::: "memory");
  }
  __syncthreads();
}

__global__ void __launch_bounds__(512, 2) yoco_fwd(Params p) {
  extern __shared__ __attribute__((aligned(16))) bf16_t smem[];
  cg::grid_group grid = cg::this_grid();
  const int tid = threadIdx.x, lane = tid & 63, wid = tid >> 6, nb = gridDim.x, bid = blockIdx.x, grp = wid >> 2, wq = wid & 3;
  int* s_unit = (int*)(smem + LDS_ELEMS);
  const float LOG2E = 1.4426950408889634f;
  XB xb = {};
  if (tid == 0) xb_init(xb, p.xbw);
  if (bid == 0 && tid < 64) p.ctr[tid] = 0;
  if (p.out == nullptr) grid.sync();

  phase0(p, smem);
  grid_barrier(xb, false);

  proj_phase(p, 0, smem);
  grid_barrier(xb, false);

  {
    const float d1 = wave_sum(p.lq1[lane] * p.lk1[lane]), d2 = wave_sum(p.lq2[lane] * p.lk2[lane]);
    const float lam = __expf(d1) - __expf(d2) + 0.2f;
    const float mqa = wave_max(fabsf(p.a_q_norm[lane])), mka = wave_max(fabsf(p.a_k_norm[lane]));
    const float mqm = wave_max(fabsf(p.mem_q_norm[lane])), mkm = wave_max(fabsf(p.mem_k_norm[lane]));
    const float sc2 = 0.125f * LOG2E;
    const float msh_a = 8.f * mqa * mka * LOG2E, msh_m = 8.f * mqm * mkm * LOG2E;
    unsigned* kvflag = (unsigned*)(p.ctr + 16);
    bool memkv_ready = false;
    const int xq = bid & 7;
    for (;;) {
      __syncthreads();
      if (tid == 0) *s_unit = atomicAdd(&p.ctr[40 + xq], 1);
      __syncthreads();
      const int u = *s_unit;
      if (u >= 1 + 96 + 32) break;
      if (u == 0) {
        mem_tile(p, xq >> 2, (xq >> 1) & 1, xq & 1, smem);
        if (xq < 4) {
          asm volatile("s_waitcnt vmcnt(0)" ::: "memory");
          __syncthreads();
          if (tid == 0) {
            __builtin_amdgcn_fence(__ATOMIC_RELEASE, "agent");
            asm volatile("s_waitcnt vmcnt(0)" ::: "memory");
            (void)__hip_atomic_fetch_add(kvflag, 1u, __ATOMIC_RELAXED, __HIP_MEMORY_SCOPE_AGENT);
          }
        }
      } else if (u < 1 + 96) {
        const int a = u - 1;
        int bh, qb;
        if (a < 32) { bh = 8 + (xq >> 1); qb = 62 + (xq & 1) - 2 * a; } else { bh = xq; qb = 63 - (a - 32); }
        attn_a_unit(p, bh / 6, bh % 6, qb, smem, lam, msh_a);
      } else {
        if (!memkv_ready) {
          if (tid == 0) {
            while (__hip_atomic_load(kvflag, __ATOMIC_RELAXED, __HIP_MEMORY_SCOPE_AGENT) < 4u) __builtin_amdgcn_s_sleep(1);
            __builtin_amdgcn_fence(__ATOMIC_ACQUIRE, "agent");
            asm volatile("s_waitcnt vmcnt(0)" ::: "memory");
          }
          __syncthreads();
          memkv_ready = true;
        }
        const int v = (xq * 32 + (u - 97)) * 2 + grp; mem_wave(p, 0, v >> 8, v & 3, ((v & 255) >> 2) * 128 + wq * 32, sc2, msh_m, smem);
      }
    }
  }
  grid_barrier(xb, false);

  {
    int mti, nti;
    for (int rd = 0; gemm_sched(rd, 4, mti, nti); ++rd) out_tile(p, p.W2t, true, mti, nti, smem);
  }
  grid_barrier(xb, false);

  proj_phase(p, 1, smem);
  grid_barrier(xb, false);

  {
    const float mqm = wave_max(fabsf(p.mem_q_norm[64 + lane])), mkm = wave_max(fabsf(p.mem_k_norm[64 + lane]));
    const float sc2 = 0.125f * LOG2E, msh_m = 8.f * mqm * mkm * LOG2E;
    const int bx = (nb & 7) ? bid : (bid & 7) * (nb >> 3) + (bid >> 3);
    for (int u = bx * 8 + wid; u < 6144 + 2048; u += nb * 8) {
      if (u < 6144) { const int bh = u >> 8, q32 = 255 - (u & 255); sb_wave(p, bh / 12, bh % 12, q32 * 32, smem); }
      else { const int v = u - 6144, rem = v & 1023; mem_wave(p, 1, v >> 10, (rem >> 2) & 3, (rem >> 4) * 128 + (rem & 3) * 32, sc2, msh_m, smem); }
    }
  }
  grid_barrier(xb, true);

  {
    int mti, nti;
    for (int rd = 0; gemm_sched(rd, 4, mti, nti); ++rd) out_tile(p, p.W4t, false, mti, nti, smem);
  }
}

extern "C" void kernel_launch(void* const* d_in, const int* in_sizes, int n_in, void* d_out, int out_size, void* d_ws, size_t ws_size, hipStream_t stream) {
  static int grid_blocks = 0;
  if (!grid_blocks) {
    int dev = 0, cus = 0, per_cu = 0;
    (void)hipGetDevice(&dev);
    (void)hipDeviceGetAttribute(&cus, hipDeviceAttributeMultiprocessorCount, dev);
    (void)hipFuncSetAttribute((const void*)yoco_fwd, hipFuncAttributeMaxDynamicSharedMemorySize, LDS_BYTES);
    (void)hipOccupancyMaxActiveBlocksPerMultiprocessor(&per_cu, yoco_fwd, NT, LDS_BYTES);
    if (per_cu > 1) per_cu = 1;
    if (per_cu < 1) per_cu = 1;
    grid_blocks = cus * per_cu;
  }
  Params p;
  memset(&p, 0, sizeof(p));
  const float* const* in = (const float* const*)d_in;
  p.x = in[0]; p.mem = in[1]; p.pos = (const int*)d_in[2];
  p.a_q_norm = in[5]; p.a_k_norm = in[6]; p.lq1 = in[7]; p.lk1 = in[8]; p.lq2 = in[9]; p.lk2 = in[10]; p.a_subln = in[11];
  p.mem_q_norm = in[20]; p.mem_k_norm = in[21];
  p.out = (float*)d_out;
  char* w = (char*)d_ws;
  size_t off = 0;
  auto take = [&](size_t bytes) { char* q = w + off; off += (bytes + 255) & ~(size_t)255; return q; };
  p.ctr = (int*)take(1024);
  p.xbw = (unsigned*)take(32768);
  p.P = (bf16_t*)take((size_t)NTOK * NP * 2);
  p.Vt = (bf16_t*)take((size_t)2 * 768 * SEQ * 2);
  p.xb = (bf16_t*)take((size_t)NTOK * DM * 2);
  p.y = (bf16_t*)take((size_t)NTOK * DM * 2);
  p.Ksb = (bf16_t*)take((size_t)2 * 768 * SEQ * 2);
  p.W1t = (bf16_t*)take((size_t)3584 * DM * 2);
  p.W2t = (bf16_t*)take((size_t)1024 * DM * 2);
  p.W3t = (bf16_t*)take((size_t)3584 * DM * 2);
  p.W4t = (bf16_t*)take((size_t)1024 * DM * 2);
  p.Wmt = (bf16_t*)take((size_t)2 * 512 * DM * 2);
  p.memb = (bf16_t*)take((size_t)512 * DM * 2);
  p.Km = (bf16_t*)take((size_t)2 * 512 * 256 * 2);
  p.Vmt = (bf16_t*)take((size_t)2 * 512 * 256 * 2);
  p.ssq0 = (float*)take((size_t)NTOK * 16 * 4);
  p.ssq1 = (float*)take((size_t)NTOK * 16 * 4);
  p.ssqm = (float*)take((size_t)512 * 16 * 4);
  p.cs = (float*)take((size_t)NTOK * 16 * 4);
  const float* a_norm = in[3]; const float* a_w_in = in[4]; const float* a_w_out = in[12]; const float* kv_norm = in[13]; const float* w_kv = in[14];
  const float* b_norm = in[15]; const float* b_w_in = in[16]; const float* b_w_out = in[17]; const float* mem_norm = in[18]; const float* mem_w_kv = in[19];
  auto setseg = [&](int i, const float* src, const float* gain, bf16_t* dst, int ld, int col0, int ncols) {
    p.seg[i].src = src; p.seg[i].gain = gain; p.seg[i].dst = dst; p.seg[i].ld = ld; p.seg[i].col0 = col0; p.seg[i].ncols = ncols; p.seg[i].pad = 0; };
  setseg(0, a_w_in, a_norm, p.W1t, 3584, 0, 3584);
  setseg(1, a_w_out, nullptr, p.W2t, 1024, 0, 1024);
  setseg(2, b_w_in, b_norm, p.W3t, 2048, 0, 768);
  setseg(3, w_kv, kv_norm, p.W3t + (size_t)768 * DM, 1536, 0, 1536);
  setseg(4, b_w_in, b_norm, p.W3t + (size_t)2304 * DM, 2048, 768, 1280);
  setseg(5, b_w_out, nullptr, p.W4t, 1024, 0, 1024);
  setseg(6, mem_w_kv, mem_norm, p.Wmt, 512, 0, 512);
  setseg(7, mem_w_kv + (size_t)1024 * 512, mem_norm + 1024, p.Wmt + (size_t)512 * DM, 512, 0, 512);
  for (int i = 0; i < 8; ++i) p.inv[i] = (float)pow(500000.0, -(double)i / 8.0);
  void* args[] = {&p};
  hipError_t e = hipLaunchCooperativeKernel((const void*)yoco_fwd, dim3(grid_blocks), dim3(NT), args, LDS_BYTES, stream);
  if (e != hipSuccess) fprintf(stderr, "cooperative launch failed: %s (grid %d)\n", hipGetErrorString(e), grid_blocks);
}
```

```cpp
#include <hip/hip_runtime.h>
#include <hip/hip_cooperative_groups.h>
#include <cstdio>
#include <cmath>
#include <cstring>
namespace cg = cooperative_groups;

typedef unsigned short bf16_t;
typedef short bf16x8 __attribute__((ext_vector_type(8)));
typedef short bf16x4 __attribute__((ext_vector_type(4)));
typedef float f32x16 __attribute__((ext_vector_type(16)));
typedef float f32x4 __attribute__((ext_vector_type(4)));
typedef float f32x2 __attribute__((ext_vector_type(2)));
typedef unsigned u32x4 __attribute__((ext_vector_type(4)));
typedef unsigned u32x2 __attribute__((ext_vector_type(2)));
typedef __bf16 bf2_t __attribute__((ext_vector_type(2)));

#define DI __device__ __forceinline__
#define MFMA32(a, b, c) __builtin_amdgcn_mfma_f32_32x32x16_bf16((a), (b), (c), 0, 0, 0)

constexpr int SEQ = 8192, DM = 1024, NTOK = 16384, NP = 3584;
constexpr int NT = 512;
constexpr float EPS = 1e-6f;
constexpr int LDS_ELEMS = 2 * 512 * 72;
constexpr int LDS_BYTES = LDS_ELEMS * 2 + 16;

struct Seg { const float* src; const float* gain; bf16_t* dst; int ld; int col0; int ncols; int pad; };

struct Params {
  const float* x; const float* mem; const int* pos;
  const float* a_q_norm; const float* a_k_norm; const float* lq1; const float* lk1; const float* lq2; const float* lk2; const float* a_subln;
  const float* mem_q_norm; const float* mem_k_norm;
  float* out;
  bf16_t* xb; bf16_t* memb; bf16_t* P; bf16_t* Vt; bf16_t* y;
  bf16_t* Ksb; bf16_t* W1t; bf16_t* W2t; bf16_t* W3t; bf16_t* W4t; bf16_t* Wmt; bf16_t* Km; bf16_t* Vmt;
  float* ssq0; float* ssq1; float* ssqm; float* cs; int* ctr; unsigned* xbw;
  Seg seg[8];
  float inv[8];
};

DI unsigned pk2(float a, float b) { f32x2 v = {a, b}; bf2_t r = __builtin_convertvector(v, bf2_t); return __builtin_bit_cast(unsigned, r); }
DI bf16_t f2bf(float a) { return (bf16_t)(pk2(a, 0.f) & 0xffffu); }
DI float bflo(unsigned w) { return __uint_as_float(w << 16); }
DI float bfhi(unsigned w) { return __uint_as_float(w & 0xffff0000u); }
DI int crow(int reg, int h) { return (reg & 3) + 8 * (reg >> 2) + 4 * h; }
DI int perm16(int kk) { return ((kk >> 2) & 1) * 8 + (kk >> 3) * 4 + (kk & 3); }
DI bf16x8 pack8(const float* v) {
  u32x4 w; w.x = pk2(v[0], v[1]); w.y = pk2(v[2], v[3]); w.z = pk2(v[4], v[5]); w.w = pk2(v[6], v[7]);
  return __builtin_bit_cast(bf16x8, w);
}
DI int opaque_tid() { int t = threadIdx.x; asm volatile("" : "+v"(t)); return t; }
DI f32x16 zero16() { f32x16 z; for (int i = 0; i < 16; ++i) z[i] = 0.f; return z; }

__device__ void phase0(const Params& p, bf16_t* smem) {
  const int tid = opaque_tid(), lane = tid & 63, wid = tid >> 6, nb = gridDim.x, bid = blockIdx.x;
  for (int row0 = (bid * 8 + wid) * 2; row0 < NTOK + 512; row0 += nb * 16) {
    f32x4 v[2][4];
#pragma unroll
    for (int q = 0; q < 2; ++q) {
      const int row = row0 + q;
      const float* src = (row < NTOK) ? p.x + (size_t)row * DM : p.mem + (size_t)(row - NTOK) * DM;
#pragma unroll
      for (int j = 0; j < 4; ++j) v[q][j] = *(const f32x4*)(src + 256 * j + 4 * lane);
    }
#pragma unroll
    for (int q = 0; q < 2; ++q) {
      const int row = row0 + q;
      bf16_t* dst; float* sq;
      if (row < NTOK) { dst = p.xb + (size_t)row * DM; sq = p.ssq0 + (size_t)row * 16; }
      else { const int r2 = row - NTOK; dst = p.memb + (size_t)r2 * DM; sq = p.ssqm + (size_t)r2 * 16; }
#pragma unroll
      for (int j = 0; j < 4; ++j) {
        const f32x4 t = v[q][j];
        float s = t.x * t.x + t.y * t.y + t.z * t.z + t.w * t.w;
        u32x2 w; w.x = pk2(t.x, t.y); w.y = pk2(t.z, t.w);
        *(u32x2*)(dst + 256 * j + 4 * lane) = w;
        s += __shfl_xor(s, 1); s += __shfl_xor(s, 2); s += __shfl_xor(s, 4); s += __shfl_xor(s, 8);
        if ((lane & 15) == 0) sq[4 * j + (lane >> 4)] = s;
      }
    }
  }
  for (int i = bid * NT + tid; i < NTOK * 8; i += nb * NT) {
    const int token = i >> 3, f = i & 7;
    const float ang = (float)p.pos[token] * p.inv[f];
    double rev = (double)ang * 0.15915494309189535;
    rev -= floor(rev);
    const double q4 = rint(rev * 4.0);
    const double a = (rev - q4 * 0.25) * 6.283185307179586;
    const int q = ((int)q4) & 3;
    const double a2 = a * a;
    double sn = -1.0 / 39916800.0; sn = sn * a2 + 1.0 / 362880.0; sn = sn * a2 - 1.0 / 5040.0; sn = sn * a2 + 1.0 / 120.0; sn = sn * a2 - 1.0 / 6.0; sn = sn * a2 + 1.0; sn *= a;
    double cn = 1.0 / 479001600.0; cn = cn * a2 - 1.0 / 3628800.0; cn = cn * a2 + 1.0 / 40320.0; cn = cn * a2 - 1.0 / 720.0; cn = cn * a2 + 1.0 / 24.0; cn = cn * a2 - 0.5; cn = cn * a2 + 1.0;
    double c, s;
    if (q == 0) { c = cn; s = sn; } else if (q == 1) { c = -sn; s = cn; } else if (q == 2) { c = -cn; s = -sn; } else { c = sn; s = -cn; }
    p.cs[(size_t)token * 16 + f] = (float)c;
    p.cs[(size_t)token * 16 + 8 + f] = (float)s;
  }
  {
    f32x4 nv[2]; float ng[2]; bf16_t* ndst = nullptr;
    auto fetch = [&](int t) {
      int ct = t >> 4; const int k0 = (t & 15) * 64;
      int si = 0;
      while (ct >= (p.seg[si].ncols >> 6)) { ct -= (p.seg[si].ncols >> 6); ++si; }
      const Seg sg = p.seg[si];
      const int n0 = ct * 64;
#pragma unroll
      for (int j = 0; j < 2; ++j) {
        const int i = tid + NT * j, kr = i >> 4, c4 = i & 15;
        nv[j] = *(const f32x4*)(sg.src + (size_t)(k0 + kr) * sg.ld + sg.col0 + n0 + c4 * 4);
        ng[j] = sg.gain ? sg.gain[k0 + kr] : 1.f;
      }
      ndst = sg.dst + (size_t)(n0 + (tid >> 3)) * DM + k0 + (tid & 7) * 8;
    };
    if (bid < 2560) fetch(bid);
    for (int t = bid; t < 2560; t += nb) {
      const f32x4 v0 = nv[0], v1 = nv[1]; const float g0 = ng[0], g1 = ng[1]; bf16_t* dst = ndst;
      if (t + nb < 2560) fetch(t + nb);
      __syncthreads();
      {
        const int kr = tid >> 4, c4 = tid & 15;
        smem[(c4 * 4 + 0) * 72 + kr] = f2bf(v0.x * g0); smem[(c4 * 4 + 1) * 72 + kr] = f2bf(v0.y * g0);
        smem[(c4 * 4 + 2) * 72 + kr] = f2bf(v0.z * g0); smem[(c4 * 4 + 3) * 72 + kr] = f2bf(v0.w * g0);
        smem[(c4 * 4 + 0) * 72 + kr + 32] = f2bf(v1.x * g1); smem[(c4 * 4 + 1) * 72 + kr + 32] = f2bf(v1.y * g1);
        smem[(c4 * 4 + 2) * 72 + kr + 32] = f2bf(v1.z * g1); smem[(c4 * 4 + 3) * 72 + kr + 32] = f2bf(v1.w * g1);
      }
      __syncthreads();
      *(u32x4*)dst = *(const u32x4*)(smem + (tid >> 3) * 72 + (tid & 7) * 8);
    }
  }
  __syncthreads();
}

template <int MT>
DI void gemm_core(const bf16_t* __restrict__ Wt, const bf16_t* __restrict__ X, int n0, int m0, f32x16 (&acc)[2][MT], bf16_t* smem) {
  const int tid = opaque_tid(), lane = tid & 63, wid = tid >> 6, wn = wid >> 1, wm = wid & 1, r = lane & 31, h = lane >> 5;
  bf16_t* Ws = smem;
  bf16_t* Xs = smem + 2 * 256 * 72;
  const char* wub = (const char*)(Wt + (size_t)n0 * DM);
  const char* xub = (const char*)(X + (size_t)m0 * DM);
  const unsigned voff = (unsigned)(((tid >> 3) * DM + (tid & 7) * 8) * 2);
#define GLD_W(i, k) (*(const u32x4*)(wub + ((size_t)(i) * 64 * DM * 2 + (size_t)(k) * 128) + voff))
#define GLD_X(i, k) (*(const u32x4*)(xub + ((size_t)(i) * 64 * DM * 2 + (size_t)(k) * 128) + voff))
  const int so = (tid >> 3) * 72 + (tid & 7) * 8;
  u32x4 wr[4], xr[MT];
#pragma unroll
  for (int i = 0; i < 4; ++i) wr[i] = GLD_W(i, 0);
#pragma unroll
  for (int i = 0; i < MT; ++i) xr[i] = GLD_X(i, 0);
  __syncthreads();
#pragma unroll
  for (int i = 0; i < 4; ++i) *(u32x4*)(Ws + so + i * 64 * 72) = wr[i];
#pragma unroll
  for (int i = 0; i < MT; ++i) *(u32x4*)(Xs + so + i * 64 * 72) = xr[i];
#pragma unroll
  for (int i = 0; i < 4; ++i) wr[i] = GLD_W(i, 1);
#pragma unroll
  for (int i = 0; i < MT; ++i) xr[i] = GLD_X(i, 1);
  __syncthreads();
  const int ao = (wn * 64 + r) * 72 + h * 8, bo = (wm * (MT * 32) + r) * 72 + h * 8;
  for (int kt = 0; kt < 16; ++kt) {
    const int cur = (kt & 1) * 256 * 72, nxt = ((kt + 1) & 1) * 256 * 72;
#pragma unroll
    for (int s = 0; s < 4; ++s) {
      bf16x8 a[2], b[MT];
#pragma unroll
      for (int nt = 0; nt < 2; ++nt) a[nt] = *(const bf16x8*)(Ws + cur + ao + nt * 32 * 72 + s * 16);
#pragma unroll
      for (int mt = 0; mt < MT; ++mt) b[mt] = *(const bf16x8*)(Xs + cur + bo + mt * 32 * 72 + s * 16);
      if (kt + 1 < 16) {
        *(u32x4*)(Ws + nxt + so + s * 64 * 72) = wr[s];
        if (s < MT) *(u32x4*)(Xs + nxt + so + s * 64 * 72) = xr[s < MT ? s : 0];
        if (kt + 2 < 16) {
          wr[s] = GLD_W(s, kt + 2);
          if (s < MT) xr[s < MT ? s : 0] = GLD_X(s, kt + 2);
        }
      }
#pragma unroll
      for (int nt = 0; nt < 2; ++nt)
#pragma unroll
        for (int mt = 0; mt < MT; ++mt) acc[nt][mt] = MFMA32(a[nt], b[mt], acc[nt][mt]);
    }
    __syncthreads();
  }
}

DI float row_rinv(const float* ssq, int token) {
  const f32x4* q = (const f32x4*)(ssq + (size_t)token * 16);
  const f32x4 a = q[0], b = q[1], c = q[2], d = q[3];
  const float s = ((a.x + a.y) + (a.z + a.w)) + ((b.x + b.y) + (b.z + b.w)) + ((c.x + c.y) + (c.z + c.w)) + ((d.x + d.y) + (d.z + d.w));
  return rsqrtf(s * (1.f / 1024.f) + EPS);
}

enum { EK_QKROPE = 0, EK_NORM = 1, EK_PLAIN = 2, EK_VT = 3, EK_SILU = 4, EK_VBLK = 5 };

template <int MT>
DI void epi_proj(const f32x16 (&acc)[2][MT], int kind, const float* __restrict__ ssq0, const float* __restrict__ gain, const float* __restrict__ cs0,
                 bf16_t* __restrict__ dbase, int ld, bf16_t* __restrict__ vbase, int vt_ld, bf16_t* smem, float qscale) {
  const int tid = opaque_tid(), lane = tid & 63, wid = tid >> 6, r = lane & 31, h = lane >> 5;
  bf16_t* wreg = smem + wid * 9216;
#pragma unroll
  for (int mt = 0; mt < MT; ++mt) {
    const float rs = row_rinv(ssq0, mt * 32);
    float v[2][16];
#pragma unroll
    for (int nt = 0; nt < 2; ++nt)
#pragma unroll
      for (int i = 0; i < 16; ++i) v[nt][i] = acc[nt][mt][i] * rs;
    if (kind <= EK_NORM) {
      float ss = 0.f;
#pragma unroll
      for (int nt = 0; nt < 2; ++nt)
#pragma unroll
        for (int i = 0; i < 16; ++i) ss += v[nt][i] * v[nt][i];
      ss += __shfl_xor(ss, 32);
      const float rn = rsqrtf(ss * (1.f / 64.f) + EPS);
#pragma unroll
      for (int nt = 0; nt < 2; ++nt)
#pragma unroll
        for (int g = 0; g < 4; ++g) {
          const f32x4 gg = *(const f32x4*)(gain + nt * 32 + 8 * g + 4 * h);
          v[nt][4 * g + 0] *= rn * gg.x; v[nt][4 * g + 1] *= rn * gg.y; v[nt][4 * g + 2] *= rn * gg.z; v[nt][4 * g + 3] *= rn * gg.w;
        }
      if (kind == EK_QKROPE) {
        const f32x4 c = *(const f32x4*)(cs0 + mt * 32 * 16 + 4 * h);
        const f32x4 s = *(const f32x4*)(cs0 + mt * 32 * 16 + 8 + 4 * h);
#pragma unroll
        for (int i = 0; i < 4; ++i) {
          const float x1 = v[0][i], x2 = v[0][4 + i];
          v[0][i] = x1 * c[i] - x2 * s[i];
          v[0][4 + i] = x2 * c[i] + x1 * s[i];
        }
#pragma unroll
        for (int nt = 0; nt < 2; ++nt)
#pragma unroll
          for (int i = 0; i < 16; ++i) v[nt][i] *= qscale;
      }
    } else if (kind == EK_PLAIN) {
#pragma unroll
      for (int nt = 0; nt < 2; ++nt)
#pragma unroll
        for (int i = 0; i < 16; ++i) v[nt][i] *= qscale;
    } else if (kind == EK_SILU) {
#pragma unroll
      for (int nt = 0; nt < 2; ++nt)
#pragma unroll
        for (int i = 0; i < 16; ++i) v[nt][i] = v[nt][i] * __builtin_amdgcn_rcpf(1.f + __builtin_amdgcn_exp2f(-1.4426950408889634f * v[nt][i]));
    }
    if (kind == EK_VT || kind == EK_VBLK) {
#pragma unroll
      for (int nt = 0; nt < 2; ++nt)
#pragma unroll
        for (int i = 0; i < 16; ++i) wreg[(nt * 32 + crow(i, h)) * 136 + mt * 32 + (r & 16) + perm16(r & 15)] = f2bf(v[nt][i]);
    } else {
#pragma unroll
      for (int nt = 0; nt < 2; ++nt)
#pragma unroll
        for (int g = 0; g < 4; ++g) {
          u32x2 w; w.x = pk2(v[nt][4 * g], v[nt][4 * g + 1]); w.y = pk2(v[nt][4 * g + 2], v[nt][4 * g + 3]);
          *(u32x2*)(wreg + (mt * 32 + r) * 72 + nt * 32 + 8 * g + 4 * h) = w;
        }
    }
  }
  __syncthreads();
  constexpr int CPR = MT * 4, RPI = 64 / CPR;
  if (kind == EK_VT) {
#pragma unroll
    for (int j = 0; j < CPR; ++j) {
      const int n = j * RPI + lane / CPR, c = lane % CPR;
      *(u32x4*)(vbase + (size_t)n * vt_ld + c * 8) = *(const u32x4*)(wreg + n * 136 + c * 8);
    }
  } else if (kind == EK_VBLK) {
#pragma unroll
    for (int j = 0; j < CPR; ++j) {
      const int n = j * RPI + lane / CPR, c = lane % CPR;
      *(u32x4*)(vbase + (size_t)(c >> 2) * 2048 + n * 32 + (c & 3) * 8) = *(const u32x4*)(wreg + n * 136 + c * 8);
    }
  } else {
#pragma unroll
    for (int j = 0; j < MT * 4; ++j) {
      const int row = j * 8 + (lane >> 3), c = lane & 7;
      *(u32x4*)(dbase + (size_t)row * ld + c * 8) = *(const u32x4*)(wreg + row * 72 + c * 8);
    }
  }
}

template <int MT>
DI void zero_acc(f32x16 (&acc)[2][MT]) {
#pragma unroll
  for (int a = 0; a < 2; ++a)
#pragma unroll
    for (int b = 0; b < MT; ++b) acc[a][b] = zero16();
}

template <int MT>
__device__ void proj_tile(const Params& p, int layer, int m0, int nti, bf16_t* smem) {
  const int tid = opaque_tid(), lane = tid & 63, wid = tid >> 6, wn = wid >> 1, wm = wid & 1, r = lane & 31, h = lane >> 5;
  const int n0 = nti * 256;
  f32x16 acc[2][MT];
  zero_acc<MT>(acc);
  gemm_core<MT>(layer ? p.W3t : p.W1t, p.xb, n0, m0, acc, smem);
  const float* ssq = layer ? p.ssq1 : p.ssq0;
  const int tok = m0 + wm * (MT * 32) + r;
  const int cc = n0 + wn * 64;
  int kind; const float* gain = p.a_q_norm;
  if (cc < 1536) { kind = layer ? EK_PLAIN : EK_QKROPE; gain = (cc < 768) ? p.a_q_norm : p.a_k_norm; }
  else if (cc < 2304) kind = EK_VT;
  else if (cc < 2560) { kind = EK_NORM; gain = p.mem_q_norm + layer * 64; }
  else kind = EK_SILU;
  const int tok0 = m0 + wm * (MT * 32), b = tok0 >> 13;
  bf16_t* vtb = p.Vt + ((size_t)b * 768 + (cc - 1536)) * SEQ + (tok0 & (SEQ - 1));
  bf16_t* dbase = p.P + (size_t)tok0 * NP + cc;
  int ld = NP;
  if (layer && cc >= 768 && cc < 1536) {
    dbase = p.Ksb + (((size_t)b * 12 + ((cc - 768) >> 6)) * SEQ + (tok0 & (SEQ - 1))) * 64; ld = 64;
  } else if (layer && kind == EK_VT) {
    kind = EK_VBLK;
    vtb = p.Vt + (((size_t)b * 12 + ((cc - 1536) >> 6)) * 256 + ((tok0 & (SEQ - 1)) >> 5)) * 2048;
  }
  epi_proj<MT>(acc, kind, ssq + (size_t)tok * 16, gain, p.cs + (size_t)tok * 16, dbase, ld, vtb, SEQ, smem, (cc < 768) ? 0.125f * 1.4426950408889634f : 1.f);
}

__device__ void mem_tile(const Params& p, int l, int mti, int nti, bf16_t* smem) {
  const int tid = opaque_tid(), lane = tid & 63, wid = tid >> 6, wn = wid >> 1, wm = wid & 1, r = lane & 31, h = lane >> 5;
  const int m0 = mti * 256, n0 = nti * 256;
  f32x16 acc[2][4];
  zero_acc<4>(acc);
  gemm_core<4>(p.Wmt + (size_t)l * 512 * DM, p.memb, n0, m0, acc, smem);
  const int tok = m0 + wm * 128 + r;
  const int cc = n0 + wn * 64;
  const int kind = (cc < 256) ? EK_NORM : EK_VT;
  const int tok0 = m0 + wm * 128, b = tok0 >> 8;
  bf16_t* vtb = p.Vmt + ((size_t)(l * 2 + b) * 256 + (cc - 256)) * 256 + (tok0 & 255);
  epi_proj<4>(acc, kind, p.ssqm + (size_t)tok * 16, p.mem_k_norm + l * 64, p.cs, p.Km + ((size_t)l * 512 + tok0) * 256 + cc, 256, vtb, 256, smem, 1.f);
}

__device__ void out_tile(const Params& p, const bf16_t* Wt, bool first, int mti, int nti, bf16_t* smem) {
  const int tid = opaque_tid(), lane = tid & 63, wid = tid >> 6, wn = wid >> 1, wm = wid & 1, r = lane & 31, h = lane >> 5;
  const int m0 = mti * 256, n0 = nti * 256;
  f32x16 acc[2][4];
  zero_acc<4>(acc);
  gemm_core<4>(Wt, p.y, n0, m0, acc, smem);
  const int cc = n0 + wn * 64;
  float* freg = (float*)smem + wid * 4608;
#pragma unroll
  for (int half = 0; half < 2; ++half) {
#pragma unroll
    for (int mtl = 0; mtl < 2; ++mtl)
#pragma unroll
      for (int nt = 0; nt < 2; ++nt)
#pragma unroll
        for (int g = 0; g < 4; ++g) {
          f32x4 o; o.x = acc[nt][half * 2 + mtl][4 * g + 0]; o.y = acc[nt][half * 2 + mtl][4 * g + 1]; o.z = acc[nt][half * 2 + mtl][4 * g + 2]; o.w = acc[nt][half * 2 + mtl][4 * g + 3];
          *(f32x4*)(freg + (mtl * 32 + r) * 68 + nt * 32 + 8 * g + 4 * h) = o;
        }
    __syncthreads();
#pragma unroll
    for (int j = 0; j < 16; ++j) {
      const int row = j * 4 + (lane >> 4), c = lane & 15;
      const int tok = m0 + wm * 128 + half * 64 + row;
      const size_t off = (size_t)tok * DM + cc + c * 4;
      const f32x4 a = *(const f32x4*)(freg + row * 68 + c * 4);
      f32x4 o;
      if (first) {
        o = *(const f32x4*)(p.x + off);
        o.x += a.x; o.y += a.y; o.z += a.z; o.w += a.w;
        u32x2 w; w.x = pk2(o.x, o.y); w.y = pk2(o.z, o.w);
        *(u32x2*)(p.xb + off) = w;
        float ss = o.x * o.x + o.y * o.y + o.z * o.z + o.w * o.w;
        ss += __shfl_xor(ss, 1); ss += __shfl_xor(ss, 2); ss += __shfl_xor(ss, 4); ss += __shfl_xor(ss, 8);
        if (c == 0) p.ssq1[(size_t)tok * 16 + (cc >> 6)] = ss;
      } else {
        const u32x2 w = *(const u32x2*)(p.xb + off);
        o.x = bflo(w.x) + a.x; o.y = bfhi(w.x) + a.y; o.z = bflo(w.y) + a.z; o.w = bfhi(w.y) + a.w;
        __builtin_nontemporal_store(o, (f32x4*)(p.out + off));
      }
      if ((j & 3) == 3) __builtin_amdgcn_sched_barrier(0);
    }
    __syncthreads();
  }
}

template <int NDT>
DI void store_gated(const f32x16 (&O)[NDT], float* reg, const bf16_t* __restrict__ grow0, bf16_t* __restrict__ yrow0, const float* __restrict__ gain, int lane) {
  constexpr int RS = NDT * 32 + 4, LPR = NDT * 8, RPI = 64 / LPR;
  const int r = lane & 31, h = lane >> 5;
#pragma unroll
  for (int dvt = 0; dvt < NDT; ++dvt)
#pragma unroll
    for (int g = 0; g < 4; ++g) {
      f32x4 o; o.x = O[dvt][4 * g + 0]; o.y = O[dvt][4 * g + 1]; o.z = O[dvt][4 * g + 2]; o.w = O[dvt][4 * g + 3];
      *(f32x4*)(reg + r * RS + dvt * 32 + 8 * g + 4 * h) = o;
    }
  asm volatile("s_waitcnt lgkmcnt(0)" ::: "memory");
  const int c = lane % LPR;
  f32x4 gg; gg.x = 1.f; gg.y = 1.f; gg.z = 1.f; gg.w = 1.f;
  if (gain) gg = *(const f32x4*)(gain + c * 4);
#pragma unroll
  for (int j = 0; j < 32 / RPI; ++j) {
    const int row = j * RPI + lane / LPR;
    const f32x4 v = *(const f32x4*)(reg + row * RS + c * 4);
    const u32x2 gw = *(const u32x2*)(grow0 + (size_t)row * NP + c * 4);
    u32x2 w;
    w.x = pk2(v.x * gg.x * bflo(gw.x), v.y * gg.y * bfhi(gw.x));
    w.y = pk2(v.z * gg.z * bflo(gw.y), v.w * gg.w * bfhi(gw.y));
    *(u32x2*)(yrow0 + (size_t)row * DM + c * 4) = w;
  }
  asm volatile("s_waitcnt lgkmcnt(0)" ::: "memory");
}

__device__ void attn_a_unit(const Params& p, int b, int hd, int qb, bf16_t* smem, float lam, float msh) {
  const int tid = opaque_tid(), lane = tid & 63, wid = tid >> 6, r = lane & 31, h = lane >> 5, grp = wid >> 2, wq = wid & 3;
  const bf16_t* Pb = p.P + (size_t)b * SEQ * NP;
  const bf16_t* Vb = p.Vt + ((size_t)b * 768 + hd * 128) * SEQ;
  const int q0 = qb * 128 + wq * 32;
  bf16x8 qf[4];
#pragma unroll
  for (int s = 0; s < 4; ++s) qf[s] = *(const bf16x8*)(Pb + (size_t)(q0 + r) * NP + grp * 384 + hd * 64 + s * 16 + h * 8);
  f32x16 O[4];
#pragma unroll
  for (int i = 0; i < 4; ++i) O[i] = zero16();
  float l = 0.f;
  const int nkt = 2 * (qb + 1);
  constexpr int VOFF = 9216, SSTR = 18432;
  const char* kub = (const char*)(Pb + 768 + hd * 64);
  const char* vub = (const char*)Vb;
  const unsigned kvo = (unsigned)(((tid >> 3) * NP + (tid & 7) * 8) * 2);
  const unsigned vvo = (unsigned)(((tid >> 3) * SEQ + (tid & 7) * 8) * 2);
#define GLD_K(i, t) (*(const u32x4*)(kub + ((size_t)(t) * 64 * NP * 2 + (size_t)(i) * 768) + kvo))
#define GLD_V(i, t) (*(const u32x4*)(vub + ((size_t)(i) * 64 * SEQ * 2 + (size_t)(t) * 128) + vvo))
  const int kso = (tid >> 3) * 72 + (tid & 7) * 8;
  const int vso = VOFF + (tid >> 3) * 72 + (tid & 7) * 8;
  const int kro = grp * 64 * 72 + r * 72 + h * 8;
  const int vro = VOFF + r * 72 + 8 * h;
  u32x4 kr[2], vr[2];
#pragma unroll
  for (int i = 0; i < 2; ++i) { kr[i] = GLD_K(i, 0); vr[i] = GLD_V(i, 0); }
#pragma unroll
  for (int i = 0; i < 2; ++i) {
    *(u32x4*)(smem + kso + i * 64 * 72) = kr[i];
    *(u32x4*)(smem + vso + i * 64 * 72) = vr[i];
  }
#pragma unroll
  for (int i = 0; i < 2; ++i) { kr[i] = GLD_K(i, 1); vr[i] = GLD_V(i, 1); }
  __syncthreads();
  for (int kt = 0; kt < nkt; ++kt) {
    const int cur = (kt & 1) * SSTR, nxt = ((kt + 1) & 1) * SSTR;
    if (kt + 1 < nkt) {
#pragma unroll
      for (int i = 0; i < 2; ++i) {
        *(u32x4*)(smem + nxt + kso + i * 64 * 72) = kr[i];
        *(u32x4*)(smem + nxt + vso + i * 64 * 72) = vr[i];
      }
      if (kt + 2 < nkt) {
#pragma unroll
        for (int i = 0; i < 2; ++i) { kr[i] = GLD_K(i, kt + 2); vr[i] = GLD_V(i, kt + 2); }
      }
    }
    const int k0 = kt * 64;
    if (k0 <= q0 + 31) {
      bf16x8 kfr[8], vfa[8], vfb[8];
#pragma unroll
      for (int s = 0; s < 8; ++s) kfr[s] = *(const bf16x8*)(smem + cur + kro + (s >> 2) * 32 * 72 + (s & 3) * 16);
      __builtin_amdgcn_sched_barrier(0);
      f32x16 S0 = zero16(), S1 = zero16();
#pragma unroll
      for (int s = 0; s < 4; ++s) S0 = MFMA32(kfr[s], qf[s], S0);
#pragma unroll
      for (int s = 0; s < 8; ++s) vfa[s] = *(const bf16x8*)(smem + cur + vro + (s >> 1) * 32 * 72 + (s & 1) * 16);
#pragma unroll
      for (int s = 0; s < 4; ++s) S1 = MFMA32(kfr[4 + s], qf[s], S1);
      __builtin_amdgcn_sched_barrier(0);
      const int dq = q0 + r - k0 - 4 * h;
      float pv[16]; bf16x8 pk[2];
#pragma unroll
      for (int s = 0; s < 8; ++s) vfb[s] = *(const bf16x8*)(smem + cur + vro + (s >> 1) * 32 * 72 + 32 + (s & 1) * 16);
#pragma unroll
      for (int i = 0; i < 16; ++i) pv[i] = __builtin_amdgcn_exp2f(S0[i]);
      if (k0 + 31 > q0) {
#pragma unroll
        for (int i = 0; i < 16; ++i) if ((i & 3) + 8 * (i >> 2) > dq) pv[i] = 0.f;
      }
#pragma unroll
      for (int i = 0; i < 16; ++i) l += pv[i];
      pk[0] = pack8(pv); pk[1] = pack8(pv + 8);
      __builtin_amdgcn_sched_barrier(0);
#pragma unroll
      for (int s = 0; s < 8; ++s) O[s >> 1] = MFMA32(vfa[s], pk[s & 1], O[s >> 1]);
#pragma unroll
      for (int i = 0; i < 16; ++i) pv[i] = __builtin_amdgcn_exp2f(S1[i]);
      if (k0 + 63 > q0) {
#pragma unroll
        for (int i = 0; i < 16; ++i) if (32 + (i & 3) + 8 * (i >> 2) > dq) pv[i] = 0.f;
      }
#pragma unroll
      for (int i = 0; i < 16; ++i) l += pv[i];
      bf16x8 pq[2]; pq[0] = pack8(pv); pq[1] = pack8(pv + 8);
      __builtin_amdgcn_sched_barrier(0);
#pragma unroll
      for (int s = 0; s < 8; ++s) O[s >> 1] = MFMA32(vfb[s], pq[s & 1], O[s >> 1]);
    }
    __syncthreads();
  }
  l += __shfl_xor(l, 32);
  float* xch = (float*)smem + (size_t)wq * 65 * 64 + lane;
  if (grp == 1) {
#pragma unroll
    for (int dvt = 0; dvt < 4; ++dvt)
#pragma unroll
      for (int i = 0; i < 16; ++i) xch[(dvt * 16 + i) * 64] = O[dvt][i];
    xch[64 * 64] = l;
  }
  __syncthreads();
  if (grp == 0) {
    const float i1 = 1.f / l, i2 = lam / xch[64 * 64];
    float ss = 0.f;
#pragma unroll
    for (int dvt = 0; dvt < 4; ++dvt)
#pragma unroll
      for (int i = 0; i < 16; ++i) { const float o = O[dvt][i] * i1 - xch[(dvt * 16 + i) * 64] * i2; O[dvt][i] = o; ss += o * o; }
    ss += __shfl_xor(ss, 32);
    const float rn = rsqrtf(ss * (1.f / 128.f) + EPS) * 0.8f;
#pragma unroll
    for (int dvt = 0; dvt < 4; ++dvt)
#pragma unroll
      for (int i = 0; i < 16; ++i) O[dvt][i] *= rn;
    const size_t tok0 = (size_t)b * SEQ + q0;
    store_gated<4>(O, (float*)smem + 16640 + wq * 4352, p.P + tok0 * NP + 2560 + hd * 128, p.y + tok0 * DM + hd * 128, p.a_subln, lane);
  }
}

__device__ void mem_wave(const Params& p, int l, int b, int mh, int q0, float sc2, float msh, bf16_t* smem) {
  const int tid = opaque_tid(), lane = tid & 63, r = lane & 31, h = lane >> 5;
  const size_t tok = (size_t)b * SEQ + q0 + r;
  const bf16_t* prow = p.P + tok * NP;
  bf16x8 qf[4];
#pragma unroll
  for (int s = 0; s < 4; ++s) qf[s] = *(const bf16x8*)(prow + 2304 + mh * 64 + s * 16 + h * 8);
  const bf16_t* Kl = p.Km + ((size_t)(l * 2 + b) * 256 + r) * 256 + mh * 64 + h * 8;
  const bf16_t* Vl = p.Vmt + ((size_t)(l * 2 + b) * 256 + mh * 64 + r) * 256 + 8 * h;
  f32x16 O[2]; O[0] = zero16(); O[1] = zero16();
  float lsum = 0.f;
  bf16x8 kf[4], vf[4], kn[4], vn[4];
#pragma unroll
  for (int s = 0; s < 4; ++s) { kf[s] = *(const bf16x8*)(Kl + s * 16); vf[s] = *(const bf16x8*)(Vl + (s >> 1) * 32 * 256 + (s & 1) * 16); }
#pragma unroll
  for (int s = 0; s < 4; ++s) { kn[s] = kf[s]; vn[s] = vf[s]; }
  for (int kt = 0; kt < 8; ++kt) {
    if (kt + 1 < 8) {
      const int k1 = (kt + 1) * 32;
#pragma unroll
      for (int s = 0; s < 4; ++s) { kn[s] = *(const bf16x8*)(Kl + (size_t)k1 * 256 + s * 16); vn[s] = *(const bf16x8*)(Vl + (s >> 1) * 32 * 256 + k1 + (s & 1) * 16); }
    }
    __builtin_amdgcn_sched_barrier(0);
    f32x16 S = zero16();
#pragma unroll
    for (int s = 0; s < 4; ++s) S = MFMA32(kf[s], qf[s], S);
    float pv[16];
#pragma unroll
    for (int i = 0; i < 16; ++i) { pv[i] = __builtin_amdgcn_exp2f(S[i] * sc2 - msh); lsum += pv[i]; }
    bf16x8 pk[2]; pk[0] = pack8(pv); pk[1] = pack8(pv + 8);
#pragma unroll
    for (int s = 0; s < 4; ++s) O[s >> 1] = MFMA32(vf[s], pk[s & 1], O[s >> 1]);
#pragma unroll
    for (int s = 0; s < 4; ++s) { kf[s] = kn[s]; vf[s] = vn[s]; }
  }
  lsum += __shfl_xor(lsum, 32);
  const float inv = __builtin_amdgcn_rcpf(lsum);
#pragma unroll
  for (int dvt = 0; dvt < 2; ++dvt)
#pragma unroll
    for (int i = 0; i < 16; ++i) O[dvt][i] *= inv;
  store_gated<2>(O, (float*)smem + (tid >> 6) * 4608, prow - (size_t)r * NP + 2560 + 768 + mh * 64, p.y + (tok - r) * DM + 768 + mh * 64, nullptr, lane);
}

__device__ void sb_wave(const Params& p, int b, int hd, int q0, bf16_t* smem) {
  const int tid = opaque_tid(), lane = tid & 63, r = lane & 31, h = lane >> 5;
  const bf16_t* Pb = p.P + (size_t)b * SEQ * NP;
  const bf16_t* Kl = p.Ksb + (((size_t)b * 12 + hd) * SEQ + r) * 64 + h * 8;
  const bf16_t* Vl = p.Vt + ((size_t)b * 12 + hd) * 256 * 2048 + r * 32 + 8 * h;
  const size_t tok = (size_t)b * SEQ + q0 + r;
  bf16x8 qf[4];
#pragma unroll
  for (int s = 0; s < 4; ++s) qf[s] = *(const bf16x8*)(Pb + (size_t)(q0 + r) * NP + hd * 64 + s * 16 + h * 8);
  f32x16 O[2]; O[0] = zero16(); O[1] = zero16();
  float R = 0.f;
  const int ktd = q0 >> 5;
  bf16x8 kf[4], kn[4], vf[4];
#pragma unroll
  for (int s = 0; s < 4; ++s) { kf[s] = *(const bf16x8*)(Kl + (size_t)q0 * 64 + s * 16); kn[s] = kf[s]; }
  for (int kt = ktd; kt >= 0; --kt) {
    const int k0 = kt * 32;
    const bool diag = (kt == ktd);
#pragma unroll
    for (int s = 0; s < 4; ++s) vf[s] = *(const bf16x8*)(Vl + (size_t)kt * 2048 + (s >> 1) * 32 * 32 + (s & 1) * 16);
    if (kt > 0) {
#pragma unroll
      for (int s = 0; s < 4; ++s) kn[s] = *(const bf16x8*)(Kl + (size_t)(k0 - 32) * 64 + s * 16);
    }
    __builtin_amdgcn_sched_barrier(0);
    f32x16 S = zero16();
#pragma unroll
    for (int s = 0; s < 4; ++s) S = MFMA32(kf[s], qf[s], S);
    float lb[16], f[16];
#pragma unroll
    for (int i = 0; i < 16; ++i) {
      const float z = S[i];
      const float L = __builtin_amdgcn_logf(1.f + __builtin_amdgcn_exp2f(-fabsf(z)));
      const float lbv = fminf(z, 0.f) - L;
      lb[i] = lbv; f[i] = lbv - z;
    }
    if (diag) {
#pragma unroll
      for (int i = 0; i < 16; ++i) if (crow(i, h) >= r) f[i] = 0.f;
    }
    float T[4], PT[4], loc[16];
#pragma unroll
    for (int g = 0; g < 4; ++g) {
      loc[4 * g + 3] = 0.f;
      loc[4 * g + 2] = f[4 * g + 3];
      loc[4 * g + 1] = loc[4 * g + 2] + f[4 * g + 2];
      loc[4 * g + 0] = loc[4 * g + 1] + f[4 * g + 1];
      T[g] = loc[4 * g + 0] + f[4 * g + 0];
    }
#pragma unroll
    for (int g = 0; g < 4; ++g) PT[g] = __shfl_xor(T[g], 32);
    float hg = R;
    float av[16];
#pragma unroll
    for (int g = 3; g >= 0; --g) {
      const float base = hg + (h == 0 ? PT[g] : 0.f);
#pragma unroll
      for (int i = 0; i < 4; ++i) av[4 * g + i] = __builtin_amdgcn_exp2f(lb[4 * g + i] + (base + loc[4 * g + i]));
      hg += T[g] + PT[g];
    }
    if (diag) {
#pragma unroll
      for (int i = 0; i < 16; ++i) if (crow(i, h) >= r) av[i] = 0.f;
    }
    R = hg;
    bf16x8 pk[2]; pk[0] = pack8(av); pk[1] = pack8(av + 8);
#pragma unroll
    for (int s = 0; s < 4; ++s) O[s >> 1] = MFMA32(vf[s], pk[s & 1], O[s >> 1]);
#pragma unroll
    for (int s = 0; s < 4; ++s) kf[s] = kn[s];
    if (__all(R < -104.f * 1.4426950408889634f)) break;
  }
  store_gated<2>(O, (float*)smem + (tid >> 6) * 4608, p.P + (tok - r) * NP + 2560 + hd * 64, p.y + (tok - r) * DM + hd * 64, nullptr, lane);
}

DI float wave_sum(float v) { for (int o = 32; o > 0; o >>= 1) v += __shfl_xor(v, o); return v; }
DI float wave_max(float v) { for (int o = 32; o > 0; o >>= 1) v = fmaxf(v, __shfl_xor(v, o)); return v; }

DI bool gemm_sched(int rd, int ntn, int& mti, int& nti) {
  const int nb = gridDim.x, bid = blockIdx.x;
  if (nb == 256) {
    const int xcd = bid & 7, li = bid >> 3, ti = rd * 32 + li;
    if (ti >= 8 * ntn) return false;
    mti = xcd * 8 + (ti & 7); nti = ti >> 3; return true;
  }
  const int t = rd * nb + bid;
  if (t >= 64 * ntn) return false;
  mti = t / ntn; nti = t % ntn; return true;
}

DI void proj_phase(const Params& p, int layer, bf16_t* smem) {
  const int nb = gridDim.x, bid = blockIdx.x;
  if (nb == 256) {
    const int xcd = bid & 7, li = bid >> 3;
    for (int rd = 0; rd < 3; ++rd) { const int ti = rd * 32 + li; proj_tile<4>(p, layer, (xcd * 8 + (ti & 7)) * 256, ti >> 3, smem); }
    { const int ti = 96 + (li >> 1); proj_tile<2>(p, layer, (xcd * 8 + (ti & 7)) * 256 + (li & 1) * 128, ti >> 3, smem); }
  } else {
    for (int t = bid; t < 64 * 14; t += nb) proj_tile<4>(p, layer, (t / 14) * 256, t % 14, smem);
  }
}

DI unsigned xb_ld(unsigned* q) { return __hip_atomic_load(q, __ATOMIC_RELAXED, __HIP_MEMORY_SCOPE_AGENT); }
DI unsigned xb_add(unsigned* q, unsigned v) { return __hip_atomic_fetch_add(q, v, __ATOMIC_RELAXED, __HIP_MEMORY_SCOPE_AGENT); }
DI void xb_st(unsigned* q, unsigned v) { __hip_atomic_store(q, v, __ATOMIC_RELAXED, __HIP_MEMORY_SCOPE_AGENT); }
struct XB { unsigned* w; unsigned x, nx, nxcc, bsub, bgen, btop, btg, k; };
#define XB_SPIN(cond) do { unsigned sp_ = 0; while (cond) { __builtin_amdgcn_s_sleep(1); if (++sp_ > (1u << 21)) break; } } while (0)
DI void xb_init(XB& b, unsigned* w) {
  b.w = w; b.k = 0; b.nx = 0; b.nxcc = 0;
  b.x = (unsigned)__builtin_amdgcn_s_getreg((3 << 11) | 20) & 0xFu;
  b.bsub = xb_ld(w + 4096 + 1024 + 64 * b.x); b.bgen = xb_ld(w + 4096 + 2048 + 64 * b.x);
  b.btop = xb_ld(w + 4096 + 3072); b.btg = xb_ld(w + 4096 + 3136);
  (void)xb_add(w + 64 * b.x, 1u);
}
DI void grid_barrier(XB& b, bool last) {
  asm volatile("s_waitcnt vmcnt(0)" ::: "memory");
  __syncthreads();
  if (threadIdx.x == 0) {
    unsigned* w = b.w;
    if (b.k == 0) {
      unsigned tot = 0, nx = 0, nxcc = 0, sp = 0;
      for (;;) {
        tot = 0; nx = 0; nxcc = 0;
        for (unsigned j = 0; j < 16; ++j) { const unsigned c = xb_ld(w + 64 * j) - xb_ld(w + 4096 + 64 * j); tot += c; nxcc += (c != 0u); if (j == b.x) nx = c; }
        if (tot == gridDim.x || ++sp > (1u << 18)) break;
        __builtin_amdgcn_s_sleep(1);
      }
      b.nx = nx; b.nxcc = nxcc;
    }
    b.k += 1;
    const unsigned old = xb_add(w + 1024 + 64 * b.x, 1u);
    if (old - b.bsub + 1u == b.k * b.nx) {
      __builtin_amdgcn_fence(__ATOMIC_RELEASE, "agent");
      asm volatile("s_waitcnt vmcnt(0)" ::: "memory");
      const unsigned ot = xb_add(w + 3072, 1u);
      if (ot - b.btop + 1u == b.k * b.nxcc) {
        if (last) { xb_st(w + 4096 + 3072, b.btop + b.k * b.nxcc); xb_st(w + 4096 + 3136, b.btg + b.k); }
        (void)xb_add(w + 3136, 1u);
      }
      XB_SPIN((int)(xb_ld(w + 3136) - b.btg - b.k) < 0);
      if (last) { xb_st(w + 4096 + 64 * b.x, xb_ld(w + 64 * b.x)); xb_st(w + 4096 + 1024 + 64 * b.x, b.bsub + b.k * b.nx); xb_st(w + 4096 + 2048 + 64 * b.x, b.bgen + b.k); }
      (void)xb_add(w + 2048 + 64 * b.x, 1u);
    } else {
      XB_SPIN((int)(xb_ld(w + 2048 + 64 * b.x) - b.bgen - b.k) < 0);
    }
    __builtin_amdgcn_fence(__ATOMIC_ACQUIRE, "agent");
    asm volatile("s_waitcnt vmcnt(0)" ::: "memory");
  }
  __syncthreads();
}

__global__ void __launch_bounds__(512, 2) yoco_fwd(Params p) {
  extern __shared__ __attribute__((aligned(16))) bf16_t smem[];
  cg::grid_group grid = cg::this_grid();
  const int tid = threadIdx.x, lane = tid & 63, wid = tid >> 6, nb = gridDim.x, bid = blockIdx.x, grp = wid >> 2, wq = wid & 3;
  int* s_unit = (int*)(smem + LDS_ELEMS);
  const float LOG2E = 1.4426950408889634f;
  XB xb = {};
  if (tid == 0) xb_init(xb, p.xbw);
  if (bid == 0 && tid < 64) p.ctr[tid] = 0;
  if (p.out == nullptr) grid.sync();

  phase0(p, smem);
  grid_barrier(xb, false);

  proj_phase(p, 0, smem);
  grid_barrier(xb, false);

  {
    const float d1 = wave_sum(p.lq1[lane] * p.lk1[lane]), d2 = wave_sum(p.lq2[lane] * p.lk2[lane]);
    const float lam = __expf(d1) - __expf(d2) + 0.2f;
    const float mqa = wave_max(fabsf(p.a_q_norm[lane])), mka = wave_max(fabsf(p.a_k_norm[lane]));
    const float mqm = wave_max(fabsf(p.mem_q_norm[lane])), mkm = wave_max(fabsf(p.mem_k_norm[lane]));
    const float sc2 = 0.125f * LOG2E;
    const float msh_a = 8.f * mqa * mka * LOG2E, msh_m = 8.f * mqm * mkm * LOG2E;
    unsigned* kvflag = (unsigned*)(p.ctr + 16);
    bool memkv_ready = false;
    const int xq = bid & 7;
    for (;;) {
      __syncthreads();
      if (tid == 0) *s_unit = atomicAdd(&p.ctr[40 + xq], 1);
      __syncthreads();
      const int u = *s_unit;
      if (u >= 1 + 96 + 32) break;
      if (u == 0) {
        mem_tile(p, xq >> 2, (xq >> 1) & 1, xq & 1, smem);
        if (xq < 4) {
          asm volatile("s_waitcnt vmcnt(0)" ::: "memory");
          __syncthreads();
          if (tid == 0) {
            __builtin_amdgcn_fence(__ATOMIC_RELEASE, "agent");
            asm volatile("s_waitcnt vmcnt(0)" ::: "memory");
            (void)__hip_atomic_fetch_add(kvflag, 1u, __ATOMIC_RELAXED, __HIP_MEMORY_SCOPE_AGENT);
          }
        }
      } else if (u < 1 + 96) {
        const int a = u - 1;
        int bh, qb;
        if (a < 32) { bh = 8 + (xq >> 1); qb = 62 + (xq & 1) - 2 * a; } else { bh = xq; qb = 63 - (a - 32); }
        attn_a_unit(p, bh / 6, bh % 6, qb, smem, lam, msh_a);
      } else {
        if (!memkv_ready) {
          if (tid == 0) {
            while (__hip_atomic_load(kvflag, __ATOMIC_RELAXED, __HIP_MEMORY_SCOPE_AGENT) < 4u) __builtin_amdgcn_s_sleep(1);
            __builtin_amdgcn_fence(__ATOMIC_ACQUIRE, "agent");
            asm volatile("s_waitcnt vmcnt(0)" ::: "memory");
          }
          __syncthreads();
          memkv_ready = true;
        }
        const int v = (xq * 32 + (u - 97)) * 2 + grp; mem_wave(p, 0, v >> 8, v & 3, ((v & 255) >> 2) * 128 + wq * 32, sc2, msh_m, smem);
      }
    }
  }
  grid_barrier(xb, false);

  {
    int mti, nti;
    for (int rd = 0; gemm_sched(rd, 4, mti, nti); ++rd) out_tile(p, p.W2t, true, mti, nti, smem);
  }
  grid_barrier(xb, false);

  proj_phase(p, 1, smem);
  grid_barrier(xb, false);

  {
    const float mqm = wave_max(fabsf(p.mem_q_norm[64 + lane])), mkm = wave_max(fabsf(p.mem_k_norm[64 + lane]));
    const float sc2 = 0.125f * LOG2E, msh_m = 8.f * mqm * mkm * LOG2E;
    const int bx = (nb & 7) ? bid : (bid & 7) * (nb >> 3) + (bid >> 3);
    for (int u = bx * 8 + wid; u < 6144 + 2048; u += nb * 8) {
      if (u < 6144) { const int bh = u >> 8, q32 = 255 - (u & 255); sb_wave(p, bh / 12, bh % 12, q32 * 32, smem); }
      else { const int v = u - 6144, rem = v & 1023; mem_wave(p, 1, v >> 10, (rem >> 2) & 3, (rem >> 4) * 128 + (rem & 3) * 32, sc2, msh_m, smem); }
    }
  }
  grid_barrier(xb, true);

  {
    int mti, nti;
    for (int rd = 0; gemm_sched(rd, 4, mti, nti); ++rd) out_tile(p, p.W4t, false, mti, nti, smem);
  }
}

extern "C" void kernel_launch(void* const* d_in, const int* in_sizes, int n_in, void* d_out, int out_size, void* d_ws, size_t ws_size, hipStream_t stream) {
  static int grid_blocks = 0;
  if (!grid_blocks) {
    int dev = 0, cus = 0, per_cu = 0;
    (void)hipGetDevice(&dev);
    (void)hipDeviceGetAttribute(&cus, hipDeviceAttributeMultiprocessorCount, dev);
    (void)hipFuncSetAttribute((const void*)yoco_fwd, hipFuncAttributeMaxDynamicSharedMemorySize, LDS_BYTES);
    (void)hipOccupancyMaxActiveBlocksPerMultiprocessor(&per_cu, yoco_fwd, NT, LDS_BYTES);
    if (per_cu > 1) per_cu = 1;
    if (per_cu < 1) per_cu = 1;
    grid_blocks = cus * per_cu;
  }
  Params p;
  memset(&p, 0, sizeof(p));
  const float* const* in = (const float* const*)d_in;
  p.x = in[0]; p.mem = in[1]; p.pos = (const int*)d_in[2];
  p.a_q_norm = in[5]; p.a_k_norm = in[6]; p.lq1 = in[7]; p.lk1 = in[8]; p.lq2 = in[9]; p.lk2 = in[10]; p.a_subln = in[11];
  p.mem_q_norm = in[20]; p.mem_k_norm = in[21];
  p.out = (float*)d_out;
  char* w = (char*)d_ws;
  size_t off = 0;
  auto take = [&](size_t bytes) { char* q = w + off; off += (bytes + 255) & ~(size_t)255; return q; };
  p.ctr = (int*)take(1024);
  p.xbw = (unsigned*)take(32768);
  p.P = (bf16_t*)take((size_t)NTOK * NP * 2);
  p.Vt = (bf16_t*)take((size_t)2 * 768 * SEQ * 2);
  p.xb = (bf16_t*)take((size_t)NTOK * DM * 2);
  p.y = (bf16_t*)take((size_t)NTOK * DM * 2);
  p.Ksb = (bf16_t*)take((size_t)2 * 768 * SEQ * 2);
  p.W1t = (bf16_t*)take((size_t)3584 * DM * 2);
  p.W2t = (bf16_t*)take((size_t)1024 * DM * 2);
  p.W3t = (bf16_t*)take((size_t)3584 * DM * 2);
  p.W4t = (bf16_t*)take((size_t)1024 * DM * 2);
  p.Wmt = (bf16_t*)take((size_t)2 * 512 * DM * 2);
  p.memb = (bf16_t*)take((size_t)512 * DM * 2);
  p.Km = (bf16_t*)take((size_t)2 * 512 * 256 * 2);
  p.Vmt = (bf16_t*)take((size_t)2 * 512 * 256 * 2);
  p.ssq0 = (float*)take((size_t)NTOK * 16 * 4);
  p.ssq1 = (float*)take((size_t)NTOK * 16 * 4);
  p.ssqm = (float*)take((size_t)512 * 16 * 4);
  p.cs = (float*)take((size_t)NTOK * 16 * 4);
  const float* a_norm = in[3]; const float* a_w_in = in[4]; const float* a_w_out = in[12]; const float* kv_norm = in[13]; const float* w_kv = in[14];
  const float* b_norm = in[15]; const float* b_w_in = in[16]; const float* b_w_out = in[17]; const float* mem_norm = in[18]; const float* mem_w_kv = in[19];
  auto setseg = [&](int i, const float* src, const float* gain, bf16_t* dst, int ld, int col0, int ncols) {
    p.seg[i].src = src; p.seg[i].gain = gain; p.seg[i].dst = dst; p.seg[i].ld = ld; p.seg[i].col0 = col0; p.seg[i].ncols = ncols; p.seg[i].pad = 0; };
  setseg(0, a_w_in, a_norm, p.W1t, 3584, 0, 3584);
  setseg(1, a_w_out, nullptr, p.W2t, 1024, 0, 1024);
  setseg(2, b_w_in, b_norm, p.W3t, 2048, 0, 768);
  setseg(3, w_kv, kv_norm, p.W3t + (size_t)768 * DM, 1536, 0, 1536);
  setseg(4, b_w_in, b_norm, p.W3t + (size_t)2304 * DM, 2048, 768, 1280);
  setseg(5, b_w_out, nullptr, p.W4t, 1024, 0, 1024);
  setseg(6, mem_w_kv, mem_norm, p.Wmt, 512, 0, 512);
  setseg(7, mem_w_kv + (size_t)1024 * 512, mem_norm + 1024, p.Wmt + (size_t)512 * DM, 512, 0, 512);
  for (int i = 0; i < 8; ++i) p.inv[i] = (float)pow(500000.0, -(double)i / 8.0);
  void* args[] = {&p};
  hipError_t e = hipLaunchCooperativeKernel((const void*)yoco_fwd, dim3(grid_blocks), dim3(NT), args, LDS_BYTES, stream);
  if (e != hipSuccess) fprintf(stderr, "cooperative launch failed: %s (grid %d)\n", hipGetErrorString(e), grid_blocks);
}
```

```cpp
#include <hip/hip_runtime.h>
#include <hip/hip_cooperative_groups.h>
#include <cstdio>
#include <cmath>
#include <cstring>
namespace cg = cooperative_groups;

typedef unsigned short bf16_t;
typedef short bf16x8 __attribute__((ext_vector_type(8)));
typedef short bf16x4 __attribute__((ext_vector_type(4)));
typedef float f32x16 __attribute__((ext_vector_type(16)));
typedef float f32x4 __attribute__((ext_vector_type(4)));
typedef float f32x2 __attribute__((ext_vector_type(2)));
typedef unsigned u32x4 __attribute__((ext_vector_type(4)));
typedef unsigned u32x2 __attribute__((ext_vector_type(2)));
typedef __bf16 bf2_t __attribute__((ext_vector_type(2)));

#define DI __device__ __forceinline__
#define MFMA32(a, b, c) __builtin_amdgcn_mfma_f32_32x32x16_bf16((a), (b), (c), 0, 0, 0)

constexpr int SEQ = 8192, DM = 1024, NTOK = 16384, NP = 3584;
constexpr int NT = 512;
constexpr float EPS = 1e-6f;
constexpr int LDS_ELEMS = 2 * 512 * 72;
constexpr int LDS_BYTES = LDS_ELEMS * 2 + 16;

struct Seg { const float* src; const float* gain; bf16_t* dst; int ld; int col0; int ncols; int pad; };

struct Params {
  const float* x; const float* mem; const int* pos;
  const float* a_q_norm; const float* a_k_norm; const float* lq1; const float* lk1; const float* lq2; const float* lk2; const float* a_subln;
  const float* mem_q_norm; const float* mem_k_norm;
  float* out;
  bf16_t* xb; bf16_t* memb; bf16_t* P; bf16_t* Vt; bf16_t* y;
  bf16_t* Ksb; bf16_t* W1t; bf16_t* W2t; bf16_t* W3t; bf16_t* W4t; bf16_t* Wmt; bf16_t* Km; bf16_t* Vmt;
  float* ssq0; float* ssq1; float* ssqm; float* cs; int* ctr; unsigned* xbw;
  Seg seg[8];
  float inv[8];
};

DI unsigned pk2(float a, float b) { f32x2 v = {a, b}; bf2_t r = __builtin_convertvector(v, bf2_t); return __builtin_bit_cast(unsigned, r); }
DI bf16_t f2bf(float a) { return (bf16_t)(pk2(a, 0.f) & 0xffffu); }
DI float bflo(unsigned w) { return __uint_as_float(w << 16); }
DI float bfhi(unsigned w) { return __uint_as_float(w & 0xffff0000u); }
DI int crow(int reg, int h) { return (reg & 3) + 8 * (reg >> 2) + 4 * h; }
DI int perm16(int kk) { return ((kk >> 2) & 1) * 8 + (kk >> 3) * 4 + (kk & 3); }
DI bf16x8 pack8(const float* v) {
  u32x4 w; w.x = pk2(v[0], v[1]); w.y = pk2(v[2], v[3]); w.z = pk2(v[4], v[5]); w.w = pk2(v[6], v[7]);
  return __builtin_bit_cast(bf16x8, w);
}
DI int opaque_tid() { int t = threadIdx.x; asm volatile("" : "+v"(t)); return t; }
DI f32x16 zero16() { f32x16 z; for (int i = 0; i < 16; ++i) z[i] = 0.f; return z; }

__device__ void phase0(const Params& p, bf16_t* smem) {
  const int tid = opaque_tid(), lane = tid & 63, wid = tid >> 6, nb = gridDim.x, bid = blockIdx.x;
  for (int row0 = (bid * 8 + wid) * 2; row0 < NTOK + 512; row0 += nb * 16) {
    f32x4 v[2][4];
#pragma unroll
    for (int q = 0; q < 2; ++q) {
      const int row = row0 + q;
      const float* src = (row < NTOK) ? p.x + (size_t)row * DM : p.mem + (size_t)(row - NTOK) * DM;
#pragma unroll
      for (int j = 0; j < 4; ++j) v[q][j] = *(const f32x4*)(src + 256 * j + 4 * lane);
    }
#pragma unroll
    for (int q = 0; q < 2; ++q) {
      const int row = row0 + q;
      bf16_t* dst; float* sq;
      if (row < NTOK) { dst = p.xb + (size_t)row * DM; sq = p.ssq0 + (size_t)row * 16; }
      else { const int r2 = row - NTOK; dst = p.memb + (size_t)r2 * DM; sq = p.ssqm + (size_t)r2 * 16; }
#pragma unroll
      for (int j = 0; j < 4; ++j) {
        const f32x4 t = v[q][j];
        float s = t.x * t.x + t.y * t.y + t.z * t.z + t.w * t.w;
        u32x2 w; w.x = pk2(t.x, t.y); w.y = pk2(t.z, t.w);
        *(u32x2*)(dst + 256 * j + 4 * lane) = w;
        s += __shfl_xor(s, 1); s += __shfl_xor(s, 2); s += __shfl_xor(s, 4); s += __shfl_xor(s, 8);
        if ((lane & 15) == 0) sq[4 * j + (lane >> 4)] = s;
      }
    }
  }
  for (int i = bid * NT + tid; i < NTOK * 8; i += nb * NT) {
    const int token = i >> 3, f = i & 7;
    const float ang = (float)p.pos[token] * p.inv[f];
    double rev = (double)ang * 0.15915494309189535;
    rev -= floor(rev);
    const double q4 = rint(rev * 4.0);
    const double a = (rev - q4 * 0.25) * 6.283185307179586;
    const int q = ((int)q4) & 3;
    const double a2 = a * a;
    double sn = -1.0 / 39916800.0; sn = sn * a2 + 1.0 / 362880.0; sn = sn * a2 - 1.0 / 5040.0; sn = sn * a2 + 1.0 / 120.0; sn = sn * a2 - 1.0 / 6.0; sn = sn * a2 + 1.0; sn *= a;
    double cn = 1.0 / 479001600.0; cn = cn * a2 - 1.0 / 3628800.0; cn = cn * a2 + 1.0 / 40320.0; cn = cn * a2 - 1.0 / 720.0; cn = cn * a2 + 1.0 / 24.0; cn = cn * a2 - 0.5; cn = cn * a2 + 1.0;
    double c, s;
    if (q == 0) { c = cn; s = sn; } else if (q == 1) { c = -sn; s = cn; } else if (q == 2) { c = -cn; s = -sn; } else { c = sn; s = -cn; }
    p.cs[(size_t)token * 16 + f] = (float)c;
    p.cs[(size_t)token * 16 + 8 + f] = (float)s;
  }
  {
    f32x4 nv[2]; float ng[2]; bf16_t* ndst = nullptr;
    auto fetch = [&](int t) {
      int ct = t >> 4; const int k0 = (t & 15) * 64;
      int si = 0;
      while (ct >= (p.seg[si].ncols >> 6)) { ct -= (p.seg[si].ncols >> 6); ++si; }
      const Seg sg = p.seg[si];
      const int n0 = ct * 64;
#pragma unroll
      for (int j = 0; j < 2; ++j) {
        const int i = tid + NT * j, kr = i >> 4, c4 = i & 15;
        nv[j] = *(const f32x4*)(sg.src + (size_t)(k0 + kr) * sg.ld + sg.col0 + n0 + c4 * 4);
        ng[j] = sg.gain ? sg.gain[k0 + kr] : 1.f;
      }
      ndst = sg.dst + (size_t)(n0 + (tid >> 3)) * DM + k0 + (tid & 7) * 8;
    };
    if (bid < 2560) fetch(bid);
    for (int t = bid; t < 2560; t += nb) {
      const f32x4 v0 = nv[0], v1 = nv[1]; const float g0 = ng[0], g1 = ng[1]; bf16_t* dst = ndst;
      if (t + nb < 2560) fetch(t + nb);
      __syncthreads();
      {
        const int kr = tid >> 4, c4 = tid & 15;
        smem[(c4 * 4 + 0) * 72 + kr] = f2bf(v0.x * g0); smem[(c4 * 4 + 1) * 72 + kr] = f2bf(v0.y * g0);
        smem[(c4 * 4 + 2) * 72 + kr] = f2bf(v0.z * g0); smem[(c4 * 4 + 3) * 72 + kr] = f2bf(v0.w * g0);
        smem[(c4 * 4 + 0) * 72 + kr + 32] = f2bf(v1.x * g1); smem[(c4 * 4 + 1) * 72 + kr + 32] = f2bf(v1.y * g1);
        smem[(c4 * 4 + 2) * 72 + kr + 32] = f2bf(v1.z * g1); smem[(c4 * 4 + 3) * 72 + kr + 32] = f2bf(v1.w * g1);
      }
      __syncthreads();
      *(u32x4*)dst = *(const u32x4*)(smem + (tid >> 3) * 72 + (tid & 7) * 8);
    }
  }
  __syncthreads();
}

template <int MT>
DI void gemm_core(const bf16_t* __restrict__ Wt, const bf16_t* __restrict__ X, int n0, int m0, f32x16 (&acc)[2][MT], bf16_t* smem) {
  const int tid = opaque_tid(), lane = tid & 63, wid = tid >> 6, wn = wid >> 1, wm = wid & 1, r = lane & 31, h = lane >> 5;
  bf16_t* Ws = smem;
  bf16_t* Xs = smem + 2 * 256 * 72;
  const char* wub = (const char*)(Wt + (size_t)n0 * DM);
  const char* xub = (const char*)(X + (size_t)m0 * DM);
  const unsigned voff = (unsigned)(((tid >> 3) * DM + (tid & 7) * 8) * 2);
#define GLD_W(i, k) (*(const u32x4*)(wub + ((size_t)(i) * 64 * DM * 2 + (size_t)(k) * 128) + voff))
#define GLD_X(i, k) (*(const u32x4*)(xub + ((size_t)(i) * 64 * DM * 2 + (size_t)(k) * 128) + voff))
  const int so = (tid >> 3) * 72 + (tid & 7) * 8;
  u32x4 wr[4], xr[MT];
#pragma unroll
  for (int i = 0; i < 4; ++i) wr[i] = GLD_W(i, 0);
#pragma unroll
  for (int i = 0; i < MT; ++i) xr[i] = GLD_X(i, 0);
  __syncthreads();
#pragma unroll
  for (int i = 0; i < 4; ++i) *(u32x4*)(Ws + so + i * 64 * 72) = wr[i];
#pragma unroll
  for (int i = 0; i < MT; ++i) *(u32x4*)(Xs + so + i * 64 * 72) = xr[i];
#pragma unroll
  for (int i = 0; i < 4; ++i) wr[i] = GLD_W(i, 1);
#pragma unroll
  for (int i = 0; i < MT; ++i) xr[i] = GLD_X(i, 1);
  __syncthreads();
  const int ao = (wn * 64 + r) * 72 + h * 8, bo = (wm * (MT * 32) + r) * 72 + h * 8;
  for (int kt = 0; kt < 16; ++kt) {
    const int cur = (kt & 1) * 256 * 72, nxt = ((kt + 1) & 1) * 256 * 72;
#pragma unroll
    for (int s = 0; s < 4; ++s) {
      bf16x8 a[2], b[MT];
#pragma unroll
      for (int nt = 0; nt < 2; ++nt) a[nt] = *(const bf16x8*)(Ws + cur + ao + nt * 32 * 72 + s * 16);
#pragma unroll
      for (int mt = 0; mt < MT; ++mt) b[mt] = *(const bf16x8*)(Xs + cur + bo + mt * 32 * 72 + s * 16);
      if (kt + 1 < 16) {
        *(u32x4*)(Ws + nxt + so + s * 64 * 72) = wr[s];
        if (s < MT) *(u32x4*)(Xs + nxt + so + s * 64 * 72) = xr[s < MT ? s : 0];
        if (kt + 2 < 16) {
          wr[s] = GLD_W(s, kt + 2);
          if (s < MT) xr[s < MT ? s : 0] = GLD_X(s, kt + 2);
        }
      }
#pragma unroll
      for (int nt = 0; nt < 2; ++nt)
#pragma unroll
        for (int mt = 0; mt < MT; ++mt) acc[nt][mt] = MFMA32(a[nt], b[mt], acc[nt][mt]);
    }
    __syncthreads();
  }
}

DI float row_rinv(const float* ssq, int token) {
  const f32x4* q = (const f32x4*)(ssq + (size_t)token * 16);
  const f32x4 a = q[0], b = q[1], c = q[2], d = q[3];
  const float s = ((a.x + a.y) + (a.z + a.w)) + ((b.x + b.y) + (b.z + b.w)) + ((c.x + c.y) + (c.z + c.w)) + ((d.x + d.y) + (d.z + d.w));
  return rsqrtf(s * (1.f / 1024.f) + EPS);
}

enum { EK_QKROPE = 0, EK_NORM = 1, EK_PLAIN = 2, EK_VT = 3, EK_SILU = 4, EK_VBLK = 5 };

template <int MT>
DI void epi_proj(const f32x16 (&acc)[2][MT], int kind, const float* __restrict__ ssq0, const float* __restrict__ gain, const float* __restrict__ cs0,
                 bf16_t* __restrict__ dbase, int ld, bf16_t* __restrict__ vbase, int vt_ld, bf16_t* smem, float qscale) {
  const int tid = opaque_tid(), lane = tid & 63, wid = tid >> 6, r = lane & 31, h = lane >> 5;
  bf16_t* wreg = smem + wid * 9216;
#pragma unroll
  for (int mt = 0; mt < MT; ++mt) {
    const float rs = row_rinv(ssq0, mt * 32);
    float v[2][16];
#pragma unroll
    for (int nt = 0; nt < 2; ++nt)
#pragma unroll
      for (int i = 0; i < 16; ++i) v[nt][i] = acc[nt][mt][i] * rs;
    if (kind <= EK_NORM) {
      float ss = 0.f;
#pragma unroll
      for (int nt = 0; nt < 2; ++nt)
#pragma unroll
        for (int i = 0; i < 16; ++i) ss += v[nt][i] * v[nt][i];
      ss += __shfl_xor(ss, 32);
      const float rn = rsqrtf(ss * (1.f / 64.f) + EPS);
#pragma unroll
      for (int nt = 0; nt < 2; ++nt)
#pragma unroll
        for (int g = 0; g < 4; ++g) {
          const f32x4 gg = *(const f32x4*)(gain + nt * 32 + 8 * g + 4 * h);
          v[nt][4 * g + 0] *= rn * gg.x; v[nt][4 * g + 1] *= rn * gg.y; v[nt][4 * g + 2] *= rn * gg.z; v[nt][4 * g + 3] *= rn * gg.w;
        }
      if (kind == EK_QKROPE) {
        const f32x4 c = *(const f32x4*)(cs0 + mt * 32 * 16 + 4 * h);
        const f32x4 s = *(const f32x4*)(cs0 + mt * 32 * 16 + 8 + 4 * h);
#pragma unroll
        for (int i = 0; i < 4; ++i) {
          const float x1 = v[0][i], x2 = v[0][4 + i];
          v[0][i] = x1 * c[i] - x2 * s[i];
          v[0][4 + i] = x2 * c[i] + x1 * s[i];
        }
#pragma unroll
        for (int nt = 0; nt < 2; ++nt)
#pragma unroll
          for (int i = 0; i < 16; ++i) v[nt][i] *= qscale;
      }
    } else if (kind == EK_PLAIN) {
#pragma unroll
      for (int nt = 0; nt < 2; ++nt)
#pragma unroll
        for (int i = 0; i < 16; ++i) v[nt][i] *= qscale;
    } else if (kind == EK_SILU) {
#pragma unroll
      for (int nt = 0; nt < 2; ++nt)
#pragma unroll
        for (int i = 0; i < 16; ++i) v[nt][i] = v[nt][i] * __builtin_amdgcn_rcpf(1.f + __builtin_amdgcn_exp2f(-1.4426950408889634f * v[nt][i]));
    }
    if (kind == EK_VT || kind == EK_VBLK) {
#pragma unroll
      for (int nt = 0; nt < 2; ++nt)
#pragma unroll
        for (int i = 0; i < 16; ++i) wreg[(nt * 32 + crow(i, h)) * 136 + mt * 32 + (r & 16) + perm16(r & 15)] = f2bf(v[nt][i]);
    } else {
#pragma unroll
      for (int nt = 0; nt < 2; ++nt)
#pragma unroll
        for (int g = 0; g < 4; ++g) {
          u32x2 w; w.x = pk2(v[nt][4 * g], v[nt][4 * g + 1]); w.y = pk2(v[nt][4 * g + 2], v[nt][4 * g + 3]);
          *(u32x2*)(wreg + (mt * 32 + r) * 72 + nt * 32 + 8 * g + 4 * h) = w;
        }
    }
  }
  __syncthreads();
  constexpr int CPR = MT * 4, RPI = 64 / CPR;
  if (kind == EK_VT) {
#pragma unroll
    for (int j = 0; j < CPR; ++j) {
      const int n = j * RPI + lane / CPR, c = lane % CPR;
      *(u32x4*)(vbase + (size_t)n * vt_ld + c * 8) = *(const u32x4*)(wreg + n * 136 + c * 8);
    }
  } else if (kind == EK_VBLK) {
#pragma unroll
    for (int j = 0; j < CPR; ++j) {
      const int n = j * RPI + lane / CPR, c = lane % CPR;
      *(u32x4*)(vbase + (size_t)(c >> 2) * 2048 + n * 32 + (c & 3) * 8) = *(const u32x4*)(wreg + n * 136 + c * 8);
    }
  } else {
#pragma unroll
    for (int j = 0; j < MT * 4; ++j) {
      const int row = j * 8 + (lane >> 3), c = lane & 7;
      *(u32x4*)(dbase + (size_t)row * ld + c * 8) = *(const u32x4*)(wreg + row * 72 + c * 8);
    }
  }
}

template <int MT>
DI void zero_acc(f32x16 (&acc)[2][MT]) {
#pragma unroll
  for (int a = 0; a < 2; ++a)
#pragma unroll
    for (int b = 0; b < MT; ++b) acc[a][b] = zero16();
}

template <int MT>
__device__ void proj_tile(const Params& p, int layer, int m0, int nti, bf16_t* smem) {
  const int tid = opaque_tid(), lane = tid & 63, wid = tid >> 6, wn = wid >> 1, wm = wid & 1, r = lane & 31, h = lane >> 5;
  const int n0 = nti * 256;
  f32x16 acc[2][MT];
  zero_acc<MT>(acc);
  gemm_core<MT>(layer ? p.W3t : p.W1t, p.xb, n0, m0, acc, smem);
  const float* ssq = layer ? p.ssq1 : p.ssq0;
  const int tok = m0 + wm * (MT * 32) + r;
  const int cc = n0 + wn * 64;
  int kind; const float* gain = p.a_q_norm;
  if (cc < 1536) { kind = layer ? EK_PLAIN : EK_QKROPE; gain = (cc < 768) ? p.a_q_norm : p.a_k_norm; }
  else if (cc < 2304) kind = EK_VT;
  else if (cc < 2560) { kind = EK_NORM; gain = p.mem_q_norm + layer * 64; }
  else kind = EK_SILU;
  const int tok0 = m0 + wm * (MT * 32), b = tok0 >> 13;
  bf16_t* vtb = p.Vt + ((size_t)b * 768 + (cc - 1536)) * SEQ + (tok0 & (SEQ - 1));
  bf16_t* dbase = p.P + (size_t)tok0 * NP + cc;
  int ld = NP;
  if (layer && cc >= 768 && cc < 1536) {
    dbase = p.Ksb + (((size_t)b * 12 + ((cc - 768) >> 6)) * SEQ + (tok0 & (SEQ - 1))) * 64; ld = 64;
  } else if (layer && kind == EK_VT) {
    kind = EK_VBLK;
    vtb = p.Vt + (((size_t)b * 12 + ((cc - 1536) >> 6)) * 256 + ((tok0 & (SEQ - 1)) >> 5)) * 2048;
  }
  epi_proj<MT>(acc, kind, ssq + (size_t)tok * 16, gain, p.cs + (size_t)tok * 16, dbase, ld, vtb, SEQ, smem, (cc < 768) ? 0.125f * 1.4426950408889634f : 1.f);
}

__device__ void mem_tile(const Params& p, int l, int mti, int nti, bf16_t* smem) {
  const int tid = opaque_tid(), lane = tid & 63, wid = tid >> 6, wn = wid >> 1, wm = wid & 1, r = lane & 31, h = lane >> 5;
  const int m0 = mti * 256, n0 = nti * 256;
  f32x16 acc[2][4];
  zero_acc<4>(acc);
  gemm_core<4>(p.Wmt + (size_t)l * 512 * DM, p.memb, n0, m0, acc, smem);
  const int tok = m0 + wm * 128 + r;
  const int cc = n0 + wn * 64;
  const int kind = (cc < 256) ? EK_NORM : EK_VT;
  const int tok0 = m0 + wm * 128, b = tok0 >> 8;
  bf16_t* vtb = p.Vmt + ((size_t)(l * 2 + b) * 256 + (cc - 256)) * 256 + (tok0 & 255);
  epi_proj<4>(acc, kind, p.ssqm + (size_t)tok * 16, p.mem_k_norm + l * 64, p.cs, p.Km + ((size_t)l * 512 + tok0) * 256 + cc, 256, vtb, 256, smem, 1.f);
}

__device__ void out_tile(const Params& p, const bf16_t* Wt, bool first, int mti, int nti, bf16_t* smem) {
  const int tid = opaque_tid(), lane = tid & 63, wid = tid >> 6, wn = wid >> 1, wm = wid & 1, r = lane & 31, h = lane >> 5;
  const int m0 = mti * 256, n0 = nti * 256;
  f32x16 acc[2][4];
  zero_acc<4>(acc);
  gemm_core<4>(Wt, p.y, n0, m0, acc, smem);
  const int cc = n0 + wn * 64;
  float* freg = (float*)smem + wid * 4608;
#pragma unroll
  for (int half = 0; half < 2; ++half) {
#pragma unroll
    for (int mtl = 0; mtl < 2; ++mtl)
#pragma unroll
      for (int nt = 0; nt < 2; ++nt)
#pragma unroll
        for (int g = 0; g < 4; ++g) {
          f32x4 o; o.x = acc[nt][half * 2 + mtl][4 * g + 0]; o.y = acc[nt][half * 2 + mtl][4 * g + 1]; o.z = acc[nt][half * 2 + mtl][4 * g + 2]; o.w = acc[nt][half * 2 + mtl][4 * g + 3];
          *(f32x4*)(freg + (mtl * 32 + r) * 68 + nt * 32 + 8 * g + 4 * h) = o;
        }
    __syncthreads();
#pragma unroll
    for (int j = 0; j < 16; ++j) {
      const int row = j * 4 + (lane >> 4), c = lane & 15;
      const int tok = m0 + wm * 128 + half * 64 + row;
      const size_t off = (size_t)tok * DM + cc + c * 4;
      const f32x4 a = *(const f32x4*)(freg + row * 68 + c * 4);
      f32x4 o;
      if (first) {
        const u32x2 xw = *(const u32x2*)(p.xb + off);
        o.x = bflo(xw.x) + a.x; o.y = bfhi(xw.x) + a.y; o.z = bflo(xw.y) + a.z; o.w = bfhi(xw.y) + a.w;
        u32x2 w; w.x = pk2(o.x, o.y); w.y = pk2(o.z, o.w);
        *(u32x2*)(p.xb + off) = w;
        float ss = o.x * o.x + o.y * o.y + o.z * o.z + o.w * o.w;
        ss += __shfl_xor(ss, 1); ss += __shfl_xor(ss, 2); ss += __shfl_xor(ss, 4); ss += __shfl_xor(ss, 8);
        if (c == 0) p.ssq1[(size_t)tok * 16 + (cc >> 6)] = ss;
      } else {
        const u32x2 w = *(const u32x2*)(p.xb + off);
        o.x = bflo(w.x) + a.x; o.y = bfhi(w.x) + a.y; o.z = bflo(w.y) + a.z; o.w = bfhi(w.y) + a.w;
        __builtin_nontemporal_store(o, (f32x4*)(p.out + off));
      }
      if ((j & 3) == 3) __builtin_amdgcn_sched_barrier(0);
    }
    __syncthreads();
  }
}

template <int NDT>
DI void store_gated(const f32x16 (&O)[NDT], float* reg, const bf16_t* __restrict__ grow0, bf16_t* __restrict__ yrow0, const float* __restrict__ gain, int lane) {
  constexpr int RS = NDT * 32 + 4, LPR = NDT * 8, RPI = 64 / LPR;
  const int r = lane & 31, h = lane >> 5;
#pragma unroll
  for (int dvt = 0; dvt < NDT; ++dvt)
#pragma unroll
    for (int g = 0; g < 4; ++g) {
      f32x4 o; o.x = O[dvt][4 * g + 0]; o.y = O[dvt][4 * g + 1]; o.z = O[dvt][4 * g + 2]; o.w = O[dvt][4 * g + 3];
      *(f32x4*)(reg + r * RS + dvt * 32 + 8 * g + 4 * h) = o;
    }
  asm volatile("s_waitcnt lgkmcnt(0)" ::: "memory");
  const int c = lane % LPR;
  f32x4 gg; gg.x = 1.f; gg.y = 1.f; gg.z = 1.f; gg.w = 1.f;
  if (gain) gg = *(const f32x4*)(gain + c * 4);
#pragma unroll
  for (int j = 0; j < 32 / RPI; ++j) {
    const int row = j * RPI + lane / LPR;
    const f32x4 v = *(const f32x4*)(reg + row * RS + c * 4);
    const u32x2 gw = *(const u32x2*)(grow0 + (size_t)row * NP + c * 4);
    u32x2 w;
    w.x = pk2(v.x * gg.x * bflo(gw.x), v.y * gg.y * bfhi(gw.x));
    w.y = pk2(v.z * gg.z * bflo(gw.y), v.w * gg.w * bfhi(gw.y));
    *(u32x2*)(yrow0 + (size_t)row * DM + c * 4) = w;
  }
  asm volatile("s_waitcnt lgkmcnt(0)" ::: "memory");
}

__device__ void attn_a_unit(const Params& p, int b, int hd, int qb, bf16_t* smem, float lam, float msh) {
  const int tid = opaque_tid(), lane = tid & 63, wid = tid >> 6, r = lane & 31, h = lane >> 5, grp = wid >> 2, wq = wid & 3;
  const bf16_t* Pb = p.P + (size_t)b * SEQ * NP;
  const bf16_t* Vb = p.Vt + ((size_t)b * 768 + hd * 128) * SEQ;
  const int q0 = qb * 128 + wq * 32;
  bf16x8 qf[4];
#pragma unroll
  for (int s = 0; s < 4; ++s) qf[s] = *(const bf16x8*)(Pb + (size_t)(q0 + r) * NP + grp * 384 + hd * 64 + s * 16 + h * 8);
  f32x16 O[4];
#pragma unroll
  for (int i = 0; i < 4; ++i) O[i] = zero16();
  float l = 0.f;
  const int nkt = 2 * (qb + 1);
  constexpr int VOFF = 9216, SSTR = 18432;
  const char* kub = (const char*)(Pb + 768 + hd * 64);
  const char* vub = (const char*)Vb;
  const unsigned kvo = (unsigned)(((tid >> 3) * NP + (tid & 7) * 8) * 2);
  const unsigned vvo = (unsigned)(((tid >> 3) * SEQ + (tid & 7) * 8) * 2);
#define GLD_K(i, t) (*(const u32x4*)(kub + ((size_t)(t) * 64 * NP * 2 + (size_t)(i) * 768) + kvo))
#define GLD_V(i, t) (*(const u32x4*)(vub + ((size_t)(i) * 64 * SEQ * 2 + (size_t)(t) * 128) + vvo))
  const int kso = (tid >> 3) * 72 + (tid & 7) * 8;
  const int vso = VOFF + (tid >> 3) * 72 + (tid & 7) * 8;
  const int kro = grp * 64 * 72 + r * 72 + h * 8;
  const int vro = VOFF + r * 72 + 8 * h;
  u32x4 kr[2], vr[2];
#pragma unroll
  for (int i = 0; i < 2; ++i) { kr[i] = GLD_K(i, 0); vr[i] = GLD_V(i, 0); }
#pragma unroll
  for (int i = 0; i < 2; ++i) {
    *(u32x4*)(smem + kso + i * 64 * 72) = kr[i];
    *(u32x4*)(smem + vso + i * 64 * 72) = vr[i];
  }
#pragma unroll
  for (int i = 0; i < 2; ++i) { kr[i] = GLD_K(i, 1); vr[i] = GLD_V(i, 1); }
  __syncthreads();
  for (int kt = 0; kt < nkt; ++kt) {
    const int cur = (kt & 1) * SSTR, nxt = ((kt + 1) & 1) * SSTR;
    if (kt + 1 < nkt) {
#pragma unroll
      for (int i = 0; i < 2; ++i) {
        *(u32x4*)(smem + nxt + kso + i * 64 * 72) = kr[i];
        *(u32x4*)(smem + nxt + vso + i * 64 * 72) = vr[i];
      }
      if (kt + 2 < nkt) {
#pragma unroll
        for (int i = 0; i < 2; ++i) { kr[i] = GLD_K(i, kt + 2); vr[i] = GLD_V(i, kt + 2); }
      }
    }
    const int k0 = kt * 64;
    if (k0 <= q0 + 31) {
      bf16x8 kfr[8], vfa[8], vfb[8];
#pragma unroll
      for (int s = 0; s < 8; ++s) kfr[s] = *(const bf16x8*)(smem + cur + kro + (s >> 2) * 32 * 72 + (s & 3) * 16);
      __builtin_amdgcn_sched_barrier(0);
      f32x16 S0 = zero16(), S1 = zero16();
#pragma unroll
      for (int s = 0; s < 4; ++s) S0 = MFMA32(kfr[s], qf[s], S0);
#pragma unroll
      for (int s = 0; s < 8; ++s) vfa[s] = *(const bf16x8*)(smem + cur + vro + (s >> 1) * 32 * 72 + (s & 1) * 16);
#pragma unroll
      for (int s = 0; s < 4; ++s) S1 = MFMA32(kfr[4 + s], qf[s], S1);
      __builtin_amdgcn_sched_barrier(0);
      const int dq = q0 + r - k0 - 4 * h;
      float pv[16]; bf16x8 pk[2];
#pragma unroll
      for (int s = 0; s < 8; ++s) vfb[s] = *(const bf16x8*)(smem + cur + vro + (s >> 1) * 32 * 72 + 32 + (s & 1) * 16);
#pragma unroll
      for (int i = 0; i < 16; ++i) pv[i] = __builtin_amdgcn_exp2f(S0[i]);
      if (k0 + 31 > q0) {
#pragma unroll
        for (int i = 0; i < 16; ++i) if ((i & 3) + 8 * (i >> 2) > dq) pv[i] = 0.f;
      }
#pragma unroll
      for (int i = 0; i < 16; ++i) l += pv[i];
      pk[0] = pack8(pv); pk[1] = pack8(pv + 8);
      __builtin_amdgcn_sched_barrier(0);
#pragma unroll
      for (int s = 0; s < 8; ++s) O[s >> 1] = MFMA32(vfa[s], pk[s & 1], O[s >> 1]);
#pragma unroll
      for (int i = 0; i < 16; ++i) pv[i] = __builtin_amdgcn_exp2f(S1[i]);
      if (k0 + 63 > q0) {
#pragma unroll
        for (int i = 0; i < 16; ++i) if (32 + (i & 3) + 8 * (i >> 2) > dq) pv[i] = 0.f;
      }
#pragma unroll
      for (int i = 0; i < 16; ++i) l += pv[i];
      bf16x8 pq[2]; pq[0] = pack8(pv); pq[1] = pack8(pv + 8);
      __builtin_amdgcn_sched_barrier(0);
#pragma unroll
      for (int s = 0; s < 8; ++s) O[s >> 1] = MFMA32(vfb[s], pq[s & 1], O[s >> 1]);
    }
    __syncthreads();
  }
  l += __shfl_xor(l, 32);
  float* xch = (float*)smem + (size_t)wq * 65 * 64 + lane;
  if (grp == 1) {
#pragma unroll
    for (int dvt = 0; dvt < 4; ++dvt)
#pragma unroll
      for (int i = 0; i < 16; ++i) xch[(dvt * 16 + i) * 64] = O[dvt][i];
    xch[64 * 64] = l;
  }
  __syncthreads();
  if (grp == 0) {
    const float i1 = 1.f / l, i2 = lam / xch[64 * 64];
    float ss = 0.f;
#pragma unroll
    for (int dvt = 0; dvt < 4; ++dvt)
#pragma unroll
      for (int i = 0; i < 16; ++i) { const float o = O[dvt][i] * i1 - xch[(dvt * 16 + i) * 64] * i2; O[dvt][i] = o; ss += o * o; }
    ss += __shfl_xor(ss, 32);
    const float rn = rsqrtf(ss * (1.f / 128.f) + EPS) * 0.8f;
#pragma unroll
    for (int dvt = 0; dvt < 4; ++dvt)
#pragma unroll
      for (int i = 0; i < 16; ++i) O[dvt][i] *= rn;
    const size_t tok0 = (size_t)b * SEQ + q0;
    store_gated<4>(O, (float*)smem + 16640 + wq * 4352, p.P + tok0 * NP + 2560 + hd * 128, p.y + tok0 * DM + hd * 128, p.a_subln, lane);
  }
}

__device__ void mem_wave(const Params& p, int l, int b, int mh, int q0, float sc2, float msh, bf16_t* smem) {
  const int tid = opaque_tid(), lane = tid & 63, r = lane & 31, h = lane >> 5;
  const size_t tok = (size_t)b * SEQ + q0 + r;
  const bf16_t* prow = p.P + tok * NP;
  bf16x8 qf[4];
#pragma unroll
  for (int s = 0; s < 4; ++s) qf[s] = *(const bf16x8*)(prow + 2304 + mh * 64 + s * 16 + h * 8);
  const bf16_t* Kl = p.Km + ((size_t)(l * 2 + b) * 256 + r) * 256 + mh * 64 + h * 8;
  const bf16_t* Vl = p.Vmt + ((size_t)(l * 2 + b) * 256 + mh * 64 + r) * 256 + 8 * h;
  f32x16 O[2]; O[0] = zero16(); O[1] = zero16();
  float lsum = 0.f;
  bf16x8 kf[4], vf[4], kn[4], vn[4];
#pragma unroll
  for (int s = 0; s < 4; ++s) { kf[s] = *(const bf16x8*)(Kl + s * 16); vf[s] = *(const bf16x8*)(Vl + (s >> 1) * 32 * 256 + (s & 1) * 16); }
#pragma unroll
  for (int s = 0; s < 4; ++s) { kn[s] = kf[s]; vn[s] = vf[s]; }
  for (int kt = 0; kt < 8; ++kt) {
    if (kt + 1 < 8) {
      const int k1 = (kt + 1) * 32;
#pragma unroll
      for (int s = 0; s < 4; ++s) { kn[s] = *(const bf16x8*)(Kl + (size_t)k1 * 256 + s * 16); vn[s] = *(const bf16x8*)(Vl + (s >> 1) * 32 * 256 + k1 + (s & 1) * 16); }
    }
    __builtin_amdgcn_sched_barrier(0);
    f32x16 S = zero16();
#pragma unroll
    for (int s = 0; s < 4; ++s) S = MFMA32(kf[s], qf[s], S);
    float pv[16];
#pragma unroll
    for (int i = 0; i < 16; ++i) { pv[i] = __builtin_amdgcn_exp2f(S[i] * sc2 - msh); lsum += pv[i]; }
    bf16x8 pk[2]; pk[0] = pack8(pv); pk[1] = pack8(pv + 8);
#pragma unroll
    for (int s = 0; s < 4; ++s) O[s >> 1] = MFMA32(vf[s], pk[s & 1], O[s >> 1]);
#pragma unroll
    for (int s = 0; s < 4; ++s) { kf[s] = kn[s]; vf[s] = vn[s]; }
  }
  lsum += __shfl_xor(lsum, 32);
  const float inv = __builtin_amdgcn_rcpf(lsum);
#pragma unroll
  for (int dvt = 0; dvt < 2; ++dvt)
#pragma unroll
    for (int i = 0; i < 16; ++i) O[dvt][i] *= inv;
  store_gated<2>(O, (float*)smem + (tid >> 6) * 4608, prow - (size_t)r * NP + 2560 + 768 + mh * 64, p.y + (tok - r) * DM + 768 + mh * 64, nullptr, lane);
}

__device__ void sb_wave(const Params& p, int b, int hd, int q0, bf16_t* smem) {
  const int tid = opaque_tid(), lane = tid & 63, r = lane & 31, h = lane >> 5;
  const bf16_t* Pb = p.P + (size_t)b * SEQ * NP;
  const bf16_t* Kl = p.Ksb + (((size_t)b * 12 + hd) * SEQ + r) * 64 + h * 8;
  const bf16_t* Vl = p.Vt + ((size_t)b * 12 + hd) * 256 * 2048 + r * 32 + 8 * h;
  const size_t tok = (size_t)b * SEQ + q0 + r;
  bf16x8 qf[4];
#pragma unroll
  for (int s = 0; s < 4; ++s) qf[s] = *(const bf16x8*)(Pb + (size_t)(q0 + r) * NP + hd * 64 + s * 16 + h * 8);
  f32x16 O[2]; O[0] = zero16(); O[1] = zero16();
  float R = 0.f;
  const int ktd = q0 >> 5;
  bf16x8 kf[4], kn[4], vf[4];
#pragma unroll
  for (int s = 0; s < 4; ++s) { kf[s] = *(const bf16x8*)(Kl + (size_t)q0 * 64 + s * 16); kn[s] = kf[s]; }
  for (int kt = ktd; kt >= 0; --kt) {
    const int k0 = kt * 32;
    const bool diag = (kt == ktd);
#pragma unroll
    for (int s = 0; s < 4; ++s) vf[s] = *(const bf16x8*)(Vl + (size_t)kt * 2048 + (s >> 1) * 32 * 32 + (s & 1) * 16);
    if (kt > 0) {
#pragma unroll
      for (int s = 0; s < 4; ++s) kn[s] = *(const bf16x8*)(Kl + (size_t)(k0 - 32) * 64 + s * 16);
    }
    __builtin_amdgcn_sched_barrier(0);
    f32x16 S = zero16();
#pragma unroll
    for (int s = 0; s < 4; ++s) S = MFMA32(kf[s], qf[s], S);
    float lb[16], f[16];
#pragma unroll
    for (int i = 0; i < 16; ++i) {
      const float z = S[i];
      const float L = __builtin_amdgcn_logf(1.f + __builtin_amdgcn_exp2f(-fabsf(z)));
      const float lbv = fminf(z, 0.f) - L;
      lb[i] = lbv; f[i] = lbv - z;
    }
    if (diag) {
#pragma unroll
      for (int i = 0; i < 16; ++i) if (crow(i, h) >= r) f[i] = 0.f;
    }
    float T[4], PT[4], loc[16];
#pragma unroll
    for (int g = 0; g < 4; ++g) {
      loc[4 * g + 3] = 0.f;
      loc[4 * g + 2] = f[4 * g + 3];
      loc[4 * g + 1] = loc[4 * g + 2] + f[4 * g + 2];
      loc[4 * g + 0] = loc[4 * g + 1] + f[4 * g + 1];
      T[g] = loc[4 * g + 0] + f[4 * g + 0];
    }
#pragma unroll
    for (int g = 0; g < 4; ++g) PT[g] = __shfl_xor(T[g], 32);
    float hg = R;
    float av[16];
#pragma unroll
    for (int g = 3; g >= 0; --g) {
      const float base = hg + (h == 0 ? PT[g] : 0.f);
#pragma unroll
      for (int i = 0; i < 4; ++i) av[4 * g + i] = __builtin_amdgcn_exp2f(lb[4 * g + i] + (base + loc[4 * g + i]));
      hg += T[g] + PT[g];
    }
    if (diag) {
#pragma unroll
      for (int i = 0; i < 16; ++i) if (crow(i, h) >= r) av[i] = 0.f;
    }
    R = hg;
    bf16x8 pk[2]; pk[0] = pack8(av); pk[1] = pack8(av + 8);
#pragma unroll
    for (int s = 0; s < 4; ++s) O[s >> 1] = MFMA32(vf[s], pk[s & 1], O[s >> 1]);
#pragma unroll
    for (int s = 0; s < 4; ++s) kf[s] = kn[s];
    if (__all(R < -104.f * 1.4426950408889634f)) break;
  }
  store_gated<2>(O, (float*)smem + (tid >> 6) * 4608, p.P + (tok - r) * NP + 2560 + hd * 64, p.y + (tok - r) * DM + hd * 64, nullptr, lane);
}

DI float wave_sum(float v) { for (int o = 32; o > 0; o >>= 1) v += __shfl_xor(v, o); return v; }
DI float wave_max(float v) { for (int o = 32; o > 0; o >>= 1) v = fmaxf(v, __shfl_xor(v, o)); return v; }

DI bool gemm_sched(int rd, int ntn, int& mti, int& nti) {
  const int nb = gridDim.x, bid = blockIdx.x;
  if (nb == 256) {
    const int xcd = bid & 7, li = bid >> 3, ti = rd * 32 + li;
    if (ti >= 8 * ntn) return false;
    mti = xcd * 8 + (ti & 7); nti = ti >> 3; return true;
  }
  const int t = rd * nb + bid;
  if (t >= 64 * ntn) return false;
  mti = t / ntn; nti = t % ntn; return true;
}

DI void proj_phase(const Params& p, int layer, bf16_t* smem) {
  const int nb = gridDim.x, bid = blockIdx.x;
  if (nb == 256) {
    const int xcd = bid & 7, li = bid >> 3;
    for (int rd = 0; rd < 3; ++rd) { const int ti = rd * 32 + li; proj_tile<4>(p, layer, (xcd * 8 + (ti & 7)) * 256, ti >> 3, smem); }
    { const int ti = 96 + (li >> 1); proj_tile<2>(p, layer, (xcd * 8 + (ti & 7)) * 256 + (li & 1) * 128, ti >> 3, smem); }
  } else {
    for (int t = bid; t < 64 * 14; t += nb) proj_tile<4>(p, layer, (t / 14) * 256, t % 14, smem);
  }
}

DI unsigned xb_ld(unsigned* q) { return __hip_atomic_load(q, __ATOMIC_RELAXED, __HIP_MEMORY_SCOPE_AGENT); }
DI unsigned xb_add(unsigned* q, unsigned v) { return __hip_atomic_fetch_add(q, v, __ATOMIC_RELAXED, __HIP_MEMORY_SCOPE_AGENT); }
DI void xb_st(unsigned* q, unsigned v) { __hip_atomic_store(q, v, __ATOMIC_RELAXED, __HIP_MEMORY_SCOPE_AGENT); }
struct XB { unsigned* w; unsigned x, nx, nxcc, bsub, bgen, btop, btg, k; };
#define XB_SPIN(cond) do { unsigned sp_ = 0; while (cond) { __builtin_amdgcn_s_sleep(1); if (++sp_ > (1u << 21)) break; } } while (0)
DI void xb_init(XB& b, unsigned* w) {
  b.w = w; b.k = 0; b.nx = 0; b.nxcc = 0;
  b.x = (unsigned)__builtin_amdgcn_s_getreg((3 << 11) | 20) & 0xFu;
  b.bsub = xb_ld(w + 4096 + 1024 + 64 * b.x); b.bgen = xb_ld(w + 4096 + 2048 + 64 * b.x);
  b.btop = xb_ld(w + 4096 + 3072); b.btg = xb_ld(w + 4096 + 3136);
  (void)xb_add(w + 64 * b.x, 1u);
}
DI void grid_barrier(XB& b, bool last) {
  asm volatile("s_waitcnt vmcnt(0)" ::: "memory");
  __syncthreads();
  if (threadIdx.x == 0) {
    unsigned* w = b.w;
    if (b.k == 0) {
      unsigned tot = 0, nx = 0, nxcc = 0, sp = 0;
      for (;;) {
        tot = 0; nx = 0; nxcc = 0;
        for (unsigned j = 0; j < 16; ++j) { const unsigned c = xb_ld(w + 64 * j) - xb_ld(w + 4096 + 64 * j); tot += c; nxcc += (c != 0u); if (j == b.x) nx = c; }
        if (tot == gridDim.x || ++sp > (1u << 18)) break;
        __builtin_amdgcn_s_sleep(1);
      }
      b.nx = nx; b.nxcc = nxcc;
    }
    b.k += 1;
    const unsigned old = xb_add(w + 1024 + 64 * b.x, 1u);
    if (old - b.bsub + 1u == b.k * b.nx) {
      __builtin_amdgcn_fence(__ATOMIC_RELEASE, "agent");
      asm volatile("s_waitcnt vmcnt(0)" ::: "memory");
      const unsigned ot = xb_add(w + 3072, 1u);
      if (ot - b.btop + 1u == b.k * b.nxcc) {
        if (last) { xb_st(w + 4096 + 3072, b.btop + b.k * b.nxcc); xb_st(w + 4096 + 3136, b.btg + b.k); }
        (void)xb_add(w + 3136, 1u);
      }
      XB_SPIN((int)(xb_ld(w + 3136) - b.btg - b.k) < 0);
      if (last) { xb_st(w + 4096 + 64 * b.x, xb_ld(w + 64 * b.x)); xb_st(w + 4096 + 1024 + 64 * b.x, b.bsub + b.k * b.nx); xb_st(w + 4096 + 2048 + 64 * b.x, b.bgen + b.k); }
      (void)xb_add(w + 2048 + 64 * b.x, 1u);
    } else {
      XB_SPIN((int)(xb_ld(w + 2048 + 64 * b.x) - b.bgen - b.k) < 0);
    }
    __builtin_amdgcn_fence(__ATOMIC_ACQUIRE, "agent");
    asm volatile("s_waitcnt vmcnt(0)" ::: "memory");
  }
  __syncthreads();
}

__global__ void __launch_bounds__(512, 2) yoco_fwd(Params p) {
  extern __shared__ __attribute__((aligned(16))) bf16_t smem[];
  cg::grid_group grid = cg::this_grid();
  const int tid = threadIdx.x, lane = tid & 63, wid = tid >> 6, nb = gridDim.x, bid = blockIdx.x, grp = wid >> 2, wq = wid & 3;
  int* s_unit = (int*)(smem + LDS_ELEMS);
  const float LOG2E = 1.4426950408889634f;
  XB xb = {};
  if (tid == 0) xb_init(xb, p.xbw);
  if (bid == 0 && tid < 64) p.ctr[tid] = 0;
  if (p.out == nullptr) grid.sync();

  phase0(p, smem);
  grid_barrier(xb, false);

  proj_phase(p, 0, smem);
  grid_barrier(xb, false);

  {
    const float d1 = wave_sum(p.lq1[lane] * p.lk1[lane]), d2 = wave_sum(p.lq2[lane] * p.lk2[lane]);
    const float lam = __expf(d1) - __expf(d2) + 0.2f;
    const float mqa = wave_max(fabsf(p.a_q_norm[lane])), mka = wave_max(fabsf(p.a_k_norm[lane]));
    const float mqm = wave_max(fabsf(p.mem_q_norm[lane])), mkm = wave_max(fabsf(p.mem_k_norm[lane]));
    const float sc2 = 0.125f * LOG2E;
    const float msh_a = 8.f * mqa * mka * LOG2E, msh_m = 8.f * mqm * mkm * LOG2E;
    unsigned* kvflag = (unsigned*)(p.ctr + 16);
    bool memkv_ready = false;
    const int xq = bid & 7;
    for (;;) {
      __syncthreads();
      if (tid == 0) *s_unit = atomicAdd(&p.ctr[40 + xq], 1);
      __syncthreads();
      const int u = *s_unit;
      if (u >= 1 + 96 + 32) break;
      if (u == 0) {
        mem_tile(p, xq >> 2, (xq >> 1) & 1, xq & 1, smem);
        if (xq < 4) {
          asm volatile("s_waitcnt vmcnt(0)" ::: "memory");
          __syncthreads();
          if (tid == 0) {
            __builtin_amdgcn_fence(__ATOMIC_RELEASE, "agent");
            asm volatile("s_waitcnt vmcnt(0)" ::: "memory");
            (void)__hip_atomic_fetch_add(kvflag, 1u, __ATOMIC_RELAXED, __HIP_MEMORY_SCOPE_AGENT);
          }
        }
      } else if (u < 1 + 96) {
        const int a = u - 1;
        int bh, qb;
        if (a < 32) { bh = 8 + (xq >> 1); qb = 62 + (xq & 1) - 2 * a; } else { bh = xq; qb = 63 - (a - 32); }
        attn_a_unit(p, bh / 6, bh % 6, qb, smem, lam, msh_a);
      } else {
        if (!memkv_ready) {
          if (tid == 0) {
            while (__hip_atomic_load(kvflag, __ATOMIC_RELAXED, __HIP_MEMORY_SCOPE_AGENT) < 4u) __builtin_amdgcn_s_sleep(1);
            __builtin_amdgcn_fence(__ATOMIC_ACQUIRE, "agent");
            asm volatile("s_waitcnt vmcnt(0)" ::: "memory");
          }
          __syncthreads();
          memkv_ready = true;
        }
        const int v = (xq * 32 + (u - 97)) * 2 + grp; mem_wave(p, 0, v >> 8, v & 3, ((v & 255) >> 2) * 128 + wq * 32, sc2, msh_m, smem);
      }
    }
  }
  grid_barrier(xb, false);

  {
    int mti, nti;
    for (int rd = 0; gemm_sched(rd, 4, mti, nti); ++rd) out_tile(p, p.W2t, true, mti, nti, smem);
  }
  grid_barrier(xb, false);

  proj_phase(p, 1, smem);
  grid_barrier(xb, false);

  {
    const float mqm = wave_max(fabsf(p.mem_q_norm[64 + lane])), mkm = wave_max(fabsf(p.mem_k_norm[64 + lane]));
    const float sc2 = 0.125f * LOG2E, msh_m = 8.f * mqm * mkm * LOG2E;
    const int bx = (nb & 7) ? bid : (bid & 7) * (nb >> 3) + (bid >> 3);
    for (int u = bx * 8 + wid; u < 6144 + 2048; u += nb * 8) {
      if (u < 6144) { const int bh = u >> 8, q32 = 255 - (u & 255); sb_wave(p, bh / 12, bh % 12, q32 * 32, smem); }
      else { const int v = u - 6144, rem = v & 1023; mem_wave(p, 1, v >> 10, (rem >> 2) & 3, (rem >> 4) * 128 + (rem & 3) * 32, sc2, msh_m, smem); }
    }
  }
  grid_barrier(xb, true);

  {
    int mti, nti;
    for (int rd = 0; gemm_sched(rd, 4, mti, nti); ++rd) out_tile(p, p.W4t, false, mti, nti, smem);
  }
}

extern "C" void kernel_launch(void* const* d_in, const int* in_sizes, int n_in, void* d_out, int out_size, void* d_ws, size_t ws_size, hipStream_t stream) {
  static int grid_blocks = 0;
  if (!grid_blocks) {
    int dev = 0, cus = 0, per_cu = 0;
    (void)hipGetDevice(&dev);
    (void)hipDeviceGetAttribute(&cus, hipDeviceAttributeMultiprocessorCount, dev);
    (void)hipFuncSetAttribute((const void*)yoco_fwd, hipFuncAttributeMaxDynamicSharedMemorySize, LDS_BYTES);
    (void)hipOccupancyMaxActiveBlocksPerMultiprocessor(&per_cu, yoco_fwd, NT, LDS_BYTES);
    if (per_cu > 1) per_cu = 1;
    if (per_cu < 1) per_cu = 1;
    grid_blocks = cus * per_cu;
  }
  Params p;
  memset(&p, 0, sizeof(p));
  const float* const* in = (const float* const*)d_in;
  p.x = in[0]; p.mem = in[1]; p.pos = (const int*)d_in[2];
  p.a_q_norm = in[5]; p.a_k_norm = in[6]; p.lq1 = in[7]; p.lk1 = in[8]; p.lq2 = in[9]; p.lk2 = in[10]; p.a_subln = in[11];
  p.mem_q_norm = in[20]; p.mem_k_norm = in[21];
  p.out = (float*)d_out;
  char* w = (char*)d_ws;
  size_t off = 0;
  auto take = [&](size_t bytes) { char* q = w + off; off += (bytes + 255) & ~(size_t)255; return q; };
  p.ctr = (int*)take(1024);
  p.xbw = (unsigned*)take(32768);
  p.P = (bf16_t*)take((size_t)NTOK * NP * 2);
  p.Vt = (bf16_t*)take((size_t)2 * 768 * SEQ * 2);
  p.xb = (bf16_t*)take((size_t)NTOK * DM * 2);
  p.y = (bf16_t*)take((size_t)NTOK * DM * 2);
  p.Ksb = (bf16_t*)take((size_t)2 * 768 * SEQ * 2);
  p.W1t = (bf16_t*)take((size_t)3584 * DM * 2);
  p.W2t = (bf16_t*)take((size_t)1024 * DM * 2);
  p.W3t = (bf16_t*)take((size_t)3584 * DM * 2);
  p.W4t = (bf16_t*)take((size_t)1024 * DM * 2);
  p.Wmt = (bf16_t*)take((size_t)2 * 512 * DM * 2);
  p.memb = (bf16_t*)take((size_t)512 * DM * 2);
  p.Km = (bf16_t*)take((size_t)2 * 512 * 256 * 2);
  p.Vmt = (bf16_t*)take((size_t)2 * 512 * 256 * 2);
  p.ssq0 = (float*)take((size_t)NTOK * 16 * 4);
  p.ssq1 = (float*)take((size_t)NTOK * 16 * 4);
  p.ssqm = (float*)take((size_t)512 * 16 * 4);
  p.cs = (float*)take((size_t)NTOK * 16 * 4);
  const float* a_norm = in[3]; const float* a_w_in = in[4]; const float* a_w_out = in[12]; const float* kv_norm = in[13]; const float* w_kv = in[14];
  const float* b_norm = in[15]; const float* b_w_in = in[16]; const float* b_w_out = in[17]; const float* mem_norm = in[18]; const float* mem_w_kv = in[19];
  auto setseg = [&](int i, const float* src, const float* gain, bf16_t* dst, int ld, int col0, int ncols) {
    p.seg[i].src = src; p.seg[i].gain = gain; p.seg[i].dst = dst; p.seg[i].ld = ld; p.seg[i].col0 = col0; p.seg[i].ncols = ncols; p.seg[i].pad = 0; };
  setseg(0, a_w_in, a_norm, p.W1t, 3584, 0, 3584);
  setseg(1, a_w_out, nullptr, p.W2t, 1024, 0, 1024);
  setseg(2, b_w_in, b_norm, p.W3t, 2048, 0, 768);
  setseg(3, w_kv, kv_norm, p.W3t + (size_t)768 * DM, 1536, 0, 1536);
  setseg(4, b_w_in, b_norm, p.W3t + (size_t)2304 * DM, 2048, 768, 1280);
  setseg(5, b_w_out, nullptr, p.W4t, 1024, 0, 1024);
  setseg(6, mem_w_kv, mem_norm, p.Wmt, 512, 0, 512);
  setseg(7, mem_w_kv + (size_t)1024 * 512, mem_norm + 1024, p.Wmt + (size_t)512 * DM, 512, 0, 512);
  for (int i = 0; i < 8; ++i) p.inv[i] = (float)pow(500000.0, -(double)i / 8.0);
  void* args[] = {&p};
  hipError_t e = hipLaunchCooperativeKernel((const void*)yoco_fwd, dim3(grid_blocks), dim3(NT), args, LDS_BYTES, stream);
  if (e != hipSuccess) fprintf(stderr, "cooperative launch failed: %s (grid %d)\n", hipGetErrorString(e), grid_blocks);
}
```

```cpp
#include <hip/hip_runtime.h>
#include <hip/hip_cooperative_groups.h>
#include <cstdio>
#include <cmath>
#include <cstring>
namespace cg = cooperative_groups;

typedef unsigned short bf16_t;
typedef short bf16x8 __attribute__((ext_vector_type(8)));
typedef short bf16x4 __attribute__((ext_vector_type(4)));
typedef float f32x16 __attribute__((ext_vector_type(16)));
typedef float f32x4 __attribute__((ext_vector_type(4)));
typedef float f32x2 __attribute__((ext_vector_type(2)));
typedef unsigned u32x4 __attribute__((ext_vector_type(4)));
typedef unsigned u32x2 __attribute__((ext_vector_type(2)));
typedef __bf16 bf2_t __attribute__((ext_vector_type(2)));

#define DI __device__ __forceinline__
#define MFMA32(a, b, c) __builtin_amdgcn_mfma_f32_32x32x16_bf16((a), (b), (c), 0, 0, 0)

constexpr int SEQ = 8192, DM = 1024, NTOK = 16384, NP = 3584;
constexpr int NT = 512;
constexpr float EPS = 1e-6f;
constexpr int LDS_ELEMS = 2 * 512 * 72;
constexpr int LDS_BYTES = LDS_ELEMS * 2 + 16;

struct Seg { const float* src; const float* gain; bf16_t* dst; int ld; int col0; int ncols; int pad; };

struct Params {
  const float* x; const float* mem; const int* pos;
  const float* a_q_norm; const float* a_k_norm; const float* lq1; const float* lk1; const float* lq2; const float* lk2; const float* a_subln;
  const float* mem_q_norm; const float* mem_k_norm;
  float* out;
  bf16_t* xb; bf16_t* memb; bf16_t* P; bf16_t* Vt; bf16_t* y;
  bf16_t* Ksb; bf16_t* W1t; bf16_t* W2t; bf16_t* W3t; bf16_t* W4t; bf16_t* Wmt; bf16_t* Km; bf16_t* Vmt;
  float* ssq0; float* ssq1; float* ssqm; float* cs; int* ctr; unsigned* xbw;
  Seg seg[8];
  float inv[8];
};

DI unsigned pk2(float a, float b) { f32x2 v = {a, b}; bf2_t r = __builtin_convertvector(v, bf2_t); return __builtin_bit_cast(unsigned, r); }
DI bf16_t f2bf(float a) { return (bf16_t)(pk2(a, 0.f) & 0xffffu); }
DI float bflo(unsigned w) { return __uint_as_float(w << 16); }
DI float bfhi(unsigned w) { return __uint_as_float(w & 0xffff0000u); }
DI int crow(int reg, int h) { return (reg & 3) + 8 * (reg >> 2) + 4 * h; }
DI int perm16(int kk) { return ((kk >> 2) & 1) * 8 + (kk >> 3) * 4 + (kk & 3); }
DI bf16x8 pack8(const float* v) {
  u32x4 w; w.x = pk2(v[0], v[1]); w.y = pk2(v[2], v[3]); w.z = pk2(v[4], v[5]); w.w = pk2(v[6], v[7]);
  return __builtin_bit_cast(bf16x8, w);
}
DI int opaque_tid() { int t = threadIdx.x; asm volatile("" : "+v"(t)); return t; }
DI f32x16 zero16() { f32x16 z; for (int i = 0; i < 16; ++i) z[i] = 0.f; return z; }

__device__ void phase0(const Params& p, bf16_t* smem) {
  const int tid = opaque_tid(), lane = tid & 63, wid = tid >> 6, nb = gridDim.x, bid = blockIdx.x;
  for (int row0 = (bid * 8 + wid) * 2; row0 < NTOK + 512; row0 += nb * 16) {
    f32x4 v[2][4];
#pragma unroll
    for (int q = 0; q < 2; ++q) {
      const int row = row0 + q;
      const float* src = (row < NTOK) ? p.x + (size_t)row * DM : p.mem + (size_t)(row - NTOK) * DM;
#pragma unroll
      for (int j = 0; j < 4; ++j) v[q][j] = __builtin_nontemporal_load((const f32x4*)(src + 256 * j + 4 * lane));
    }
#pragma unroll
    for (int q = 0; q < 2; ++q) {
      const int row = row0 + q;
      bf16_t* dst; float* sq;
      if (row < NTOK) { dst = p.xb + (size_t)row * DM; sq = p.ssq0 + (size_t)row * 16; }
      else { const int r2 = row - NTOK; dst = p.memb + (size_t)r2 * DM; sq = p.ssqm + (size_t)r2 * 16; }
#pragma unroll
      for (int j = 0; j < 4; ++j) {
        const f32x4 t = v[q][j];
        float s = t.x * t.x + t.y * t.y + t.z * t.z + t.w * t.w;
        u32x2 w; w.x = pk2(t.x, t.y); w.y = pk2(t.z, t.w);
        *(u32x2*)(dst + 256 * j + 4 * lane) = w;
        s += __shfl_xor(s, 1); s += __shfl_xor(s, 2); s += __shfl_xor(s, 4); s += __shfl_xor(s, 8);
        if ((lane & 15) == 0) sq[4 * j + (lane >> 4)] = s;
      }
    }
  }
  for (int i = bid * NT + tid; i < NTOK * 8; i += nb * NT) {
    const int token = i >> 3, f = i & 7;
    const float ang = (float)p.pos[token] * p.inv[f];
    double rev = (double)ang * 0.15915494309189535;
    rev -= floor(rev);
    const double q4 = rint(rev * 4.0);
    const double a = (rev - q4 * 0.25) * 6.283185307179586;
    const int q = ((int)q4) & 3;
    const double a2 = a * a;
    double sn = -1.0 / 39916800.0; sn = sn * a2 + 1.0 / 362880.0; sn = sn * a2 - 1.0 / 5040.0; sn = sn * a2 + 1.0 / 120.0; sn = sn * a2 - 1.0 / 6.0; sn = sn * a2 + 1.0; sn *= a;
    double cn = 1.0 / 479001600.0; cn = cn * a2 - 1.0 / 3628800.0; cn = cn * a2 + 1.0 / 40320.0; cn = cn * a2 - 1.0 / 720.0; cn = cn * a2 + 1.0 / 24.0; cn = cn * a2 - 0.5; cn = cn * a2 + 1.0;
    double c, s;
    if (q == 0) { c = cn; s = sn; } else if (q == 1) { c = -sn; s = cn; } else if (q == 2) { c = -cn; s = -sn; } else { c = sn; s = -cn; }
    p.cs[(size_t)token * 16 + f] = (float)c;
    p.cs[(size_t)token * 16 + 8 + f] = (float)s;
  }
  {
    f32x4 nv[2]; float ng[2]; bf16_t* ndst = nullptr;
    auto fetch = [&](int t) {
      int ct = t >> 4; const int k0 = (t & 15) * 64;
      int si = 0;
      while (ct >= (p.seg[si].ncols >> 6)) { ct -= (p.seg[si].ncols >> 6); ++si; }
      const Seg sg = p.seg[si];
      const int n0 = ct * 64;
#pragma unroll
      for (int j = 0; j < 2; ++j) {
        const int i = tid + NT * j, kr = i >> 4, c4 = i & 15;
        nv[j] = __builtin_nontemporal_load((const f32x4*)(sg.src + (size_t)(k0 + kr) * sg.ld + sg.col0 + n0 + c4 * 4));
        ng[j] = sg.gain ? sg.gain[k0 + kr] : 1.f;
      }
      ndst = sg.dst + (size_t)(n0 + (tid >> 3)) * DM + k0 + (tid & 7) * 8;
    };
    if (bid < 2560) fetch(bid);
    for (int t = bid; t < 2560; t += nb) {
      const f32x4 v0 = nv[0], v1 = nv[1]; const float g0 = ng[0], g1 = ng[1]; bf16_t* dst = ndst;
      if (t + nb < 2560) fetch(t + nb);
      __syncthreads();
      {
        const int kr = tid >> 4, c4 = tid & 15;
        smem[(c4 * 4 + 0) * 72 + kr] = f2bf(v0.x * g0); smem[(c4 * 4 + 1) * 72 + kr] = f2bf(v0.y * g0);
        smem[(c4 * 4 + 2) * 72 + kr] = f2bf(v0.z * g0); smem[(c4 * 4 + 3) * 72 + kr] = f2bf(v0.w * g0);
        smem[(c4 * 4 + 0) * 72 + kr + 32] = f2bf(v1.x * g1); smem[(c4 * 4 + 1) * 72 + kr + 32] = f2bf(v1.y * g1);
        smem[(c4 * 4 + 2) * 72 + kr + 32] = f2bf(v1.z * g1); smem[(c4 * 4 + 3) * 72 + kr + 32] = f2bf(v1.w * g1);
      }
      __syncthreads();
      *(u32x4*)dst = *(const u32x4*)(smem + (tid >> 3) * 72 + (tid & 7) * 8);
    }
  }
  __syncthreads();
}

template <int MT>
DI void gemm_core(const bf16_t* __restrict__ Wt, const bf16_t* __restrict__ X, int n0, int m0, f32x16 (&acc)[2][MT], bf16_t* smem) {
  const int tid = opaque_tid(), lane = tid & 63, wid = tid >> 6, wn = wid >> 1, wm = wid & 1, r = lane & 31, h = lane >> 5;
  bf16_t* Ws = smem;
  bf16_t* Xs = smem + 2 * 256 * 72;
  const char* wub = (const char*)(Wt + (size_t)n0 * DM);
  const char* xub = (const char*)(X + (size_t)m0 * DM);
  const unsigned voff = (unsigned)(((tid >> 3) * DM + (tid & 7) * 8) * 2);
#define GLD_W(i, k) (*(const u32x4*)(wub + ((size_t)(i) * 64 * DM * 2 + (size_t)(k) * 128) + voff))
#define GLD_X(i, k) (*(const u32x4*)(xub + ((size_t)(i) * 64 * DM * 2 + (size_t)(k) * 128) + voff))
  const int so = (tid >> 3) * 72 + (tid & 7) * 8;
  u32x4 wr[4], xr[MT];
#pragma unroll
  for (int i = 0; i < 4; ++i) wr[i] = GLD_W(i, 0);
#pragma unroll
  for (int i = 0; i < MT; ++i) xr[i] = GLD_X(i, 0);
  __syncthreads();
#pragma unroll
  for (int i = 0; i < 4; ++i) *(u32x4*)(Ws + so + i * 64 * 72) = wr[i];
#pragma unroll
  for (int i = 0; i < MT; ++i) *(u32x4*)(Xs + so + i * 64 * 72) = xr[i];
#pragma unroll
  for (int i = 0; i < 4; ++i) wr[i] = GLD_W(i, 1);
#pragma unroll
  for (int i = 0; i < MT; ++i) xr[i] = GLD_X(i, 1);
  __syncthreads();
  const int ao = (wn * 64 + r) * 72 + h * 8, bo = (wm * (MT * 32) + r) * 72 + h * 8;
  for (int kt = 0; kt < 16; ++kt) {
    const int cur = (kt & 1) * 256 * 72, nxt = ((kt + 1) & 1) * 256 * 72;
#pragma unroll
    for (int s = 0; s < 4; ++s) {
      bf16x8 a[2], b[MT];
#pragma unroll
      for (int nt = 0; nt < 2; ++nt) a[nt] = *(const bf16x8*)(Ws + cur + ao + nt * 32 * 72 + s * 16);
#pragma unroll
      for (int mt = 0; mt < MT; ++mt) b[mt] = *(const bf16x8*)(Xs + cur + bo + mt * 32 * 72 + s * 16);
      if (kt + 1 < 16) {
        *(u32x4*)(Ws + nxt + so + s * 64 * 72) = wr[s];
        if (s < MT) *(u32x4*)(Xs + nxt + so + s * 64 * 72) = xr[s < MT ? s : 0];
        if (kt + 2 < 16) {
          wr[s] = GLD_W(s, kt + 2);
          if (s < MT) xr[s < MT ? s : 0] = GLD_X(s, kt + 2);
        }
      }
#pragma unroll
      for (int nt = 0; nt < 2; ++nt)
#pragma unroll
        for (int mt = 0; mt < MT; ++mt) acc[nt][mt] = MFMA32(a[nt], b[mt], acc[nt][mt]);
    }
    __syncthreads();
  }
}

DI float row_rinv(const float* ssq, int token) {
  const f32x4* q = (const f32x4*)(ssq + (size_t)token * 16);
  const f32x4 a = q[0], b = q[1], c = q[2], d = q[3];
  const float s = ((a.x + a.y) + (a.z + a.w)) + ((b.x + b.y) + (b.z + b.w)) + ((c.x + c.y) + (c.z + c.w)) + ((d.x + d.y) + (d.z + d.w));
  return rsqrtf(s * (1.f / 1024.f) + EPS);
}

enum { EK_QKROPE = 0, EK_NORM = 1, EK_PLAIN = 2, EK_VT = 3, EK_SILU = 4, EK_VBLK = 5 };

template <int MT>
DI void epi_proj(const f32x16 (&acc)[2][MT], int kind, const float* __restrict__ ssq0, const float* __restrict__ gain, const float* __restrict__ cs0,
                 bf16_t* __restrict__ dbase, int ld, bf16_t* __restrict__ vbase, int vt_ld, bf16_t* smem, float qscale) {
  const int tid = opaque_tid(), lane = tid & 63, wid = tid >> 6, r = lane & 31, h = lane >> 5;
  bf16_t* wreg = smem + wid * 9216;
#pragma unroll
  for (int mt = 0; mt < MT; ++mt) {
    const float rs = row_rinv(ssq0, mt * 32);
    float v[2][16];
#pragma unroll
    for (int nt = 0; nt < 2; ++nt)
#pragma unroll
      for (int i = 0; i < 16; ++i) v[nt][i] = acc[nt][mt][i] * rs;
    if (kind <= EK_NORM) {
      float ss = 0.f;
#pragma unroll
      for (int nt = 0; nt < 2; ++nt)
#pragma unroll
        for (int i = 0; i < 16; ++i) ss += v[nt][i] * v[nt][i];
      ss += __shfl_xor(ss, 32);
      const float rn = rsqrtf(ss * (1.f / 64.f) + EPS);
#pragma unroll
      for (int nt = 0; nt < 2; ++nt)
#pragma unroll
        for (int g = 0; g < 4; ++g) {
          const f32x4 gg = *(const f32x4*)(gain + nt * 32 + 8 * g + 4 * h);
          v[nt][4 * g + 0] *= rn * gg.x; v[nt][4 * g + 1] *= rn * gg.y; v[nt][4 * g + 2] *= rn * gg.z; v[nt][4 * g + 3] *= rn * gg.w;
        }
      if (kind == EK_QKROPE) {
        const f32x4 c = *(const f32x4*)(cs0 + mt * 32 * 16 + 4 * h);
        const f32x4 s = *(const f32x4*)(cs0 + mt * 32 * 16 + 8 + 4 * h);
#pragma unroll
        for (int i = 0; i < 4; ++i) {
          const float x1 = v[0][i], x2 = v[0][4 + i];
          v[0][i] = x1 * c[i] - x2 * s[i];
          v[0][4 + i] = x2 * c[i] + x1 * s[i];
        }
#pragma unroll
        for (int nt = 0; nt < 2; ++nt)
#pragma unroll
          for (int i = 0; i < 16; ++i) v[nt][i] *= qscale;
      }
    } else if (kind == EK_PLAIN) {
#pragma unroll
      for (int nt = 0; nt < 2; ++nt)
#pragma unroll
        for (int i = 0; i < 16; ++i) v[nt][i] *= qscale;
    } else if (kind == EK_SILU) {
#pragma unroll
      for (int nt = 0; nt < 2; ++nt)
#pragma unroll
        for (int i = 0; i < 16; ++i) v[nt][i] = v[nt][i] * __builtin_amdgcn_rcpf(1.f + __builtin_amdgcn_exp2f(-1.4426950408889634f * v[nt][i]));
    }
    if (kind == EK_VT || kind == EK_VBLK) {
#pragma unroll
      for (int nt = 0; nt < 2; ++nt)
#pragma unroll
        for (int i = 0; i < 16; ++i) wreg[(nt * 32 + crow(i, h)) * 136 + mt * 32 + (r & 16) + perm16(r & 15)] = f2bf(v[nt][i]);
    } else {
#pragma unroll
      for (int nt = 0; nt < 2; ++nt)
#pragma unroll
        for (int g = 0; g < 4; ++g) {
          u32x2 w; w.x = pk2(v[nt][4 * g], v[nt][4 * g + 1]); w.y = pk2(v[nt][4 * g + 2], v[nt][4 * g + 3]);
          *(u32x2*)(wreg + (mt * 32 + r) * 72 + nt * 32 + 8 * g + 4 * h) = w;
        }
    }
  }
  __syncthreads();
  constexpr int CPR = MT * 4, RPI = 64 / CPR;
  if (kind == EK_VT) {
#pragma unroll
    for (int j = 0; j < CPR; ++j) {
      const int n = j * RPI + lane / CPR, c = lane % CPR;
      *(u32x4*)(vbase + (size_t)n * vt_ld + c * 8) = *(const u32x4*)(wreg + n * 136 + c * 8);
    }
  } else if (kind == EK_VBLK) {
#pragma unroll
    for (int j = 0; j < CPR; ++j) {
      const int n = j * RPI + lane / CPR, c = lane % CPR;
      *(u32x4*)(vbase + (size_t)(c >> 2) * 2048 + n * 32 + (c & 3) * 8) = *(const u32x4*)(wreg + n * 136 + c * 8);
    }
  } else {
#pragma unroll
    for (int j = 0; j < MT * 4; ++j) {
      const int row = j * 8 + (lane >> 3), c = lane & 7;
      *(u32x4*)(dbase + (size_t)row * ld + c * 8) = *(const u32x4*)(wreg + row * 72 + c * 8);
    }
  }
}

template <int MT>
DI void zero_acc(f32x16 (&acc)[2][MT]) {
#pragma unroll
  for (int a = 0; a < 2; ++a)
#pragma unroll
    for (int b = 0; b < MT; ++b) acc[a][b] = zero16();
}

template <int MT>
__device__ void proj_tile(const Params& p, int layer, int m0, int nti, bf16_t* smem) {
  const int tid = opaque_tid(), lane = tid & 63, wid = tid >> 6, wn = wid >> 1, wm = wid & 1, r = lane & 31, h = lane >> 5;
  const int n0 = nti * 256;
  f32x16 acc[2][MT];
  zero_acc<MT>(acc);
  gemm_core<MT>(layer ? p.W3t : p.W1t, p.xb, n0, m0, acc, smem);
  const float* ssq = layer ? p.ssq1 : p.ssq0;
  const int tok = m0 + wm * (MT * 32) + r;
  const int cc = n0 + wn * 64;
  int kind; const float* gain = p.a_q_norm;
  if (cc < 1536) { kind = layer ? EK_PLAIN : EK_QKROPE; gain = (cc < 768) ? p.a_q_norm : p.a_k_norm; }
  else if (cc < 2304) kind = EK_VT;
  else if (cc < 2560) { kind = EK_NORM; gain = p.mem_q_norm + layer * 64; }
  else kind = EK_SILU;
  const int tok0 = m0 + wm * (MT * 32), b = tok0 >> 13;
  bf16_t* vtb = p.Vt + ((size_t)b * 768 + (cc - 1536)) * SEQ + (tok0 & (SEQ - 1));
  bf16_t* dbase = p.P + (size_t)tok0 * NP + cc;
  int ld = NP;
  if (layer && cc >= 768 && cc < 1536) {
    dbase = p.Ksb + (((size_t)b * 12 + ((cc - 768) >> 6)) * SEQ + (tok0 & (SEQ - 1))) * 64; ld = 64;
  } else if (layer && kind == EK_VT) {
    kind = EK_VBLK;
    vtb = p.Vt + (((size_t)b * 12 + ((cc - 1536) >> 6)) * 256 + ((tok0 & (SEQ - 1)) >> 5)) * 2048;
  }
  epi_proj<MT>(acc, kind, ssq + (size_t)tok * 16, gain, p.cs + (size_t)tok * 16, dbase, ld, vtb, SEQ, smem, (cc < 768) ? 0.125f * 1.4426950408889634f : 1.f);
}

__device__ void mem_tile(const Params& p, int l, int mti, int nti, bf16_t* smem) {
  const int tid = opaque_tid(), lane = tid & 63, wid = tid >> 6, wn = wid >> 1, wm = wid & 1, r = lane & 31, h = lane >> 5;
  const int m0 = mti * 256, n0 = nti * 256;
  f32x16 acc[2][4];
  zero_acc<4>(acc);
  gemm_core<4>(p.Wmt + (size_t)l * 512 * DM, p.memb, n0, m0, acc, smem);
  const int tok = m0 + wm * 128 + r;
  const int cc = n0 + wn * 64;
  const int kind = (cc < 256) ? EK_NORM : EK_VT;
  const int tok0 = m0 + wm * 128, b = tok0 >> 8;
  bf16_t* vtb = p.Vmt + ((size_t)(l * 2 + b) * 256 + (cc - 256)) * 256 + (tok0 & 255);
  epi_proj<4>(acc, kind, p.ssqm + (size_t)tok * 16, p.mem_k_norm + l * 64, p.cs, p.Km + ((size_t)l * 512 + tok0) * 256 + cc, 256, vtb, 256, smem, 1.f);
}

__device__ void out_tile(const Params& p, const bf16_t* Wt, bool first, int mti, int nti, bf16_t* smem) {
  const int tid = opaque_tid(), lane = tid & 63, wid = tid >> 6, wn = wid >> 1, wm = wid & 1, r = lane & 31, h = lane >> 5;
  const int m0 = mti * 256, n0 = nti * 256;
  f32x16 acc[2][4];
  zero_acc<4>(acc);
  gemm_core<4>(Wt, p.y, n0, m0, acc, smem);
  const int cc = n0 + wn * 64;
  float* freg = (float*)smem + wid * 4608;
#pragma unroll
  for (int half = 0; half < 2; ++half) {
#pragma unroll
    for (int mtl = 0; mtl < 2; ++mtl)
#pragma unroll
      for (int nt = 0; nt < 2; ++nt)
#pragma unroll
        for (int g = 0; g < 4; ++g) {
          f32x4 o; o.x = acc[nt][half * 2 + mtl][4 * g + 0]; o.y = acc[nt][half * 2 + mtl][4 * g + 1]; o.z = acc[nt][half * 2 + mtl][4 * g + 2]; o.w = acc[nt][half * 2 + mtl][4 * g + 3];
          *(f32x4*)(freg + (mtl * 32 + r) * 68 + nt * 32 + 8 * g + 4 * h) = o;
        }
    __syncthreads();
#pragma unroll
    for (int j = 0; j < 16; ++j) {
      const int row = j * 4 + (lane >> 4), c = lane & 15;
      const int tok = m0 + wm * 128 + half * 64 + row;
      const size_t off = (size_t)tok * DM + cc + c * 4;
      const f32x4 a = *(const f32x4*)(freg + row * 68 + c * 4);
      f32x4 o;
      if (first) {
        const u32x2 xw = *(const u32x2*)(p.xb + off);
        o.x = bflo(xw.x) + a.x; o.y = bfhi(xw.x) + a.y; o.z = bflo(xw.y) + a.z; o.w = bfhi(xw.y) + a.w;
        u32x2 w; w.x = pk2(o.x, o.y); w.y = pk2(o.z, o.w);
        *(u32x2*)(p.xb + off) = w;
        float ss = o.x * o.x + o.y * o.y + o.z * o.z + o.w * o.w;
        ss += __shfl_xor(ss, 1); ss += __shfl_xor(ss, 2); ss += __shfl_xor(ss, 4); ss += __shfl_xor(ss, 8);
        if (c == 0) p.ssq1[(size_t)tok * 16 + (cc >> 6)] = ss;
      } else {
        const u32x2 w = *(const u32x2*)(p.xb + off);
        o.x = bflo(w.x) + a.x; o.y = bfhi(w.x) + a.y; o.z = bflo(w.y) + a.z; o.w = bfhi(w.y) + a.w;
        __builtin_nontemporal_store(o, (f32x4*)(p.out + off));
      }
      if ((j & 3) == 3) __builtin_amdgcn_sched_barrier(0);
    }
    __syncthreads();
  }
}

template <int NDT>
DI void store_gated(const f32x16 (&O)[NDT], float* reg, const bf16_t* __restrict__ grow0, bf16_t* __restrict__ yrow0, const float* __restrict__ gain, int lane) {
  constexpr int RS = NDT * 32 + 4, LPR = NDT * 8, RPI = 64 / LPR;
  const int r = lane & 31, h = lane >> 5;
#pragma unroll
  for (int dvt = 0; dvt < NDT; ++dvt)
#pragma unroll
    for (int g = 0; g < 4; ++g) {
      f32x4 o; o.x = O[dvt][4 * g + 0]; o.y = O[dvt][4 * g + 1]; o.z = O[dvt][4 * g + 2]; o.w = O[dvt][4 * g + 3];
      *(f32x4*)(reg + r * RS + dvt * 32 + 8 * g + 4 * h) = o;
    }
  asm volatile("s_waitcnt lgkmcnt(0)" ::: "memory");
  const int c = lane % LPR;
  f32x4 gg; gg.x = 1.f; gg.y = 1.f; gg.z = 1.f; gg.w = 1.f;
  if (gain) gg = *(const f32x4*)(gain + c * 4);
#pragma unroll
  for (int j = 0; j < 32 / RPI; ++j) {
    const int row = j * RPI + lane / LPR;
    const f32x4 v = *(const f32x4*)(reg + row * RS + c * 4);
    const u32x2 gw = *(const u32x2*)(grow0 + (size_t)row * NP + c * 4);
    u32x2 w;
    w.x = pk2(v.x * gg.x * bflo(gw.x), v.y * gg.y * bfhi(gw.x));
    w.y = pk2(v.z * gg.z * bflo(gw.y), v.w * gg.w * bfhi(gw.y));
    *(u32x2*)(yrow0 + (size_t)row * DM + c * 4) = w;
  }
  asm volatile("s_waitcnt lgkmcnt(0)" ::: "memory");
}

__device__ void attn_a_unit(const Params& p, int b, int hd, int qb, bf16_t* smem, float lam, float msh) {
  const int tid = opaque_tid(), lane = tid & 63, wid = tid >> 6, r = lane & 31, h = lane >> 5, grp = wid >> 2, wq = wid & 3;
  const bf16_t* Pb = p.P + (size_t)b * SEQ * NP;
  const bf16_t* Vb = p.Vt + ((size_t)b * 768 + hd * 128) * SEQ;
  const int q0 = qb * 128 + wq * 32;
  bf16x8 qf[4];
#pragma unroll
  for (int s = 0; s < 4; ++s) qf[s] = *(const bf16x8*)(Pb + (size_t)(q0 + r) * NP + grp * 384 + hd * 64 + s * 16 + h * 8);
  f32x16 O[4];
#pragma unroll
  for (int i = 0; i < 4; ++i) O[i] = zero16();
  float l = 0.f;
  const int nkt = 2 * (qb + 1);
  constexpr int VOFF = 9216, SSTR = 18432;
  const char* kub = (const char*)(Pb + 768 + hd * 64);
  const char* vub = (const char*)Vb;
  const unsigned kvo = (unsigned)(((tid >> 3) * NP + (tid & 7) * 8) * 2);
  const unsigned vvo = (unsigned)(((tid >> 3) * SEQ + (tid & 7) * 8) * 2);
#define GLD_K(i, t) (*(const u32x4*)(kub + ((size_t)(t) * 64 * NP * 2 + (size_t)(i) * 768) + kvo))
#define GLD_V(i, t) (*(const u32x4*)(vub + ((size_t)(i) * 64 * SEQ * 2 + (size_t)(t) * 128) + vvo))
  const int kso = (tid >> 3) * 72 + (tid & 7) * 8;
  const int vso = VOFF + (tid >> 3) * 72 + (tid & 7) * 8;
  const int kro = grp * 64 * 72 + r * 72 + h * 8;
  const int vro = VOFF + r * 72 + 8 * h;
  u32x4 kr[2], vr[2];
#pragma unroll
  for (int i = 0; i < 2; ++i) { kr[i] = GLD_K(i, 0); vr[i] = GLD_V(i, 0); }
#pragma unroll
  for (int i = 0; i < 2; ++i) {
    *(u32x4*)(smem + kso + i * 64 * 72) = kr[i];
    *(u32x4*)(smem + vso + i * 64 * 72) = vr[i];
  }
#pragma unroll
  for (int i = 0; i < 2; ++i) { kr[i] = GLD_K(i, 1); vr[i] = GLD_V(i, 1); }
  __syncthreads();
  for (int kt = 0; kt < nkt; ++kt) {
    const int cur = (kt & 1) * SSTR, nxt = ((kt + 1) & 1) * SSTR;
    if (kt + 1 < nkt) {
#pragma unroll
      for (int i = 0; i < 2; ++i) {
        *(u32x4*)(smem + nxt + kso + i * 64 * 72) = kr[i];
        *(u32x4*)(smem + nxt + vso + i * 64 * 72) = vr[i];
      }
      if (kt + 2 < nkt) {
#pragma unroll
        for (int i = 0; i < 2; ++i) { kr[i] = GLD_K(i, kt + 2); vr[i] = GLD_V(i, kt + 2); }
      }
    }
    const int k0 = kt * 64;
    if (k0 <= q0 + 31) {
      bf16x8 kfr[8], vfa[8], vfb[8];
#pragma unroll
      for (int s = 0; s < 8; ++s) kfr[s] = *(const bf16x8*)(smem + cur + kro + (s >> 2) * 32 * 72 + (s & 3) * 16);
      __builtin_amdgcn_sched_barrier(0);
      f32x16 S0 = zero16(), S1 = zero16();
#pragma unroll
      for (int s = 0; s < 4; ++s) S0 = MFMA32(kfr[s], qf[s], S0);
#pragma unroll
      for (int s = 0; s < 8; ++s) vfa[s] = *(const bf16x8*)(smem + cur + vro + (s >> 1) * 32 * 72 + (s & 1) * 16);
#pragma unroll
      for (int s = 0; s < 4; ++s) S1 = MFMA32(kfr[4 + s], qf[s], S1);
      __builtin_amdgcn_sched_barrier(0);
      const int dq = q0 + r - k0 - 4 * h;
      float pv[16]; bf16x8 pk[2];
#pragma unroll
      for (int s = 0; s < 8; ++s) vfb[s] = *(const bf16x8*)(smem + cur + vro + (s >> 1) * 32 * 72 + 32 + (s & 1) * 16);
#pragma unroll
      for (int i = 0; i < 16; ++i) pv[i] = __builtin_amdgcn_exp2f(S0[i]);
      if (k0 + 31 > q0) {
#pragma unroll
        for (int i = 0; i < 16; ++i) if ((i & 3) + 8 * (i >> 2) > dq) pv[i] = 0.f;
      }
#pragma unroll
      for (int i = 0; i < 16; ++i) l += pv[i];
      pk[0] = pack8(pv); pk[1] = pack8(pv + 8);
      __builtin_amdgcn_sched_barrier(0);
#pragma unroll
      for (int s = 0; s < 8; ++s) O[s >> 1] = MFMA32(vfa[s], pk[s & 1], O[s >> 1]);
#pragma unroll
      for (int i = 0; i < 16; ++i) pv[i] = __builtin_amdgcn_exp2f(S1[i]);
      if (k0 + 63 > q0) {
#pragma unroll
        for (int i = 0; i < 16; ++i) if (32 + (i & 3) + 8 * (i >> 2) > dq) pv[i] = 0.f;
      }
#pragma unroll
      for (int i = 0; i < 16; ++i) l += pv[i];
      bf16x8 pq[2]; pq[0] = pack8(pv); pq[1] = pack8(pv + 8);
      __builtin_amdgcn_sched_barrier(0);
#pragma unroll
      for (int s = 0; s < 8; ++s) O[s >> 1] = MFMA32(vfb[s], pq[s & 1], O[s >> 1]);
    }
    __syncthreads();
  }
  l += __shfl_xor(l, 32);
  float* xch = (float*)smem + (size_t)wq * 65 * 64 + lane;
  if (grp == 1) {
#pragma unroll
    for (int dvt = 0; dvt < 4; ++dvt)
#pragma unroll
      for (int i = 0; i < 16; ++i) xch[(dvt * 16 + i) * 64] = O[dvt][i];
    xch[64 * 64] = l;
  }
  __syncthreads();
  if (grp == 0) {
    const float i1 = 1.f / l, i2 = lam / xch[64 * 64];
    float ss = 0.f;
#pragma unroll
    for (int dvt = 0; dvt < 4; ++dvt)
#pragma unroll
      for (int i = 0; i < 16; ++i) { const float o = O[dvt][i] * i1 - xch[(dvt * 16 + i) * 64] * i2; O[dvt][i] = o; ss += o * o; }
    ss += __shfl_xor(ss, 32);
    const float rn = rsqrtf(ss * (1.f / 128.f) + EPS) * 0.8f;
#pragma unroll
    for (int dvt = 0; dvt < 4; ++dvt)
#pragma unroll
      for (int i = 0; i < 16; ++i) O[dvt][i] *= rn;
    const size_t tok0 = (size_t)b * SEQ + q0;
    store_gated<4>(O, (float*)smem + 16640 + wq * 4352, p.P + tok0 * NP + 2560 + hd * 128, p.y + tok0 * DM + hd * 128, p.a_subln, lane);
  }
}

__device__ void mem_wave(const Params& p, int l, int b, int mh, int q0, float sc2, float msh, bf16_t* smem) {
  const int tid = opaque_tid(), lane = tid & 63, r = lane & 31, h = lane >> 5;
  const size_t tok = (size_t)b * SEQ + q0 + r;
  const bf16_t* prow = p.P + tok * NP;
  bf16x8 qf[4];
#pragma unroll
  for (int s = 0; s < 4; ++s) qf[s] = *(const bf16x8*)(prow + 2304 + mh * 64 + s * 16 + h * 8);
  const bf16_t* Kl = p.Km + ((size_t)(l * 2 + b) * 256 + r) * 256 + mh * 64 + h * 8;
  const bf16_t* Vl = p.Vmt + ((size_t)(l * 2 + b) * 256 + mh * 64 + r) * 256 + 8 * h;
  f32x16 O[2]; O[0] = zero16(); O[1] = zero16();
  float lsum = 0.f;
  bf16x8 kf[4], vf[4], kn[4], vn[4];
#pragma unroll
  for (int s = 0; s < 4; ++s) { kf[s] = *(const bf16x8*)(Kl + s * 16); vf[s] = *(const bf16x8*)(Vl + (s >> 1) * 32 * 256 + (s & 1) * 16); }
#pragma unroll
  for (int s = 0; s < 4; ++s) { kn[s] = kf[s]; vn[s] = vf[s]; }
  for (int kt = 0; kt < 8; ++kt) {
    if (kt + 1 < 8) {
      const int k1 = (kt + 1) * 32;
#pragma unroll
      for (int s = 0; s < 4; ++s) { kn[s] = *(const bf16x8*)(Kl + (size_t)k1 * 256 + s * 16); vn[s] = *(const bf16x8*)(Vl + (s >> 1) * 32 * 256 + k1 + (s & 1) * 16); }
    }
    __builtin_amdgcn_sched_barrier(0);
    f32x16 S = zero16();
#pragma unroll
    for (int s = 0; s < 4; ++s) S = MFMA32(kf[s], qf[s], S);
    float pv[16];
#pragma unroll
    for (int i = 0; i < 16; ++i) { pv[i] = __builtin_amdgcn_exp2f(S[i] * sc2 - msh); lsum += pv[i]; }
    bf16x8 pk[2]; pk[0] = pack8(pv); pk[1] = pack8(pv + 8);
#pragma unroll
    for (int s = 0; s < 4; ++s) O[s >> 1] = MFMA32(vf[s], pk[s & 1], O[s >> 1]);
#pragma unroll
    for (int s = 0; s < 4; ++s) { kf[s] = kn[s]; vf[s] = vn[s]; }
  }
  lsum += __shfl_xor(lsum, 32);
  const float inv = __builtin_amdgcn_rcpf(lsum);
#pragma unroll
  for (int dvt = 0; dvt < 2; ++dvt)
#pragma unroll
    for (int i = 0; i < 16; ++i) O[dvt][i] *= inv;
  store_gated<2>(O, (float*)smem + (tid >> 6) * 4608, prow - (size_t)r * NP + 2560 + 768 + mh * 64, p.y + (tok - r) * DM + 768 + mh * 64, nullptr, lane);
}

__device__ void sb_wave(const Params& p, int b, int hd, int q0, bf16_t* smem) {
  const int tid = opaque_tid(), lane = tid & 63, r = lane & 31, h = lane >> 5;
  const bf16_t* Pb = p.P + (size_t)b * SEQ * NP;
  const bf16_t* Kl = p.Ksb + (((size_t)b * 12 + hd) * SEQ + r) * 64 + h * 8;
  const bf16_t* Vl = p.Vt + ((size_t)b * 12 + hd) * 256 * 2048 + r * 32 + 8 * h;
  const size_t tok = (size_t)b * SEQ + q0 + r;
  bf16x8 qf[4];
#pragma unroll
  for (int s = 0; s < 4; ++s) qf[s] = *(const bf16x8*)(Pb + (size_t)(q0 + r) * NP + hd * 64 + s * 16 + h * 8);
  f32x16 O[2]; O[0] = zero16(); O[1] = zero16();
  float R = 0.f;
  const int ktd = q0 >> 5;
  bf16x8 kf[4], kn[4], vf[4];
#pragma unroll
  for (int s = 0; s < 4; ++s) { kf[s] = *(const bf16x8*)(Kl + (size_t)q0 * 64 + s * 16); kn[s] = kf[s]; }
  for (int kt = ktd; kt >= 0; --kt) {
    const int k0 = kt * 32;
    const bool diag = (kt == ktd);
#pragma unroll
    for (int s = 0; s < 4; ++s) vf[s] = *(const bf16x8*)(Vl + (size_t)kt * 2048 + (s >> 1) * 32 * 32 + (s & 1) * 16);
    if (kt > 0) {
#pragma unroll
      for (int s = 0; s < 4; ++s) kn[s] = *(const bf16x8*)(Kl + (size_t)(k0 - 32) * 64 + s * 16);
    }
    __builtin_amdgcn_sched_barrier(0);
    f32x16 S = zero16();
#pragma unroll
    for (int s = 0; s < 4; ++s) S = MFMA32(kf[s], qf[s], S);
    float lb[16], f[16];
#pragma unroll
    for (int i = 0; i < 16; ++i) {
      const float z = S[i];
      const float L = __builtin_amdgcn_logf(1.f + __builtin_amdgcn_exp2f(-fabsf(z)));
      const float lbv = fminf(z, 0.f) - L;
      lb[i] = lbv; f[i] = lbv - z;
    }
    if (diag) {
#pragma unroll
      for (int i = 0; i < 16; ++i) if (crow(i, h) >= r) f[i] = 0.f;
    }
    float T[4], PT[4], loc[16];
#pragma unroll
    for (int g = 0; g < 4; ++g) {
      loc[4 * g + 3] = 0.f;
      loc[4 * g + 2] = f[4 * g + 3];
      loc[4 * g + 1] = loc[4 * g + 2] + f[4 * g + 2];
      loc[4 * g + 0] = loc[4 * g + 1] + f[4 * g + 1];
      T[g] = loc[4 * g + 0] + f[4 * g + 0];
    }
#pragma unroll
    for (int g = 0; g < 4; ++g) PT[g] = __shfl_xor(T[g], 32);
    float hg = R;
    float av[16];
#pragma unroll
    for (int g = 3; g >= 0; --g) {
      const float base = hg + (h == 0 ? PT[g] : 0.f);
#pragma unroll
      for (int i = 0; i < 4; ++i) av[4 * g + i] = __builtin_amdgcn_exp2f(lb[4 * g + i] + (base + loc[4 * g + i]));
      hg += T[g] + PT[g];
    }
    if (diag) {
#pragma unroll
      for (int i = 0; i < 16; ++i) if (crow(i, h) >= r) av[i] = 0.f;
    }
    R = hg;
    bf16x8 pk[2]; pk[0] = pack8(av); pk[1] = pack8(av + 8);
#pragma unroll
    for (int s = 0; s < 4; ++s) O[s >> 1] = MFMA32(vf[s], pk[s & 1], O[s >> 1]);
#pragma unroll
    for (int s = 0; s < 4; ++s) kf[s] = kn[s];
    if (__all(R < -104.f * 1.4426950408889634f)) break;
  }
  store_gated<2>(O, (float*)smem + (tid >> 6) * 4608, p.P + (tok - r) * NP + 2560 + hd * 64, p.y + (tok - r) * DM + hd * 64, nullptr, lane);
}

DI float wave_sum(float v) { for (int o = 32; o > 0; o >>= 1) v += __shfl_xor(v, o); return v; }
DI float wave_max(float v) { for (int o = 32; o > 0; o >>= 1) v = fmaxf(v, __shfl_xor(v, o)); return v; }

DI bool gemm_sched(int rd, int ntn, int& mti, int& nti) {
  const int nb = gridDim.x, bid = blockIdx.x;
  if (nb == 256) {
    const int xcd = bid & 7, li = bid >> 3, ti = rd * 32 + li;
    if (ti >= 8 * ntn) return false;
    mti = xcd * 8 + (ti & 7); nti = ti >> 3; return true;
  }
  const int t = rd * nb + bid;
  if (t >= 64 * ntn) return false;
  mti = t / ntn; nti = t % ntn; return true;
}

DI void proj_phase(const Params& p, int layer, bf16_t* smem) {
  const int nb = gridDim.x, bid = blockIdx.x;
  if (nb == 256) {
    const int xcd = bid & 7, li = bid >> 3;
    for (int rd = 0; rd < 3; ++rd) { const int ti = rd * 32 + li; proj_tile<4>(p, layer, (xcd * 8 + (ti & 7)) * 256, ti >> 3, smem); }
    { const int ti = 96 + (li >> 1); proj_tile<2>(p, layer, (xcd * 8 + (ti & 7)) * 256 + (li & 1) * 128, ti >> 3, smem); }
  } else {
    for (int t = bid; t < 64 * 14; t += nb) proj_tile<4>(p, layer, (t / 14) * 256, t % 14, smem);
  }
}

DI unsigned xb_ld(unsigned* q) { return __hip_atomic_load(q, __ATOMIC_RELAXED, __HIP_MEMORY_SCOPE_AGENT); }
DI unsigned xb_add(unsigned* q, unsigned v) { return __hip_atomic_fetch_add(q, v, __ATOMIC_RELAXED, __HIP_MEMORY_SCOPE_AGENT); }
DI void xb_st(unsigned* q, unsigned v) { __hip_atomic_store(q, v, __ATOMIC_RELAXED, __HIP_MEMORY_SCOPE_AGENT); }
struct XB { unsigned* w; unsigned x, nx, nxcc, bsub, bgen, btop, btg, k; };
#define XB_SPIN(cond) do { unsigned sp_ = 0; while (cond) { __builtin_amdgcn_s_sleep(1); if (++sp_ > (1u << 21)) break; } } while (0)
DI void xb_init(XB& b, unsigned* w) {
  b.w = w; b.k = 0; b.nx = 0; b.nxcc = 0;
  b.x = (unsigned)__builtin_amdgcn_s_getreg((3 << 11) | 20) & 0xFu;
  b.bsub = xb_ld(w + 4096 + 1024 + 64 * b.x); b.bgen = xb_ld(w + 4096 + 2048 + 64 * b.x);
  b.btop = xb_ld(w + 4096 + 3072); b.btg = xb_ld(w + 4096 + 3136);
  (void)xb_add(w + 64 * b.x, 1u);
}
DI void grid_barrier(XB& b, bool last) {
  asm volatile("s_waitcnt vmcnt(0)" ::: "memory");
  __syncthreads();
  if (threadIdx.x == 0) {
    unsigned* w = b.w;
    if (b.k == 0) {
      unsigned tot = 0, nx = 0, nxcc = 0, sp = 0;
      for (;;) {
        tot = 0; nx = 0; nxcc = 0;
        for (unsigned j = 0; j < 16; ++j) { const unsigned c = xb_ld(w + 64 * j) - xb_ld(w + 4096 + 64 * j); tot += c; nxcc += (c != 0u); if (j == b.x) nx = c; }
        if (tot == gridDim.x || ++sp > (1u << 18)) break;
        __builtin_amdgcn_s_sleep(1);
      }
      b.nx = nx; b.nxcc = nxcc;
    }
    b.k += 1;
    const unsigned old = xb_add(w + 1024 + 64 * b.x, 1u);
    if (old - b.bsub + 1u == b.k * b.nx) {
      __builtin_amdgcn_fence(__ATOMIC_RELEASE, "agent");
      asm volatile("s_waitcnt vmcnt(0)" ::: "memory");
      const unsigned ot = xb_add(w + 3072, 1u);
      if (ot - b.btop + 1u == b.k * b.nxcc) {
        if (last) { xb_st(w + 4096 + 3072, b.btop + b.k * b.nxcc); xb_st(w + 4096 + 3136, b.btg + b.k); }
        (void)xb_add(w + 3136, 1u);
      }
      XB_SPIN((int)(xb_ld(w + 3136) - b.btg - b.k) < 0);
      if (last) { xb_st(w + 4096 + 64 * b.x, xb_ld(w + 64 * b.x)); xb_st(w + 4096 + 1024 + 64 * b.x, b.bsub + b.k * b.nx); xb_st(w + 4096 + 2048 + 64 * b.x, b.bgen + b.k); }
      (void)xb_add(w + 2048 + 64 * b.x, 1u);
    } else {
      XB_SPIN((int)(xb_ld(w + 2048 + 64 * b.x) - b.bgen - b.k) < 0);
    }
    __builtin_amdgcn_fence(__ATOMIC_ACQUIRE, "agent");
    asm volatile("s_waitcnt vmcnt(0)" ::: "memory");
  }
  __syncthreads();
}

__global__ void __launch_bounds__(512, 2) yoco_fwd(Params p) {
  extern __shared__ __attribute__((aligned(16))) bf16_t smem[];
  cg::grid_group grid = cg::this_grid();
  const int tid = threadIdx.x, lane = tid & 63, wid = tid >> 6, nb = gridDim.x, bid = blockIdx.x, grp = wid >> 2, wq = wid & 3;
  int* s_unit = (int*)(smem + LDS_ELEMS);
  const float LOG2E = 1.4426950408889634f;
  XB xb = {};
  if (tid == 0) xb_init(xb, p.xbw);
  if (bid == 0 && tid < 64) p.ctr[tid] = 0;
  if (p.out == nullptr) grid.sync();

  phase0(p, smem);
  grid_barrier(xb, false);

  proj_phase(p, 0, smem);
  grid_barrier(xb, false);

  {
    const float d1 = wave_sum(p.lq1[lane] * p.lk1[lane]), d2 = wave_sum(p.lq2[lane] * p.lk2[lane]);
    const float lam = __expf(d1) - __expf(d2) + 0.2f;
    const float mqa = wave_max(fabsf(p.a_q_norm[lane])), mka = wave_max(fabsf(p.a_k_norm[lane]));
    const float mqm = wave_max(fabsf(p.mem_q_norm[lane])), mkm = wave_max(fabsf(p.mem_k_norm[lane]));
    const float sc2 = 0.125f * LOG2E;
    const float msh_a = 8.f * mqa * mka * LOG2E, msh_m = 8.f * mqm * mkm * LOG2E;
    unsigned* kvflag = (unsigned*)(p.ctr + 16);
    bool memkv_ready = false;
    const int xq = bid & 7;
    for (;;) {
      __syncthreads();
      if (tid == 0) *s_unit = atomicAdd(&p.ctr[40 + xq], 1);
      __syncthreads();
      const int u = *s_unit;
      if (u >= 1 + 96 + 32) break;
      if (u == 0) {
        mem_tile(p, xq >> 2, (xq >> 1) & 1, xq & 1, smem);
        if (xq < 4) {
          asm volatile("s_waitcnt vmcnt(0)" ::: "memory");
          __syncthreads();
          if (tid == 0) {
            __builtin_amdgcn_fence(__ATOMIC_RELEASE, "agent");
            asm volatile("s_waitcnt vmcnt(0)" ::: "memory");
            (void)__hip_atomic_fetch_add(kvflag, 1u, __ATOMIC_RELAXED, __HIP_MEMORY_SCOPE_AGENT);
          }
        }
      } else if (u < 1 + 96) {
        const int a = u - 1;
        int bh, qb;
        if (a < 32) { bh = 8 + (xq >> 1); qb = 62 + (xq & 1) - 2 * a; } else { bh = xq; qb = 63 - (a - 32); }
        attn_a_unit(p, bh / 6, bh % 6, qb, smem, lam, msh_a);
      } else {
        if (!memkv_ready) {
          if (tid == 0) {
            while (__hip_atomic_load(kvflag, __ATOMIC_RELAXED, __HIP_MEMORY_SCOPE_AGENT) < 4u) __builtin_amdgcn_s_sleep(1);
            __builtin_amdgcn_fence(__ATOMIC_ACQUIRE, "agent");
            asm volatile("s_waitcnt vmcnt(0)" ::: "memory");
          }
          __syncthreads();
          memkv_ready = true;
        }
        const int v = (xq * 32 + (u - 97)) * 2 + grp; mem_wave(p, 0, v >> 8, v & 3, ((v & 255) >> 2) * 128 + wq * 32, sc2, msh_m, smem);
      }
    }
  }
  grid_barrier(xb, false);

  {
    int mti, nti;
    for (int rd = 0; gemm_sched(rd, 4, mti, nti); ++rd) out_tile(p, p.W2t, true, mti, nti, smem);
  }
  grid_barrier(xb, false);

  proj_phase(p, 1, smem);
  grid_barrier(xb, false);

  {
    const float mqm = wave_max(fabsf(p.mem_q_norm[64 + lane])), mkm = wave_max(fabsf(p.mem_k_norm[64 + lane]));
    const float sc2 = 0.125f * LOG2E, msh_m = 8.f * mqm * mkm * LOG2E;
    const int bx = (nb & 7) ? bid : (bid & 7) * (nb >> 3) + (bid >> 3);
    for (int u = bx * 8 + wid; u < 6144 + 2048; u += nb * 8) {
      if (u < 6144) { const int bh = u >> 8, q32 = 255 - (u & 255); sb_wave(p, bh / 12, bh % 12, q32 * 32, smem); }
      else { const int v = u - 6144, rem = v & 1023; mem_wave(p, 1, v >> 10, (rem >> 2) & 3, (rem >> 4) * 128 + (rem & 3) * 32, sc2, msh_m, smem); }
    }
  }
  grid_barrier(xb, true);

  {
    int mti, nti;
    for (int rd = 0; gemm_sched(rd, 4, mti, nti); ++rd) out_tile(p, p.W4t, false, mti, nti, smem);
  }
}

extern "C" void kernel_launch(void* const* d_in, const int* in_sizes, int n_in, void* d_out, int out_size, void* d_ws, size_t ws_size, hipStream_t stream) {
  static int grid_blocks = 0;
  if (!grid_blocks) {
    int dev = 0, cus = 0, per_cu = 0;
    (void)hipGetDevice(&dev);
    (void)hipDeviceGetAttribute(&cus, hipDeviceAttributeMultiprocessorCount, dev);
    (void)hipFuncSetAttribute((const void*)yoco_fwd, hipFuncAttributeMaxDynamicSharedMemorySize, LDS_BYTES);
    (void)hipOccupancyMaxActiveBlocksPerMultiprocessor(&per_cu, yoco_fwd, NT, LDS_BYTES);
    if (per_cu > 1) per_cu = 1;
    if (per_cu < 1) per_cu = 1;
    grid_blocks = cus * per_cu;
  }
  Params p;
  memset(&p, 0, sizeof(p));
  const float* const* in = (const float* const*)d_in;
  p.x = in[0]; p.mem = in[1]; p.pos = (const int*)d_in[2];
  p.a_q_norm = in[5]; p.a_k_norm = in[6]; p.lq1 = in[7]; p.lk1 = in[8]; p.lq2 = in[9]; p.lk2 = in[10]; p.a_subln = in[11];
  p.mem_q_norm = in[20]; p.mem_k_norm = in[21];
  p.out = (float*)d_out;
  char* w = (char*)d_ws;
  size_t off = 0;
  auto take = [&](size_t bytes) { char* q = w + off; off += (bytes + 255) & ~(size_t)255; return q; };
  p.ctr = (int*)take(1024);
  p.xbw = (unsigned*)take(32768);
  p.P = (bf16_t*)take((size_t)NTOK * NP * 2);
  p.Vt = (bf16_t*)take((size_t)2 * 768 * SEQ * 2);
  p.xb = (bf16_t*)take((size_t)NTOK * DM * 2);
  p.y = (bf16_t*)take((size_t)NTOK * DM * 2);
  p.Ksb = (bf16_t*)take((size_t)2 * 768 * SEQ * 2);
  p.W1t = (bf16_t*)take((size_t)3584 * DM * 2);
  p.W2t = (bf16_t*)take((size_t)1024 * DM * 2);
  p.W3t = (bf16_t*)take((size_t)3584 * DM * 2);
  p.W4t = (bf16_t*)take((size_t)1024 * DM * 2);
  p.Wmt = (bf16_t*)take((size_t)2 * 512 * DM * 2);
  p.memb = (bf16_t*)take((size_t)512 * DM * 2);
  p.Km = (bf16_t*)take((size_t)2 * 512 * 256 * 2);
  p.Vmt = (bf16_t*)take((size_t)2 * 512 * 256 * 2);
  p.ssq0 = (float*)take((size_t)NTOK * 16 * 4);
  p.ssq1 = (float*)take((size_t)NTOK * 16 * 4);
  p.ssqm = (float*)take((size_t)512 * 16 * 4);
  p.cs = (float*)take((size_t)NTOK * 16 * 4);
  const float* a_norm = in[3]; const float* a_w_in = in[4]; const float* a_w_out = in[12]; const float* kv_norm = in[13]; const float* w_kv = in[14];
  const float* b_norm = in[15]; const float* b_w_in = in[16]; const float* b_w_out = in[17]; const float* mem_norm = in[18]; const float* mem_w_kv = in[19];
  auto setseg = [&](int i, const float* src, const float* gain, bf16_t* dst, int ld, int col0, int ncols) {
    p.seg[i].src = src; p.seg[i].gain = gain; p.seg[i].dst = dst; p.seg[i].ld = ld; p.seg[i].col0 = col0; p.seg[i].ncols = ncols; p.seg[i].pad = 0; };
  setseg(0, a_w_in, a_norm, p.W1t, 3584, 0, 3584);
  setseg(1, a_w_out, nullptr, p.W2t, 1024, 0, 1024);
  setseg(2, b_w_in, b_norm, p.W3t, 2048, 0, 768);
  setseg(3, w_kv, kv_norm, p.W3t + (size_t)768 * DM, 1536, 0, 1536);
  setseg(4, b_w_in, b_norm, p.W3t + (size_t)2304 * DM, 2048, 768, 1280);
  setseg(5, b_w_out, nullptr, p.W4t, 1024, 0, 1024);
  setseg(6, mem_w_kv, mem_norm, p.Wmt, 512, 0, 512);
  setseg(7, mem_w_kv + (size_t)1024 * 512, mem_norm + 1024, p.Wmt + (size_t)512 * DM, 512, 0, 512);
  for (int i = 0; i < 8; ++i) p.inv[i] = (float)pow(500000.0, -(double)i / 8.0);
  void* args[] = {&p};
  hipError_t e = hipLaunchCooperativeKernel((const void*)yoco_fwd, dim3(grid_blocks), dim3(NT), args, LDS_BYTES, stream);
  if (e != hipSuccess) fprintf(stderr, "cooperative launch failed: %s (grid %d)\n", hipGetErrorString(e), grid_blocks);
}
```

```cpp
#include <hip/hip_runtime.h>
#include <hip/hip_cooperative_groups.h>
#include <cstdio>
#include <cmath>
#include <cstring>
namespace cg = cooperative_groups;

typedef unsigned short bf16_t;
typedef short bf16x8 __attribute__((ext_vector_type(8)));
typedef short bf16x4 __attribute__((ext_vector_type(4)));
typedef float f32x16 __attribute__((ext_vector_type(16)));
typedef float f32x4 __attribute__((ext_vector_type(4)));
typedef float f32x2 __attribute__((ext_vector_type(2)));
typedef unsigned u32x4 __attribute__((ext_vector_type(4)));
typedef unsigned u32x2 __attribute__((ext_vector_type(2)));
typedef __bf16 bf2_t __attribute__((ext_vector_type(2)));

#define DI __device__ __forceinline__
#define MFMA32(a, b, c) __builtin_amdgcn_mfma_f32_32x32x16_bf16((a), (b), (c), 0, 0, 0)

constexpr int SEQ = 8192, DM = 1024, NTOK = 16384, NP = 3584;
constexpr int NT = 512;
constexpr float EPS = 1e-6f;
constexpr int LDS_ELEMS = 2 * 512 * 72;
constexpr int LDS_BYTES = LDS_ELEMS * 2 + 16;

struct Seg { const float* src; const float* gain; bf16_t* dst; int ld; int col0; int ncols; int pad; };

struct Params {
  const float* x; const float* mem; const int* pos;
  const float* a_q_norm; const float* a_k_norm; const float* lq1; const float* lk1; const float* lq2; const float* lk2; const float* a_subln;
  const float* mem_q_norm; const float* mem_k_norm;
  float* out;
  bf16_t* xb; bf16_t* memb; bf16_t* P; bf16_t* Vt; bf16_t* y;
  bf16_t* Ksb; bf16_t* W1t; bf16_t* W2t; bf16_t* W3t; bf16_t* W4t; bf16_t* Wmt; bf16_t* Km; bf16_t* Vmt;
  float* ssq0; float* ssq1; float* ssqm; float* cs; int* ctr; unsigned* xbw;
  Seg seg[8];
  float inv[8];
};

DI unsigned pk2(float a, float b) { f32x2 v = {a, b}; bf2_t r = __builtin_convertvector(v, bf2_t); return __builtin_bit_cast(unsigned, r); }
DI bf16_t f2bf(float a) { return (bf16_t)(pk2(a, 0.f) & 0xffffu); }
DI float bflo(unsigned w) { return __uint_as_float(w << 16); }
DI float bfhi(unsigned w) { return __uint_as_float(w & 0xffff0000u); }
DI int crow(int reg, int h) { return (reg & 3) + 8 * (reg >> 2) + 4 * h; }
DI int perm16(int kk) { return ((kk >> 2) & 1) * 8 + (kk >> 3) * 4 + (kk & 3); }
DI bf16x8 pack8(const float* v) {
  u32x4 w; w.x = pk2(v[0], v[1]); w.y = pk2(v[2], v[3]); w.z = pk2(v[4], v[5]); w.w = pk2(v[6], v[7]);
  return __builtin_bit_cast(bf16x8, w);
}
DI int opaque_tid() { int t = threadIdx.x; asm volatile("" : "+v"(t)); return t; }
DI f32x16 zero16() { f32x16 z; for (int i = 0; i < 16; ++i) z[i] = 0.f; return z; }

__device__ void phase0(const Params& p, bf16_t* smem) {
  const int tid = opaque_tid(), lane = tid & 63, wid = tid >> 6, nb = gridDim.x, bid = blockIdx.x;
  for (int row0 = (bid * 8 + wid) * 2; row0 < NTOK + 512; row0 += nb * 16) {
    f32x4 v[2][4];
#pragma unroll
    for (int q = 0; q < 2; ++q) {
      const int row = row0 + q;
      const float* src = (row < NTOK) ? p.x + (size_t)row * DM : p.mem + (size_t)(row - NTOK) * DM;
#pragma unroll
      for (int j = 0; j < 4; ++j) v[q][j] = __builtin_nontemporal_load((const f32x4*)(src + 256 * j + 4 * lane));
    }
#pragma unroll
    for (int q = 0; q < 2; ++q) {
      const int row = row0 + q;
      bf16_t* dst; float* sq;
      if (row < NTOK) { dst = p.xb + (size_t)row * DM; sq = p.ssq0 + (size_t)row * 16; }
      else { const int r2 = row - NTOK; dst = p.memb + (size_t)r2 * DM; sq = p.ssqm + (size_t)r2 * 16; }
#pragma unroll
      for (int j = 0; j < 4; ++j) {
        const f32x4 t = v[q][j];
        float s = t.x * t.x + t.y * t.y + t.z * t.z + t.w * t.w;
        u32x2 w; w.x = pk2(t.x, t.y); w.y = pk2(t.z, t.w);
        *(u32x2*)(dst + 256 * j + 4 * lane) = w;
        s += __shfl_xor(s, 1); s += __shfl_xor(s, 2); s += __shfl_xor(s, 4); s += __shfl_xor(s, 8);
        if ((lane & 15) == 0) sq[4 * j + (lane >> 4)] = s;
      }
    }
  }
  for (int i = bid * NT + tid; i < NTOK * 8; i += nb * NT) {
    const int token = i >> 3, f = i & 7;
    const float ang = (float)p.pos[token] * p.inv[f];
    double rev = (double)ang * 0.15915494309189535;
    rev -= floor(rev);
    const double q4 = rint(rev * 4.0);
    const double a = (rev - q4 * 0.25) * 6.283185307179586;
    const int q = ((int)q4) & 3;
    const double a2 = a * a;
    double sn = -1.0 / 39916800.0; sn = sn * a2 + 1.0 / 362880.0; sn = sn * a2 - 1.0 / 5040.0; sn = sn * a2 + 1.0 / 120.0; sn = sn * a2 - 1.0 / 6.0; sn = sn * a2 + 1.0; sn *= a;
    double cn = 1.0 / 479001600.0; cn = cn * a2 - 1.0 / 3628800.0; cn = cn * a2 + 1.0 / 40320.0; cn = cn * a2 - 1.0 / 720.0; cn = cn * a2 + 1.0 / 24.0; cn = cn * a2 - 0.5; cn = cn * a2 + 1.0;
    double c, s;
    if (q == 0) { c = cn; s = sn; } else if (q == 1) { c = -sn; s = cn; } else if (q == 2) { c = -cn; s = -sn; } else { c = sn; s = -cn; }
    p.cs[(size_t)token * 16 + f] = (float)c;
    p.cs[(size_t)token * 16 + 8 + f] = (float)s;
  }
  {
    f32x4 nv[2]; float ng[2]; bf16_t* ndst = nullptr;
    auto fetch = [&](int t) {
      int ct = t >> 4; const int k0 = (t & 15) * 64;
      int si = 0;
      while (ct >= (p.seg[si].ncols >> 6)) { ct -= (p.seg[si].ncols >> 6); ++si; }
      const Seg sg = p.seg[si];
      const int n0 = ct * 64;
#pragma unroll
      for (int j = 0; j < 2; ++j) {
        const int i = tid + NT * j, kr = i >> 4, c4 = i & 15;
        nv[j] = __builtin_nontemporal_load((const f32x4*)(sg.src + (size_t)(k0 + kr) * sg.ld + sg.col0 + n0 + c4 * 4));
        ng[j] = sg.gain ? sg.gain[k0 + kr] : 1.f;
      }
      ndst = sg.dst + (size_t)(n0 + (tid >> 3)) * DM + k0 + (tid & 7) * 8;
    };
    if (bid < 2560) fetch(bid);
    for (int t = bid; t < 2560; t += nb) {
      const f32x4 v0 = nv[0], v1 = nv[1]; const float g0 = ng[0], g1 = ng[1]; bf16_t* dst = ndst;
      if (t + nb < 2560) fetch(t + nb);
      __syncthreads();
      {
        const int kr = tid >> 4, c4 = tid & 15;
        smem[(c4 * 4 + 0) * 72 + kr] = f2bf(v0.x * g0); smem[(c4 * 4 + 1) * 72 + kr] = f2bf(v0.y * g0);
        smem[(c4 * 4 + 2) * 72 + kr] = f2bf(v0.z * g0); smem[(c4 * 4 + 3) * 72 + kr] = f2bf(v0.w * g0);
        smem[(c4 * 4 + 0) * 72 + kr + 32] = f2bf(v1.x * g1); smem[(c4 * 4 + 1) * 72 + kr + 32] = f2bf(v1.y * g1);
        smem[(c4 * 4 + 2) * 72 + kr + 32] = f2bf(v1.z * g1); smem[(c4 * 4 + 3) * 72 + kr + 32] = f2bf(v1.w * g1);
      }
      __syncthreads();
      *(u32x4*)dst = *(const u32x4*)(smem + (tid >> 3) * 72 + (tid & 7) * 8);
    }
  }
  __syncthreads();
}

template <int MT>
DI void gemm_core(const bf16_t* __restrict__ Wt, const bf16_t* __restrict__ X, int n0, int m0, f32x16 (&acc)[2][MT], bf16_t* smem) {
  const int tid = opaque_tid(), lane = tid & 63, wid = tid >> 6, wn = wid >> 1, wm = wid & 1, r = lane & 31, h = lane >> 5;
  bf16_t* Ws = smem;
  bf16_t* Xs = smem + 2 * 256 * 72;
  const char* wub = (const char*)(Wt + (size_t)n0 * DM);
  const char* xub = (const char*)(X + (size_t)m0 * DM);
  const unsigned voff = (unsigned)(((tid >> 3) * DM + (tid & 7) * 8) * 2);
#define GLD_W(i, k) (*(const u32x4*)(wub + ((size_t)(i) * 64 * DM * 2 + (size_t)(k) * 128) + voff))
#define GLD_X(i, k) (*(const u32x4*)(xub + ((size_t)(i) * 64 * DM * 2 + (size_t)(k) * 128) + voff))
  const int so = (tid >> 3) * 72 + (tid & 7) * 8;
  u32x4 wr[4], xr[MT];
#pragma unroll
  for (int i = 0; i < 4; ++i) wr[i] = GLD_W(i, 0);
#pragma unroll
  for (int i = 0; i < MT; ++i) xr[i] = GLD_X(i, 0);
  __syncthreads();
#pragma unroll
  for (int i = 0; i < 4; ++i) *(u32x4*)(Ws + so + i * 64 * 72) = wr[i];
#pragma unroll
  for (int i = 0; i < MT; ++i) *(u32x4*)(Xs + so + i * 64 * 72) = xr[i];
#pragma unroll
  for (int i = 0; i < 4; ++i) wr[i] = GLD_W(i, 1);
#pragma unroll
  for (int i = 0; i < MT; ++i) xr[i] = GLD_X(i, 1);
  __syncthreads();
  const int ao = (wn * 64 + r) * 72 + h * 8, bo = (wm * (MT * 32) + r) * 72 + h * 8;
  for (int kt = 0; kt < 16; ++kt) {
    const int cur = (kt & 1) * 256 * 72, nxt = ((kt + 1) & 1) * 256 * 72;
#pragma unroll
    for (int s = 0; s < 4; ++s) {
      bf16x8 a[2], b[MT];
#pragma unroll
      for (int nt = 0; nt < 2; ++nt) a[nt] = *(const bf16x8*)(Ws + cur + ao + nt * 32 * 72 + s * 16);
#pragma unroll
      for (int mt = 0; mt < MT; ++mt) b[mt] = *(const bf16x8*)(Xs + cur + bo + mt * 32 * 72 + s * 16);
      if (kt + 1 < 16) {
        *(u32x4*)(Ws + nxt + so + s * 64 * 72) = wr[s];
        if (s < MT) *(u32x4*)(Xs + nxt + so + s * 64 * 72) = xr[s < MT ? s : 0];
        if (kt + 2 < 16) {
          wr[s] = GLD_W(s, kt + 2);
          if (s < MT) xr[s < MT ? s : 0] = GLD_X(s, kt + 2);
        }
      }
#pragma unroll
      for (int nt = 0; nt < 2; ++nt)
#pragma unroll
        for (int mt = 0; mt < MT; ++mt) acc[nt][mt] = MFMA32(a[nt], b[mt], acc[nt][mt]);
    }
    __syncthreads();
  }
}

DI float row_rinv(const float* ssq, int token) {
  const f32x4* q = (const f32x4*)(ssq + (size_t)token * 16);
  const f32x4 a = q[0], b = q[1], c = q[2], d = q[3];
  const float s = ((a.x + a.y) + (a.z + a.w)) + ((b.x + b.y) + (b.z + b.w)) + ((c.x + c.y) + (c.z + c.w)) + ((d.x + d.y) + (d.z + d.w));
  return rsqrtf(s * (1.f / 1024.f) + EPS);
}

enum { EK_QKROPE = 0, EK_NORM = 1, EK_PLAIN = 2, EK_VT = 3, EK_SILU = 4, EK_VBLK = 5 };

template <int MT>
DI void epi_proj(const f32x16 (&acc)[2][MT], int kind, const float* __restrict__ ssq0, const float* __restrict__ gain, const float* __restrict__ cs0,
                 bf16_t* __restrict__ dbase, int ld, bf16_t* __restrict__ vbase, int vt_ld, bf16_t* smem, float qscale) {
  const int tid = opaque_tid(), lane = tid & 63, wid = tid >> 6, r = lane & 31, h = lane >> 5;
  bf16_t* wreg = smem + wid * 9216;
#pragma unroll
  for (int mt = 0; mt < MT; ++mt) {
    const float rs = row_rinv(ssq0, mt * 32);
    float v[2][16];
#pragma unroll
    for (int nt = 0; nt < 2; ++nt)
#pragma unroll
      for (int i = 0; i < 16; ++i) v[nt][i] = acc[nt][mt][i] * rs;
    if (kind <= EK_NORM) {
      float ss = 0.f;
#pragma unroll
      for (int nt = 0; nt < 2; ++nt)
#pragma unroll
        for (int i = 0; i < 16; ++i) ss += v[nt][i] * v[nt][i];
      ss += __shfl_xor(ss, 32);
      const float rn = rsqrtf(ss * (1.f / 64.f) + EPS);
#pragma unroll
      for (int nt = 0; nt < 2; ++nt)
#pragma unroll
        for (int g = 0; g < 4; ++g) {
          const f32x4 gg = *(const f32x4*)(gain + nt * 32 + 8 * g + 4 * h);
          v[nt][4 * g + 0] *= rn * gg.x; v[nt][4 * g + 1] *= rn * gg.y; v[nt][4 * g + 2] *= rn * gg.z; v[nt][4 * g + 3] *= rn * gg.w;
        }
      if (kind == EK_QKROPE) {
        const f32x4 c = *(const f32x4*)(cs0 + mt * 32 * 16 + 4 * h);
        const f32x4 s = *(const f32x4*)(cs0 + mt * 32 * 16 + 8 + 4 * h);
#pragma unroll
        for (int i = 0; i < 4; ++i) {
          const float x1 = v[0][i], x2 = v[0][4 + i];
          v[0][i] = x1 * c[i] - x2 * s[i];
          v[0][4 + i] = x2 * c[i] + x1 * s[i];
        }
#pragma unroll
        for (int nt = 0; nt < 2; ++nt)
#pragma unroll
          for (int i = 0; i < 16; ++i) v[nt][i] *= qscale;
      }
    } else if (kind == EK_PLAIN) {
#pragma unroll
      for (int nt = 0; nt < 2; ++nt)
#pragma unroll
        for (int i = 0; i < 16; ++i) v[nt][i] *= qscale;
    } else if (kind == EK_SILU) {
#pragma unroll
      for (int nt = 0; nt < 2; ++nt)
#pragma unroll
        for (int i = 0; i < 16; ++i) v[nt][i] = v[nt][i] * __builtin_amdgcn_rcpf(1.f + __builtin_amdgcn_exp2f(-1.4426950408889634f * v[nt][i]));
    }
    if (kind == EK_VT || kind == EK_VBLK) {
#pragma unroll
      for (int nt = 0; nt < 2; ++nt)
#pragma unroll
        for (int i = 0; i < 16; ++i) wreg[(nt * 32 + crow(i, h)) * 136 + mt * 32 + (r & 16) + perm16(r & 15)] = f2bf(v[nt][i]);
    } else {
#pragma unroll
      for (int nt = 0; nt < 2; ++nt)
#pragma unroll
        for (int g = 0; g < 4; ++g) {
          u32x2 w; w.x = pk2(v[nt][4 * g], v[nt][4 * g + 1]); w.y = pk2(v[nt][4 * g + 2], v[nt][4 * g + 3]);
          *(u32x2*)(wreg + (mt * 32 + r) * 72 + nt * 32 + 8 * g + 4 * h) = w;
        }
    }
  }
  __syncthreads();
  constexpr int CPR = MT * 4, RPI = 64 / CPR;
  if (kind == EK_VT) {
#pragma unroll
    for (int j = 0; j < CPR; ++j) {
      const int n = j * RPI + lane / CPR, c = lane % CPR;
      *(u32x4*)(vbase + (size_t)n * vt_ld + c * 8) = *(const u32x4*)(wreg + n * 136 + c * 8);
    }
  } else if (kind == EK_VBLK) {
#pragma unroll
    for (int j = 0; j < CPR; ++j) {
      const int n = j * RPI + lane / CPR, c = lane % CPR;
      *(u32x4*)(vbase + (size_t)(c >> 2) * 2048 + n * 32 + (c & 3) * 8) = *(const u32x4*)(wreg + n * 136 + c * 8);
    }
  } else {
#pragma unroll
    for (int j = 0; j < MT * 4; ++j) {
      const int row = j * 8 + (lane >> 3), c = lane & 7;
      *(u32x4*)(dbase + (size_t)row * ld + c * 8) = *(const u32x4*)(wreg + row * 72 + c * 8);
    }
  }
}

template <int MT>
DI void zero_acc(f32x16 (&acc)[2][MT]) {
#pragma unroll
  for (int a = 0; a < 2; ++a)
#pragma unroll
    for (int b = 0; b < MT; ++b) acc[a][b] = zero16();
}

template <int MT>
__device__ void proj_tile(const Params& p, int layer, int m0, int nti, bf16_t* smem) {
  const int tid = opaque_tid(), lane = tid & 63, wid = tid >> 6, wn = wid >> 1, wm = wid & 1, r = lane & 31, h = lane >> 5;
  const int n0 = nti * 256;
  f32x16 acc[2][MT];
  zero_acc<MT>(acc);
  gemm_core<MT>(layer ? p.W3t : p.W1t, p.xb, n0, m0, acc, smem);
  const float* ssq = layer ? p.ssq1 : p.ssq0;
  const int tok = m0 + wm * (MT * 32) + r;
  const int cc = n0 + wn * 64;
  int kind; const float* gain = p.a_q_norm;
  if (cc < 1536) { kind = layer ? EK_PLAIN : EK_QKROPE; gain = (cc < 768) ? p.a_q_norm : p.a_k_norm; }
  else if (cc < 2304) kind = EK_VT;
  else if (cc < 2560) { kind = EK_NORM; gain = p.mem_q_norm + layer * 64; }
  else kind = EK_SILU;
  const int tok0 = m0 + wm * (MT * 32), b = tok0 >> 13;
  bf16_t* vtb = p.Vt + ((size_t)b * 768 + (cc - 1536)) * SEQ + (tok0 & (SEQ - 1));
  bf16_t* dbase = p.P + (size_t)tok0 * NP + cc;
  int ld = NP;
  if (layer && cc >= 768 && cc < 1536) {
    dbase = p.Ksb + (((size_t)b * 12 + ((cc - 768) >> 6)) * SEQ + (tok0 & (SEQ - 1))) * 64; ld = 64;
  } else if (layer && kind == EK_VT) {
    kind = EK_VBLK;
    vtb = p.Vt + (((size_t)b * 12 + ((cc - 1536) >> 6)) * 256 + ((tok0 & (SEQ - 1)) >> 5)) * 2048;
  }
  epi_proj<MT>(acc, kind, ssq + (size_t)tok * 16, gain, p.cs + (size_t)tok * 16, dbase, ld, vtb, SEQ, smem, (cc < 768) ? 0.125f * 1.4426950408889634f : 1.f);
}

__device__ void mem_tile(const Params& p, int l, int mti, int nti, bf16_t* smem) {
  const int tid = opaque_tid(), lane = tid & 63, wid = tid >> 6, wn = wid >> 1, wm = wid & 1, r = lane & 31, h = lane >> 5;
  const int m0 = mti * 256, n0 = nti * 256;
  f32x16 acc[2][4];
  zero_acc<4>(acc);
  gemm_core<4>(p.Wmt + (size_t)l * 512 * DM, p.memb, n0, m0, acc, smem);
  const int tok = m0 + wm * 128 + r;
  const int cc = n0 + wn * 64;
  const int kind = (cc < 256) ? EK_NORM : EK_VT;
  const int tok0 = m0 + wm * 128, b = tok0 >> 8;
  bf16_t* vtb = p.Vmt + ((size_t)(l * 2 + b) * 256 + (cc - 256)) * 256 + (tok0 & 255);
  epi_proj<4>(acc, kind, p.ssqm + (size_t)tok * 16, p.mem_k_norm + l * 64, p.cs, p.Km + ((size_t)l * 512 + tok0) * 256 + cc, 256, vtb, 256, smem, 1.f);
}

__device__ void out_tile(const Params& p, const bf16_t* Wt, bool first, int mti, int nti, bf16_t* smem) {
  const int tid = opaque_tid(), lane = tid & 63, wid = tid >> 6, wn = wid >> 1, wm = wid & 1, r = lane & 31, h = lane >> 5;
  const int m0 = mti * 256, n0 = nti * 256;
  f32x16 acc[2][4];
  zero_acc<4>(acc);
  gemm_core<4>(Wt, p.y, n0, m0, acc, smem);
  const int cc = n0 + wn * 64;
  float* freg = (float*)smem + wid * 4608;
#pragma unroll
  for (int half = 0; half < 2; ++half) {
#pragma unroll
    for (int mtl = 0; mtl < 2; ++mtl)
#pragma unroll
      for (int nt = 0; nt < 2; ++nt)
#pragma unroll
        for (int g = 0; g < 4; ++g) {
          f32x4 o; o.x = acc[nt][half * 2 + mtl][4 * g + 0]; o.y = acc[nt][half * 2 + mtl][4 * g + 1]; o.z = acc[nt][half * 2 + mtl][4 * g + 2]; o.w = acc[nt][half * 2 + mtl][4 * g + 3];
          *(f32x4*)(freg + (mtl * 32 + r) * 68 + nt * 32 + 8 * g + 4 * h) = o;
        }
    __syncthreads();
#pragma unroll
    for (int j = 0; j < 16; ++j) {
      const int row = j * 4 + (lane >> 4), c = lane & 15;
      const int tok = m0 + wm * 128 + half * 64 + row;
      const size_t off = (size_t)tok * DM + cc + c * 4;
      const f32x4 a = *(const f32x4*)(freg + row * 68 + c * 4);
      f32x4 o;
      if (first) {
        const u32x2 xw = *(const u32x2*)(p.xb + off);
        o.x = bflo(xw.x) + a.x; o.y = bfhi(xw.x) + a.y; o.z = bflo(xw.y) + a.z; o.w = bfhi(xw.y) + a.w;
        u32x2 w; w.x = pk2(o.x, o.y); w.y = pk2(o.z, o.w);
        *(u32x2*)(p.xb + off) = w;
        float ss = o.x * o.x + o.y * o.y + o.z * o.z + o.w * o.w;
        ss += __shfl_xor(ss, 1); ss += __shfl_xor(ss, 2); ss += __shfl_xor(ss, 4); ss += __shfl_xor(ss, 8);
        if (c == 0) p.ssq1[(size_t)tok * 16 + (cc >> 6)] = ss;
      } else {
        const u32x2 w = *(const u32x2*)(p.xb + off);
        o.x = bflo(w.x) + a.x; o.y = bfhi(w.x) + a.y; o.z = bflo(w.y) + a.z; o.w = bfhi(w.y) + a.w;
        __builtin_nontemporal_store(o, (f32x4*)(p.out + off));
      }
      if ((j & 3) == 3) __builtin_amdgcn_sched_barrier(0);
    }
    __syncthreads();
  }
}

template <int NDT>
DI void store_gated(const f32x16 (&O)[NDT], float* reg, const bf16_t* __restrict__ grow0, bf16_t* __restrict__ yrow0, const float* __restrict__ gain, int lane) {
  constexpr int RS = NDT * 32 + 4, LPR = NDT * 8, RPI = 64 / LPR;
  const int r = lane & 31, h = lane >> 5;
#pragma unroll
  for (int dvt = 0; dvt < NDT; ++dvt)
#pragma unroll
    for (int g = 0; g < 4; ++g) {
      f32x4 o; o.x = O[dvt][4 * g + 0]; o.y = O[dvt][4 * g + 1]; o.z = O[dvt][4 * g + 2]; o.w = O[dvt][4 * g + 3];
      *(f32x4*)(reg + r * RS + dvt * 32 + 8 * g + 4 * h) = o;
    }
  asm volatile("s_waitcnt lgkmcnt(0)" ::: "memory");
  const int c = lane % LPR;
  f32x4 gg; gg.x = 1.f; gg.y = 1.f; gg.z = 1.f; gg.w = 1.f;
  if (gain) gg = *(const f32x4*)(gain + c * 4);
#pragma unroll
  for (int j = 0; j < 32 / RPI; ++j) {
    const int row = j * RPI + lane / LPR;
    const f32x4 v = *(const f32x4*)(reg + row * RS + c * 4);
    const u32x2 gw = *(const u32x2*)(grow0 + (size_t)row * NP + c * 4);
    u32x2 w;
    w.x = pk2(v.x * gg.x * bflo(gw.x), v.y * gg.y * bfhi(gw.x));
    w.y = pk2(v.z * gg.z * bflo(gw.y), v.w * gg.w * bfhi(gw.y));
    *(u32x2*)(yrow0 + (size_t)row * DM + c * 4) = w;
  }
  asm volatile("s_waitcnt lgkmcnt(0)" ::: "memory");
}

__device__ int attn_a_unit(const Params& p, int b, int hd, int qb, bf16_t* smem, float lam, float msh, int* qctr) {
  const int tid = opaque_tid(), lane = tid & 63, wid = tid >> 6, r = lane & 31, h = lane >> 5, grp = wid >> 2, wq = wid & 3;
  const bf16_t* Pb = p.P + (size_t)b * SEQ * NP;
  const bf16_t* Vb = p.Vt + ((size_t)b * 768 + hd * 128) * SEQ;
  const int q0 = qb * 128 + wq * 32;
  bf16x8 qf[4];
#pragma unroll
  for (int s = 0; s < 4; ++s) qf[s] = *(const bf16x8*)(Pb + (size_t)(q0 + r) * NP + grp * 384 + hd * 64 + s * 16 + h * 8);
  f32x16 O[4];
#pragma unroll
  for (int i = 0; i < 4; ++i) O[i] = zero16();
  float l = 0.f;
  const int nkt = 2 * (qb + 1);
  constexpr int VOFF = 9216, SSTR = 18432;
  const char* kub = (const char*)(Pb + 768 + hd * 64);
  const char* vub = (const char*)Vb;
  const unsigned kvo = (unsigned)(((tid >> 3) * NP + (tid & 7) * 8) * 2);
  const unsigned vvo = (unsigned)(((tid >> 3) * SEQ + (tid & 7) * 8) * 2);
#define GLD_K(i, t) (*(const u32x4*)(kub + ((size_t)(t) * 64 * NP * 2 + (size_t)(i) * 768) + kvo))
#define GLD_V(i, t) (*(const u32x4*)(vub + ((size_t)(i) * 64 * SEQ * 2 + (size_t)(t) * 128) + vvo))
  const int kso = (tid >> 3) * 72 + (tid & 7) * 8;
  const int vso = VOFF + (tid >> 3) * 72 + (tid & 7) * 8;
  const int kro = grp * 64 * 72 + r * 72 + h * 8;
  const int vro = VOFF + r * 72 + 8 * h;
  u32x4 kr[2], vr[2];
#pragma unroll
  for (int i = 0; i < 2; ++i) { kr[i] = GLD_K(i, 0); vr[i] = GLD_V(i, 0); }
#pragma unroll
  for (int i = 0; i < 2; ++i) {
    *(u32x4*)(smem + kso + i * 64 * 72) = kr[i];
    *(u32x4*)(smem + vso + i * 64 * 72) = vr[i];
  }
#pragma unroll
  for (int i = 0; i < 2; ++i) { kr[i] = GLD_K(i, 1); vr[i] = GLD_V(i, 1); }
  __syncthreads();
  for (int kt = 0; kt < nkt; ++kt) {
    const int cur = (kt & 1) * SSTR, nxt = ((kt + 1) & 1) * SSTR;
    if (kt + 1 < nkt) {
#pragma unroll
      for (int i = 0; i < 2; ++i) {
        *(u32x4*)(smem + nxt + kso + i * 64 * 72) = kr[i];
        *(u32x4*)(smem + nxt + vso + i * 64 * 72) = vr[i];
      }
      if (kt + 2 < nkt) {
#pragma unroll
        for (int i = 0; i < 2; ++i) { kr[i] = GLD_K(i, kt + 2); vr[i] = GLD_V(i, kt + 2); }
      }
    }
    const int k0 = kt * 64;
    if (k0 <= q0 + 31) {
      bf16x8 kfr[8], vfa[8], vfb[8];
#pragma unroll
      for (int s = 0; s < 8; ++s) kfr[s] = *(const bf16x8*)(smem + cur + kro + (s >> 2) * 32 * 72 + (s & 3) * 16);
      __builtin_amdgcn_sched_barrier(0);
      f32x16 S0 = zero16(), S1 = zero16();
#pragma unroll
      for (int s = 0; s < 4; ++s) S0 = MFMA32(kfr[s], qf[s], S0);
#pragma unroll
      for (int s = 0; s < 8; ++s) vfa[s] = *(const bf16x8*)(smem + cur + vro + (s >> 1) * 32 * 72 + (s & 1) * 16);
#pragma unroll
      for (int s = 0; s < 4; ++s) S1 = MFMA32(kfr[4 + s], qf[s], S1);
      __builtin_amdgcn_sched_barrier(0);
      const int dq = q0 + r - k0 - 4 * h;
      float pv[16]; bf16x8 pk[2];
#pragma unroll
      for (int s = 0; s < 8; ++s) vfb[s] = *(const bf16x8*)(smem + cur + vro + (s >> 1) * 32 * 72 + 32 + (s & 1) * 16);
#pragma unroll
      for (int i = 0; i < 16; ++i) pv[i] = __builtin_amdgcn_exp2f(S0[i]);
      if (k0 + 31 > q0) {
#pragma unroll
        for (int i = 0; i < 16; ++i) if ((i & 3) + 8 * (i >> 2) > dq) pv[i] = 0.f;
      }
#pragma unroll
      for (int i = 0; i < 16; ++i) l += pv[i];
      pk[0] = pack8(pv); pk[1] = pack8(pv + 8);
      __builtin_amdgcn_sched_barrier(0);
#pragma unroll
      for (int s = 0; s < 8; ++s) O[s >> 1] = MFMA32(vfa[s], pk[s & 1], O[s >> 1]);
#pragma unroll
      for (int i = 0; i < 16; ++i) pv[i] = __builtin_amdgcn_exp2f(S1[i]);
      if (k0 + 63 > q0) {
#pragma unroll
        for (int i = 0; i < 16; ++i) if (32 + (i & 3) + 8 * (i >> 2) > dq) pv[i] = 0.f;
      }
#pragma unroll
      for (int i = 0; i < 16; ++i) l += pv[i];
      bf16x8 pq[2]; pq[0] = pack8(pv); pq[1] = pack8(pv + 8);
      __builtin_amdgcn_sched_barrier(0);
#pragma unroll
      for (int s = 0; s < 8; ++s) O[s >> 1] = MFMA32(vfb[s], pq[s & 1], O[s >> 1]);
    }
    __syncthreads();
  }
  int nu = 0;
  if (tid == 0) nu = atomicAdd(qctr, 1);
  l += __shfl_xor(l, 32);
  float* xch = (float*)smem + (size_t)wq * 65 * 64 + lane;
  if (grp == 1) {
#pragma unroll
    for (int dvt = 0; dvt < 4; ++dvt)
#pragma unroll
      for (int i = 0; i < 16; ++i) xch[(dvt * 16 + i) * 64] = O[dvt][i];
    xch[64 * 64] = l;
  }
  __syncthreads();
  if (grp == 0) {
    const float i1 = 1.f / l, i2 = lam / xch[64 * 64];
    float ss = 0.f;
#pragma unroll
    for (int dvt = 0; dvt < 4; ++dvt)
#pragma unroll
      for (int i = 0; i < 16; ++i) { const float o = O[dvt][i] * i1 - xch[(dvt * 16 + i) * 64] * i2; O[dvt][i] = o; ss += o * o; }
    ss += __shfl_xor(ss, 32);
    const float rn = rsqrtf(ss * (1.f / 128.f) + EPS) * 0.8f;
#pragma unroll
    for (int dvt = 0; dvt < 4; ++dvt)
#pragma unroll
      for (int i = 0; i < 16; ++i) O[dvt][i] *= rn;
    const size_t tok0 = (size_t)b * SEQ + q0;
    store_gated<4>(O, (float*)smem + 16640 + wq * 4352, p.P + tok0 * NP + 2560 + hd * 128, p.y + tok0 * DM + hd * 128, p.a_subln, lane);
  }
  return nu;
}

__device__ void mem_wave(const Params& p, int l, int b, int mh, int q0, float sc2, float msh, bf16_t* smem) {
  const int tid = opaque_tid(), lane = tid & 63, r = lane & 31, h = lane >> 5;
  const size_t tok = (size_t)b * SEQ + q0 + r;
  const bf16_t* prow = p.P + tok * NP;
  bf16x8 qf[4];
#pragma unroll
  for (int s = 0; s < 4; ++s) qf[s] = *(const bf16x8*)(prow + 2304 + mh * 64 + s * 16 + h * 8);
  const bf16_t* Kl = p.Km + ((size_t)(l * 2 + b) * 256 + r) * 256 + mh * 64 + h * 8;
  const bf16_t* Vl = p.Vmt + ((size_t)(l * 2 + b) * 256 + mh * 64 + r) * 256 + 8 * h;
  f32x16 O[2]; O[0] = zero16(); O[1] = zero16();
  float lsum = 0.f;
  bf16x8 kf[4], vf[4], kn[4], vn[4];
#pragma unroll
  for (int s = 0; s < 4; ++s) { kf[s] = *(const bf16x8*)(Kl + s * 16); vf[s] = *(const bf16x8*)(Vl + (s >> 1) * 32 * 256 + (s & 1) * 16); }
#pragma unroll
  for (int s = 0; s < 4; ++s) { kn[s] = kf[s]; vn[s] = vf[s]; }
  for (int kt = 0; kt < 8; ++kt) {
    if (kt + 1 < 8) {
      const int k1 = (kt + 1) * 32;
#pragma unroll
      for (int s = 0; s < 4; ++s) { kn[s] = *(const bf16x8*)(Kl + (size_t)k1 * 256 + s * 16); vn[s] = *(const bf16x8*)(Vl + (s >> 1) * 32 * 256 + k1 + (s & 1) * 16); }
    }
    __builtin_amdgcn_sched_barrier(0);
    f32x16 S = zero16();
#pragma unroll
    for (int s = 0; s < 4; ++s) S = MFMA32(kf[s], qf[s], S);
    float pv[16];
#pragma unroll
    for (int i = 0; i < 16; ++i) { pv[i] = __builtin_amdgcn_exp2f(S[i] * sc2 - msh); lsum += pv[i]; }
    bf16x8 pk[2]; pk[0] = pack8(pv); pk[1] = pack8(pv + 8);
#pragma unroll
    for (int s = 0; s < 4; ++s) O[s >> 1] = MFMA32(vf[s], pk[s & 1], O[s >> 1]);
#pragma unroll
    for (int s = 0; s < 4; ++s) { kf[s] = kn[s]; vf[s] = vn[s]; }
  }
  lsum += __shfl_xor(lsum, 32);
  const float inv = __builtin_amdgcn_rcpf(lsum);
#pragma unroll
  for (int dvt = 0; dvt < 2; ++dvt)
#pragma unroll
    for (int i = 0; i < 16; ++i) O[dvt][i] *= inv;
  store_gated<2>(O, (float*)smem + (tid >> 6) * 4608, prow - (size_t)r * NP + 2560 + 768 + mh * 64, p.y + (tok - r) * DM + 768 + mh * 64, nullptr, lane);
}

__device__ void sb_wave(const Params& p, int b, int hd, int q0, bf16_t* smem) {
  const int tid = opaque_tid(), lane = tid & 63, r = lane & 31, h = lane >> 5;
  const bf16_t* Pb = p.P + (size_t)b * SEQ * NP;
  const bf16_t* Kl = p.Ksb + (((size_t)b * 12 + hd) * SEQ + r) * 64 + h * 8;
  const bf16_t* Vl = p.Vt + ((size_t)b * 12 + hd) * 256 * 2048 + r * 32 + 8 * h;
  const size_t tok = (size_t)b * SEQ + q0 + r;
  bf16x8 qf[4];
#pragma unroll
  for (int s = 0; s < 4; ++s) qf[s] = *(const bf16x8*)(Pb + (size_t)(q0 + r) * NP + hd * 64 + s * 16 + h * 8);
  f32x16 O[2]; O[0] = zero16(); O[1] = zero16();
  float R = 0.f;
  const int ktd = q0 >> 5;
  bf16x8 kf[4], kn[4], vf[4];
#pragma unroll
  for (int s = 0; s < 4; ++s) { kf[s] = *(const bf16x8*)(Kl + (size_t)q0 * 64 + s * 16); kn[s] = kf[s]; }
  for (int kt = ktd; kt >= 0; --kt) {
    const int k0 = kt * 32;
    const bool diag = (kt == ktd);
#pragma unroll
    for (int s = 0; s < 4; ++s) vf[s] = *(const bf16x8*)(Vl + (size_t)kt * 2048 + (s >> 1) * 32 * 32 + (s & 1) * 16);
    if (kt > 0) {
#pragma unroll
      for (int s = 0; s < 4; ++s) kn[s] = *(const bf16x8*)(Kl + (size_t)(k0 - 32) * 64 + s * 16);
    }
    __builtin_amdgcn_sched_barrier(0);
    f32x16 S = zero16();
#pragma unroll
    for (int s = 0; s < 4; ++s) S = MFMA32(kf[s], qf[s], S);
    float lb[16], f[16];
#pragma unroll
    for (int i = 0; i < 16; ++i) {
      const float z = S[i];
      const float L = __builtin_amdgcn_logf(1.f + __builtin_amdgcn_exp2f(-fabsf(z)));
      const float lbv = fminf(z, 0.f) - L;
      lb[i] = lbv; f[i] = lbv - z;
    }
    if (diag) {
#pragma unroll
      for (int i = 0; i < 16; ++i) if (crow(i, h) >= r) f[i] = 0.f;
    }
    float T[4], PT[4], loc[16];
#pragma unroll
    for (int g = 0; g < 4; ++g) {
      loc[4 * g + 3] = 0.f;
      loc[4 * g + 2] = f[4 * g + 3];
      loc[4 * g + 1] = loc[4 * g + 2] + f[4 * g + 2];
      loc[4 * g + 0] = loc[4 * g + 1] + f[4 * g + 1];
      T[g] = loc[4 * g + 0] + f[4 * g + 0];
    }
#pragma unroll
    for (int g = 0; g < 4; ++g) PT[g] = __shfl_xor(T[g], 32);
    float hg = R;
    float av[16];
#pragma unroll
    for (int g = 3; g >= 0; --g) {
      const float base = hg + (h == 0 ? PT[g] : 0.f);
#pragma unroll
      for (int i = 0; i < 4; ++i) av[4 * g + i] = __builtin_amdgcn_exp2f(lb[4 * g + i] + (base + loc[4 * g + i]));
      hg += T[g] + PT[g];
    }
    if (diag) {
#pragma unroll
      for (int i = 0; i < 16; ++i) if (crow(i, h) >= r) av[i] = 0.f;
    }
    R = hg;
    bf16x8 pk[2]; pk[0] = pack8(av); pk[1] = pack8(av + 8);
#pragma unroll
    for (int s = 0; s < 4; ++s) O[s >> 1] = MFMA32(vf[s], pk[s & 1], O[s >> 1]);
#pragma unroll
    for (int s = 0; s < 4; ++s) kf[s] = kn[s];
    if (__all(R < -104.f * 1.4426950408889634f)) break;
  }
  store_gated<2>(O, (float*)smem + (tid >> 6) * 4608, p.P + (tok - r) * NP + 2560 + hd * 64, p.y + (tok - r) * DM + hd * 64, nullptr, lane);
}

DI float wave_sum(float v) { for (int o = 32; o > 0; o >>= 1) v += __shfl_xor(v, o); return v; }
DI float wave_max(float v) { for (int o = 32; o > 0; o >>= 1) v = fmaxf(v, __shfl_xor(v, o)); return v; }

DI bool gemm_sched(int rd, int ntn, int& mti, int& nti) {
  const int nb = gridDim.x, bid = blockIdx.x;
  if (nb == 256) {
    const int xcd = bid & 7, li = bid >> 3, ti = rd * 32 + li;
    if (ti >= 8 * ntn) return false;
    mti = xcd * 8 + (ti & 7); nti = ti >> 3; return true;
  }
  const int t = rd * nb + bid;
  if (t >= 64 * ntn) return false;
  mti = t / ntn; nti = t % ntn; return true;
}

DI void proj_phase(const Params& p, int layer, bf16_t* smem) {
  const int nb = gridDim.x, bid = blockIdx.x;
  if (nb == 256) {
    const int xcd = bid & 7, li = bid >> 3;
    for (int rd = 0; rd < 3; ++rd) { const int ti = rd * 32 + li; proj_tile<4>(p, layer, (xcd * 8 + (ti & 7)) * 256, ti >> 3, smem); }
    { const int ti = 96 + (li >> 1); proj_tile<2>(p, layer, (xcd * 8 + (ti & 7)) * 256 + (li & 1) * 128, ti >> 3, smem); }
  } else {
    for (int t = bid; t < 64 * 14; t += nb) proj_tile<4>(p, layer, (t / 14) * 256, t % 14, smem);
  }
}

DI unsigned xb_ld(unsigned* q) { return __hip_atomic_load(q, __ATOMIC_RELAXED, __HIP_MEMORY_SCOPE_AGENT); }
DI unsigned xb_add(unsigned* q, unsigned v) { return __hip_atomic_fetch_add(q, v, __ATOMIC_RELAXED, __HIP_MEMORY_SCOPE_AGENT); }
DI void xb_st(unsigned* q, unsigned v) { __hip_atomic_store(q, v, __ATOMIC_RELAXED, __HIP_MEMORY_SCOPE_AGENT); }
struct XB { unsigned* w; unsigned x, nx, nxcc, bsub, bgen, btop, btg, k; };
#define XB_SPIN(cond) do { unsigned sp_ = 0; while (cond) { __builtin_amdgcn_s_sleep(1); if (++sp_ > (1u << 21)) break; } } while (0)
DI void xb_init(XB& b, unsigned* w) {
  b.w = w; b.k = 0; b.nx = 0; b.nxcc = 0;
  b.x = (unsigned)__builtin_amdgcn_s_getreg((3 << 11) | 20) & 0xFu;
  b.bsub = xb_ld(w + 4096 + 1024 + 64 * b.x); b.bgen = xb_ld(w + 4096 + 2048 + 64 * b.x);
  b.btop = xb_ld(w + 4096 + 3072); b.btg = xb_ld(w + 4096 + 3136);
  (void)xb_add(w + 64 * b.x, 1u);
}
DI void grid_barrier(XB& b, bool last) {
  asm volatile("s_waitcnt vmcnt(0)" ::: "memory");
  __syncthreads();
  if (threadIdx.x == 0) {
    unsigned* w = b.w;
    if (b.k == 0) {
      unsigned tot = 0, nx = 0, nxcc = 0, sp = 0;
      for (;;) {
        tot = 0; nx = 0; nxcc = 0;
        for (unsigned j = 0; j < 16; ++j) { const unsigned c = xb_ld(w + 64 * j) - xb_ld(w + 4096 + 64 * j); tot += c; nxcc += (c != 0u); if (j == b.x) nx = c; }
        if (tot == gridDim.x || ++sp > (1u << 18)) break;
        __builtin_amdgcn_s_sleep(1);
      }
      b.nx = nx; b.nxcc = nxcc;
    }
    b.k += 1;
    const unsigned old = xb_add(w + 1024 + 64 * b.x, 1u);
    if (old - b.bsub + 1u == b.k * b.nx) {
      __builtin_amdgcn_fence(__ATOMIC_RELEASE, "agent");
      asm volatile("s_waitcnt vmcnt(0)" ::: "memory");
      const unsigned ot = xb_add(w + 3072, 1u);
      if (ot - b.btop + 1u == b.k * b.nxcc) {
        if (last) { xb_st(w + 4096 + 3072, b.btop + b.k * b.nxcc); xb_st(w + 4096 + 3136, b.btg + b.k); }
        (void)xb_add(w + 3136, 1u);
      }
      XB_SPIN((int)(xb_ld(w + 3136) - b.btg - b.k) < 0);
      if (last) { xb_st(w + 4096 + 64 * b.x, xb_ld(w + 64 * b.x)); xb_st(w + 4096 + 1024 + 64 * b.x, b.bsub + b.k * b.nx); xb_st(w + 4096 + 2048 + 64 * b.x, b.bgen + b.k); }
      (void)xb_add(w + 2048 + 64 * b.x, 1u);
    } else {
      XB_SPIN((int)(xb_ld(w + 2048 + 64 * b.x) - b.bgen - b.k) < 0);
    }
    __builtin_amdgcn_fence(__ATOMIC_ACQUIRE, "agent");
    asm volatile("s_waitcnt vmcnt(0)" ::: "memory");
  }
  __syncthreads();
}

__global__ void __launch_bounds__(512, 2) yoco_fwd(Params p) {
  extern __shared__ __attribute__((aligned(16))) bf16_t smem[];
  cg::grid_group grid = cg::this_grid();
  const int tid = threadIdx.x, lane = tid & 63, wid = tid >> 6, nb = gridDim.x, bid = blockIdx.x, grp = wid >> 2, wq = wid & 3;
  int* s_unit = (int*)(smem + LDS_ELEMS);
  const float LOG2E = 1.4426950408889634f;
  XB xb = {};
  if (tid == 0) xb_init(xb, p.xbw);
  if (bid == 0 && tid < 64) p.ctr[tid] = 0;
  if (p.out == nullptr) grid.sync();

  phase0(p, smem);
  grid_barrier(xb, false);

  proj_phase(p, 0, smem);
  grid_barrier(xb, false);

  {
    const float d1 = wave_sum(p.lq1[lane] * p.lk1[lane]), d2 = wave_sum(p.lq2[lane] * p.lk2[lane]);
    const float lam = __expf(d1) - __expf(d2) + 0.2f;
    const float mqa = wave_max(fabsf(p.a_q_norm[lane])), mka = wave_max(fabsf(p.a_k_norm[lane]));
    const float mqm = wave_max(fabsf(p.mem_q_norm[lane])), mkm = wave_max(fabsf(p.mem_k_norm[lane]));
    const float sc2 = 0.125f * LOG2E;
    const float msh_a = 8.f * mqa * mka * LOG2E, msh_m = 8.f * mqm * mkm * LOG2E;
    unsigned* kvflag = (unsigned*)(p.ctr + 16);
    bool memkv_ready = false;
    const int xq = bid & 7;
    int* qctr = &p.ctr[40 + xq];
    int nextu = 0;
    if (tid == 0) nextu = atomicAdd(qctr, 1);
    for (;;) {
      __syncthreads();
      if (tid == 0) *s_unit = nextu;
      __syncthreads();
      const int u = *s_unit;
      if (u >= 1 + 96 + 32) break;
      if (u == 0) {
        mem_tile(p, xq >> 2, (xq >> 1) & 1, xq & 1, smem);
        if (xq < 4) {
          asm volatile("s_waitcnt vmcnt(0)" ::: "memory");
          __syncthreads();
          if (tid == 0) {
            __builtin_amdgcn_fence(__ATOMIC_RELEASE, "agent");
            asm volatile("s_waitcnt vmcnt(0)" ::: "memory");
            (void)__hip_atomic_fetch_add(kvflag, 1u, __ATOMIC_RELAXED, __HIP_MEMORY_SCOPE_AGENT);
          }
        }
        if (tid == 0) nextu = atomicAdd(qctr, 1);
      } else if (u < 1 + 96) {
        const int a = u - 1;
        int bh, qb;
        if (a < 32) { bh = 8 + (xq >> 1); qb = 62 + (xq & 1) - 2 * a; } else { bh = xq; qb = 63 - (a - 32); }
        nextu = attn_a_unit(p, bh / 6, bh % 6, qb, smem, lam, msh_a, qctr);
      } else {
        if (!memkv_ready) {
          if (tid == 0) {
            while (__hip_atomic_load(kvflag, __ATOMIC_RELAXED, __HIP_MEMORY_SCOPE_AGENT) < 4u) __builtin_amdgcn_s_sleep(1);
            __builtin_amdgcn_fence(__ATOMIC_ACQUIRE, "agent");
            asm volatile("s_waitcnt vmcnt(0)" ::: "memory");
          }
          __syncthreads();
          memkv_ready = true;
        }
        const int v = (xq * 32 + (u - 97)) * 2 + grp; mem_wave(p, 0, v >> 8, v & 3, ((v & 255) >> 2) * 128 + wq * 32, sc2, msh_m, smem);
        if (tid == 0) nextu = atomicAdd(qctr, 1);
      }
    }
  }
  grid_barrier(xb, false);

  {
    int mti, nti;
    for (int rd = 0; gemm_sched(rd, 4, mti, nti); ++rd) out_tile(p, p.W2t, true, mti, nti, smem);
  }
  grid_barrier(xb, false);

  proj_phase(p, 1, smem);
  grid_barrier(xb, false);

  {
    const float mqm = wave_max(fabsf(p.mem_q_norm[64 + lane])), mkm = wave_max(fabsf(p.mem_k_norm[64 + lane]));
    const float sc2 = 0.125f * LOG2E, msh_m = 8.f * mqm * mkm * LOG2E;
    const int bx = (nb & 7) ? bid : (bid & 7) * (nb >> 3) + (bid >> 3);
    for (int u = bx * 8 + wid; u < 6144 + 2048; u += nb * 8) {
      if (u < 6144) { const int bh = u >> 8, q32 = 255 - (u & 255); sb_wave(p, bh / 12, bh % 12, q32 * 32, smem); }
      else { const int v = u - 6144, rem = v & 1023; mem_wave(p, 1, v >> 10, (rem >> 2) & 3, (rem >> 4) * 128 + (rem & 3) * 32, sc2, msh_m, smem); }
    }
  }
  grid_barrier(xb, true);

  {
    int mti, nti;
    for (int rd = 0; gemm_sched(rd, 4, mti, nti); ++rd) out_tile(p, p.W4t, false, mti, nti, smem);
  }
}

extern "C" void kernel_launch(void* const* d_in, const int* in_sizes, int n_in, void* d_out, int out_size, void* d_ws, size_t ws_size, hipStream_t stream) {
  static int grid_blocks = 0;
  if (!grid_blocks) {
    int dev = 0, cus = 0, per_cu = 0;
    (void)hipGetDevice(&dev);
    (void)hipDeviceGetAttribute(&cus, hipDeviceAttributeMultiprocessorCount, dev);
    (void)hipFuncSetAttribute((const void*)yoco_fwd, hipFuncAttributeMaxDynamicSharedMemorySize, LDS_BYTES);
    (void)hipOccupancyMaxActiveBlocksPerMultiprocessor(&per_cu, yoco_fwd, NT, LDS_BYTES);
    if (per_cu > 1) per_cu = 1;
    if (per_cu < 1) per_cu = 1;
    grid_blocks = cus * per_cu;
  }
  Params p;
  memset(&p, 0, sizeof(p));
  const float* const* in = (const float* const*)d_in;
  p.x = in[0]; p.mem = in[1]; p.pos = (const int*)d_in[2];
  p.a_q_norm = in[5]; p.a_k_norm = in[6]; p.lq1 = in[7]; p.lk1 = in[8]; p.lq2 = in[9]; p.lk2 = in[10]; p.a_subln = in[11];
  p.mem_q_norm = in[20]; p.mem_k_norm = in[21];
  p.out = (float*)d_out;
  char* w = (char*)d_ws;
  size_t off = 0;
  auto take = [&](size_t bytes) { char* q = w + off; off += (bytes + 255) & ~(size_t)255; return q; };
  p.ctr = (int*)take(1024);
  p.xbw = (unsigned*)take(32768);
  p.P = (bf16_t*)take((size_t)NTOK * NP * 2);
  p.Vt = (bf16_t*)take((size_t)2 * 768 * SEQ * 2);
  p.xb = (bf16_t*)take((size_t)NTOK * DM * 2);
  p.y = (bf16_t*)take((size_t)NTOK * DM * 2);
  p.Ksb = (bf16_t*)take((size_t)2 * 768 * SEQ * 2);
  p.W1t = (bf16_t*)take((size_t)3584 * DM * 2);
  p.W2t = (bf16_t*)take((size_t)1024 * DM * 2);
  p.W3t = (bf16_t*)take((size_t)3584 * DM * 2);
  p.W4t = (bf16_t*)take((size_t)1024 * DM * 2);
  p.Wmt = (bf16_t*)take((size_t)2 * 512 * DM * 2);
  p.memb = (bf16_t*)take((size_t)512 * DM * 2);
  p.Km = (bf16_t*)take((size_t)2 * 512 * 256 * 2);
  p.Vmt = (bf16_t*)take((size_t)2 * 512 * 256 * 2);
  p.ssq0 = (float*)take((size_t)NTOK * 16 * 4);
  p.ssq1 = (float*)take((size_t)NTOK * 16 * 4);
  p.ssqm = (float*)take((size_t)512 * 16 * 4);
  p.cs = (float*)take((size_t)NTOK * 16 * 4);
  const float* a_norm = in[3]; const float* a_w_in = in[4]; const float* a_w_out = in[12]; const float* kv_norm = in[13]; const float* w_kv = in[14];
  const float* b_norm = in[15]; const float* b_w_in = in[16]; const float* b_w_out = in[17]; const float* mem_norm = in[18]; const float* mem_w_kv = in[19];
  auto setseg = [&](int i, const float* src, const float* gain, bf16_t* dst, int ld, int col0, int ncols) {
    p.seg[i].src = src; p.seg[i].gain = gain; p.seg[i].dst = dst; p.seg[i].ld = ld; p.seg[i].col0 = col0; p.seg[i].ncols = ncols; p.seg[i].pad = 0; };
  setseg(0, a_w_in, a_norm, p.W1t, 3584, 0, 3584);
  setseg(1, a_w_out, nullptr, p.W2t, 1024, 0, 1024);
  setseg(2, b_w_in, b_norm, p.W3t, 2048, 0, 768);
  setseg(3, w_kv, kv_norm, p.W3t + (size_t)768 * DM, 1536, 0, 1536);
  setseg(4, b_w_in, b_norm, p.W3t + (size_t)2304 * DM, 2048, 768, 1280);
  setseg(5, b_w_out, nullptr, p.W4t, 1024, 0, 1024);
  setseg(6, mem_w_kv, mem_norm, p.Wmt, 512, 0, 512);
  setseg(7, mem_w_kv + (size_t)1024 * 512, mem_norm + 1024, p.Wmt + (size_t)512 * DM, 512, 0, 512);
  for (int i = 0; i < 8; ++i) p.inv[i] = (float)pow(500000.0, -(double)i / 8.0);
  void* args[] = {&p};
  hipError_t e = hipLaunchCooperativeKernel((const void*)yoco_fwd, dim3(grid_blocks), dim3(NT), args, LDS_BYTES, stream);
  if (e != hipSuccess) fprintf(stderr, "cooperative launch failed: %s (grid %d)\n", hipGetErrorString(e), grid_blocks);
}
```
